# Optimizing an MI355X kernel written in HIP

```python
import jax, jax.numpy as jnp
from jax import lax
import numpy as np

D_MODEL = 2048
BATCH = 2
SEQ = 4096
DEPTH = 1

CHUNK = 64
EPS = 1e-6
A_WIDTH = D_MODEL
A_GROUPS = 8
A_GROUP_W = A_WIDTH // A_GROUPS
A_BLOCK = 128
B_HEAD_DIM = 128
B_HEADS = D_MODEL // B_HEAD_DIM
KV_LATENT = D_MODEL // 4
IDX_HEADS = D_MODEL // 128
IDX_DIM = 64
TOPK_MAX = 256
Q_BLOCK = 128
D_FF = ((8 * D_MODEL + 3 * 256 - 1) // (3 * 256)) * 256
SPLIT_SIZES = (2 * A_WIDTH, B_HEADS * B_HEAD_DIM, KV_LATENT, IDX_HEADS * IDX_DIM, IDX_DIM, IDX_HEADS, 2 * D_MODEL)
N_IN = 2 * A_WIDTH + B_HEADS * B_HEAD_DIM + KV_LATENT + IDX_HEADS * IDX_DIM + IDX_DIM + IDX_HEADS + 2 * D_MODEL

kernel_name = "hybrid_gmlp_dsa_block"


def rms_norm(x, g):
    xf = x.astype(jnp.float32)
    y = xf * lax.rsqrt(jnp.mean(xf * xf, axis=-1, keepdims=True) + EPS)
    return (y * g.astype(jnp.float32)).astype(x.dtype)


def layer_norm(x, g, b):
    xf = x.astype(jnp.float32)
    xc = xf - jnp.mean(xf, axis=-1, keepdims=True)
    y = xc * lax.rsqrt(jnp.mean(xc * xc, axis=-1, keepdims=True) + EPS)
    return (y * g.astype(jnp.float32) + b.astype(jnp.float32)).astype(x.dtype)


def chunk_causal(q_pos, k_pos):
    return (k_pos[None, :] // CHUNK) <= (q_pos[:, None] // CHUNK)


def spatial_gating_unit(z, ln_g, ln_b, w_s, b_s):
    bsz, seq, _ = z.shape
    u, v = jnp.split(z, 2, axis=-1)
    v = layer_norm(v, ln_g, ln_b).reshape(bsz, seq // A_BLOCK, A_BLOCK, A_GROUPS, A_GROUP_W)
    pos = jnp.arange(A_BLOCK)
    w = jnp.where(chunk_causal(pos, pos)[None], w_s, jnp.zeros((), w_s.dtype))
    sv = jnp.einsum("gpq,bnqgc->bnpgc", w, v) + b_s.T[None, None, :, :, None]
    return u * sv.reshape(bsz, seq, A_WIDTH)


def indexer_sparse_attention(q, c_kv, q_idx, k_idx, w_idx, w_uk, w_uv):
    bsz, seq = q.shape[0], q.shape[1]
    n_keys = c_kv.shape[1]
    k_sel = min(TOPK_MAX, n_keys // 4)
    n_blk = seq // Q_BLOCK
    key_pos = jnp.arange(n_keys)

    def to_blocks(a):
        return a.reshape((bsz, n_blk, Q_BLOCK) + a.shape[2:]).swapaxes(0, 1)

    def one_block(args):
        qb, qib, wib, start = args
        q_pos = start + jnp.arange(Q_BLOCK)
        adm = chunk_causal(q_pos, key_pos)
        logits = jnp.einsum("bthd,bsd->bths", qib, k_idx).astype(jnp.float32) * IDX_DIM ** -0.5
        score = jnp.einsum("bth,bths->bts", wib.astype(jnp.float32) * IDX_HEADS ** -0.5, jax.nn.relu(logits))
        score = jnp.where(adm[None], score, -jnp.inf)
        _, sel = lax.top_k(score, k_sel)
        valid = (sel // CHUNK) <= (q_pos[None, :, None] // CHUNK)
        c_sel = jax.vmap(lambda c, i: c[i])(c_kv, sel)
        q_lat = jnp.einsum("bthd,chd->bthc", qb, w_uk)
        att = jnp.einsum("bthc,btkc->bthk", q_lat, c_sel).astype(jnp.float32) * B_HEAD_DIM ** -0.5
        att = jnp.where(valid[:, :, None, :], att, -jnp.inf)
        p = jax.nn.softmax(att, axis=-1).astype(c_sel.dtype)
        o_lat = jnp.einsum("bthk,btkc->bthc", p, c_sel)
        return jnp.einsum("bthc,chd->bthd", o_lat, w_uv)

    starts = jnp.arange(n_blk, dtype=jnp.int32) * Q_BLOCK
    out = lax.map(one_block, (to_blocks(q), to_blocks(q_idx), to_blocks(w_idx), starts))
    return out.swapaxes(0, 1).reshape(bsz, seq, B_HEADS * B_HEAD_DIM)


def setup_inputs(seed: int = 0) -> dict:
    key = jax.random.key(seed)
    ks = jax.random.split(key, 18)
    f32 = jnp.float32

    def nrm(k, shape, scale):
        return jax.random.normal(k, shape, f32) * scale

    def gain(k, shape):
        return 1.0 + 0.02 * jax.random.normal(k, shape, f32)

    L = DEPTH
    return {
        "x": nrm(ks[0], (BATCH, SEQ, D_MODEL), 1.0),
        "norm1_g": gain(ks[1], (L, D_MODEL)),
        "w_in": nrm(ks[2], (L, D_MODEL, N_IN), D_MODEL ** -0.5),
        "a_ln_g": gain(ks[3], (L, A_WIDTH)),
        "a_ln_b": nrm(ks[4], (L, A_WIDTH), 0.02),
        "a_w_s": nrm(ks[5], (L, A_GROUPS, A_BLOCK, A_BLOCK), A_BLOCK ** -0.5),
        "a_b_s": gain(ks[6], (L, A_GROUPS, A_BLOCK)),
        "kv_norm_g": gain(ks[7], (L, KV_LATENT)),
        "w_uk": nrm(ks[8], (L, KV_LATENT, B_HEADS, B_HEAD_DIM), KV_LATENT ** -0.5),
        "w_uv": nrm(ks[9], (L, KV_LATENT, B_HEADS, B_HEAD_DIM), KV_LATENT ** -0.5),
        "w_oa": nrm(ks[10], (L, A_WIDTH, D_MODEL), A_WIDTH ** -0.5),
        "w_ob": nrm(ks[11], (L, B_HEADS * B_HEAD_DIM, D_MODEL), (B_HEADS * B_HEAD_DIM) ** -0.5),
        "w_out": nrm(ks[12], (L, D_MODEL, D_MODEL), D_MODEL ** -0.5),
        "norm2_g": gain(ks[13], (L, D_MODEL)),
        "w_ff_gate": nrm(ks[14], (L, D_MODEL, D_FF), D_MODEL ** -0.5),
        "w_ff_up": nrm(ks[15], (L, D_MODEL, D_FF), D_MODEL ** -0.5),
        "w_ff_down": nrm(ks[16], (L, D_FF, D_MODEL), D_FF ** -0.5),
        "final_g": gain(ks[17], (D_MODEL,)),
    }


def reference(x, norm1_g, w_in, a_ln_g, a_ln_b, a_w_s, a_b_s, kv_norm_g, w_uk, w_uv, w_oa, w_ob, w_out, norm2_g, w_ff_gate, w_ff_up, w_ff_down, final_g):
    bsz, seq, _ = x.shape
    cuts = []
    offset = 0
    for n in SPLIT_SIZES[:-1]:
        offset += n
        cuts.append(offset)
    h = x
    for l in range(DEPTH):
        xn = rms_norm(h, norm1_g[l])
        proj = xn @ w_in[l]
        z_a, q, c_kv, q_idx, k_idx, w_idx, gates = jnp.split(proj, cuts, axis=-1)
        y_a = spatial_gating_unit(jax.nn.gelu(z_a), a_ln_g[l], a_ln_b[l], a_w_s[l], a_b_s[l])
        y_b = indexer_sparse_attention(
            q.reshape(bsz, seq, B_HEADS, B_HEAD_DIM),
            rms_norm(c_kv, kv_norm_g[l]),
            q_idx.reshape(bsz, seq, IDX_HEADS, IDX_DIM),
            k_idx, w_idx, w_uk[l], w_uv[l])
        g_a, g_b = jnp.split(jax.nn.sigmoid(gates), 2, axis=-1)
        mixed = g_a * (y_a @ w_oa[l]) + g_b * (y_b @ w_ob[l])
        h = h + mixed @ w_out[l]
        hn = rms_norm(h, norm2_g[l])
        h = h + (jax.nn.silu(hn @ w_ff_gate[l]) * (hn @ w_ff_up[l])) @ w_ff_down[l]
    return rms_norm(h, final_g)
```

```cpp
#include <hip/hip_runtime.h>
#include <cstdio>
#include <cstdint>

constexpr int BATCH = 2, SEQ = 4096, D = 2048, M = BATCH * SEQ, NIN = 11856, FF = 5632;
constexpr int CL = 512, NH = 16, HD = 128, IH = 16, IDM = 64, TOPK = 256, CHUNK = 64;
constexpr float EPS = 1e-6f;
constexpr int NTHREADS = 512, NWAVES = 8;

typedef unsigned short bf16;
typedef float f32x4 __attribute__((ext_vector_type(4)));
typedef unsigned u32x4 __attribute__((ext_vector_type(4)));
typedef unsigned u32x2 __attribute__((ext_vector_type(2)));

__device__ __forceinline__ float bf2f(bf16 v) { return __uint_as_float(((unsigned)v) << 16); }
__device__ __forceinline__ bf16 f2bf(float f) { unsigned u = __float_as_uint(f); return (bf16)((u + 0x7fffu + ((u >> 16) & 1u)) >> 16); }
__device__ __forceinline__ float wave_sum(float v) {
#pragma unroll
    for (int o = 1; o < 64; o <<= 1) v += __shfl_xor(v, o);
    return v;
}
__device__ __forceinline__ float wave_max(float v) {
#pragma unroll
    for (int o = 1; o < 64; o <<= 1) v = fmaxf(v, __shfl_xor(v, o));
    return v;
}
__device__ __forceinline__ float gelu_tanh(float x) {
    const float u = 0.7978845608028654f * (x + 0.044715f * x * x * x);
    const float e = __expf(2.f * u);
    const float t = 1.f - 2.f / (e + 1.f);
    return 0.5f * x * (1.f + t);
}
__device__ __forceinline__ float sigmoidf(float x) { return 1.f / (1.f + __expf(-x)); }

constexpr size_t MiB = 1u << 20;
constexpr size_t WS_CTL = 0;
constexpr size_t WS_VST = 1 * MiB;
constexpr size_t WS_HST = 3 * MiB;
constexpr size_t WS_WI = 4 * MiB;
constexpr size_t WS_KI = 5 * MiB;
constexpr size_t WS_SEL = 6 * MiB;
constexpr size_t WS_CN = 14 * MiB;
constexpr size_t WS_CKR = 22 * MiB;
constexpr size_t WS_QI = 38 * MiB;
constexpr size_t WS_WSM = 54 * MiB;
constexpr size_t WS_A = 82 * MiB;
constexpr size_t WS_XN = WS_A + 47 * MiB;
constexpr size_t WS_SC = 97 * MiB;
constexpr size_t WS_QL = 98 * MiB;
constexpr size_t WS_U = 162 * MiB;
constexpr size_t WS_V = 194 * MiB;
constexpr size_t WS_Q = 226 * MiB;
constexpr size_t WS_GA = 258 * MiB;
constexpr size_t WS_GB = 290 * MiB;
constexpr size_t WS_HB = 148 * MiB;
constexpr size_t WS_FF = 226 * MiB;
constexpr size_t WS_END = 322 * MiB;

constexpr int LDS_BYTES = 147456;
constexpr size_t SC_PER_BATCH = 8519680;

__device__ __forceinline__ size_t sc_off(int b, int pos) {
    const int c = pos >> 6, r = pos & 63;
    return (size_t)b * SC_PER_BATCH + (size_t)2048 * c * (c + 1) + (size_t)r * 64 * (c + 1);
}

struct Args {
    const float* in[18];
    float* out;
    unsigned char* ws;
    int ph_lo, ph_hi;
};

template <bool DUAL, class Epi>
__device__ __forceinline__ void naive_gemm(float* lds, const bf16* A, int lda, const float* W, const float* W2, int ldw, const float* kscale,
                                           int Mrows, int N, int K, const Epi& epi, int vb, int nb) {
    float* As = lds;
    float* Ws = lds + 16 * 132;
    float* Ws2 = lds + 32 * 132;
    const int tid = threadIdx.x, tx = tid & 31, ty = tid >> 5;
    const int ntn = (N + 127) / 128, ntm = Mrows / 128;
    for (int tile = vb; tile < ntm * ntn; tile += nb) {
        const int tm = tile / ntn, tn = tile % ntn;
        const int row0 = tm * 128, col0 = tn * 128;
        float acc[8][4], acc2[8][4];
#pragma unroll
        for (int i = 0; i < 8; ++i)
#pragma unroll
            for (int j = 0; j < 4; ++j) { acc[i][j] = 0.f; acc2[i][j] = 0.f; }
        for (int k0 = 0; k0 < K; k0 += 16) {
            {
                const int r = tid >> 2, k4 = (tid & 3) * 4;
                const u32x2 raw = *(const u32x2*)(A + (size_t)(row0 + r) * lda + k0 + k4);
                As[(k4 + 0) * 132 + r] = __uint_as_float(raw.x << 16);
                As[(k4 + 1) * 132 + r] = __uint_as_float(raw.x & 0xffff0000u);
                As[(k4 + 2) * 132 + r] = __uint_as_float(raw.y << 16);
                As[(k4 + 3) * 132 + r] = __uint_as_float(raw.y & 0xffff0000u);
            }
            {
                const int k = tid >> 5, c4 = (tid & 31) * 4;
                f32x4 w = {0.f, 0.f, 0.f, 0.f}, w2 = {0.f, 0.f, 0.f, 0.f};
                if (col0 + c4 < N) {
                    w = *(const f32x4*)(W + (size_t)(k0 + k) * ldw + col0 + c4);
                    if (DUAL) w2 = *(const f32x4*)(W2 + (size_t)(k0 + k) * ldw + col0 + c4);
                    if (kscale) { const float s = kscale[k0 + k]; w = w * s; w2 = w2 * s; }
                }
                *(f32x4*)(Ws + k * 132 + c4) = w;
                if (DUAL) *(f32x4*)(Ws2 + k * 132 + c4) = w2;
            }
            __syncthreads();
#pragma unroll
            for (int k = 0; k < 16; ++k) {
                const f32x4 a0 = *(const f32x4*)(As + k * 132 + ty * 8), a1 = *(const f32x4*)(As + k * 132 + ty * 8 + 4);
                const f32x4 w = *(const f32x4*)(Ws + k * 132 + tx * 4);
                const float a[8] = {a0.x, a0.y, a0.z, a0.w, a1.x, a1.y, a1.z, a1.w};
#pragma unroll
                for (int i = 0; i < 8; ++i) { acc[i][0] += a[i] * w.x; acc[i][1] += a[i] * w.y; acc[i][2] += a[i] * w.z; acc[i][3] += a[i] * w.w; }
                if (DUAL) {
                    const f32x4 w2 = *(const f32x4*)(Ws2 + k * 132 + tx * 4);
#pragma unroll
                    for (int i = 0; i < 8; ++i) { acc2[i][0] += a[i] * w2.x; acc2[i][1] += a[i] * w2.y; acc2[i][2] += a[i] * w2.z; acc2[i][3] += a[i] * w2.w; }
                }
            }
            __syncthreads();
        }
#pragma unroll
        for (int i = 0; i < 8; ++i)
#pragma unroll
            for (int j = 0; j < 4; ++j) { const int r = row0 + ty * 8 + i, c = col0 + tx * 4 + j; if (c < N) epi(r, c, acc[i][j], acc2[i][j]); }
    }
}

struct EpiProj {
    bf16 *U, *V, *Q, *QI, *KI, *GA, *GB; float *CKR, *WI;
    __device__ __forceinline__ void operator()(int r, int c, float v, float) const {
        if (c < 2048) U[(size_t)r * 2048 + c] = f2bf(gelu_tanh(v));
        else if (c < 4096) V[(size_t)r * 2048 + c - 2048] = f2bf(gelu_tanh(v));
        else if (c < 6144) Q[(size_t)r * 2048 + c - 4096] = f2bf(v);
        else if (c < 6656) CKR[(size_t)r * 512 + c - 6144] = v;
        else if (c < 7680) QI[(size_t)r * 1024 + c - 6656] = f2bf(v);
        else if (c < 7744) KI[(size_t)r * 64 + c - 7680] = f2bf(v);
        else if (c < 7760) WI[(size_t)r * 16 + c - 7744] = v;
        else if (c < 9808) GA[(size_t)r * 2048 + c - 7760] = f2bf(sigmoidf(v));
        else GB[(size_t)r * 2048 + c - 9808] = f2bf(sigmoidf(v));
    }
};
struct EpiGateA {
    bf16* GA;
    __device__ __forceinline__ void operator()(int r, int c, float v, float) const { const size_t i = (size_t)r * 2048 + c; GA[i] = f2bf(bf2f(GA[i]) * v); }
};
struct EpiGateB {
    bf16* TMP; const bf16* GB;
    __device__ __forceinline__ void operator()(int r, int c, float v, float) const { const size_t i = (size_t)r * 2048 + c; TMP[i] = f2bf(bf2f(TMP[i]) + bf2f(GB[i]) * v); }
};
struct EpiRes {
    const float* X; float* H; bf16* HB;
    __device__ __forceinline__ void operator()(int r, int c, float v, float) const { const size_t i = (size_t)r * 2048 + c; const float h = X[i] + v; H[i] = h; HB[i] = f2bf(h); }
};
struct EpiSwiglu {
    const float* HST; bf16* FFo;
    __device__ __forceinline__ void operator()(int r, int c, float g, float u) const {
        float ss = 0.f;
        for (int j = 0; j < 32; ++j) ss += HST[(size_t)r * 32 + j];
        const float rs = rsqrtf(ss * (1.f / D) + EPS);
        const float gg = g * rs, uu = u * rs;
        FFo[(size_t)r * FF + c] = f2bf(gg * sigmoidf(gg) * uu);
    }
};
struct EpiRes2 {
    float* H;
    __device__ __forceinline__ void operator()(int r, int c, float v, float) const { const size_t i = (size_t)r * 2048 + c; H[i] = H[i] + v; }
};

__device__ __forceinline__ void rows_xn(const float* x, const float* g, bf16* XN, int gw, int ngw, int lane) {
    for (int m = gw; m < M; m += ngw) {
        const f32x4* xr = (const f32x4*)(x + (size_t)m * D) + lane;
        f32x4 v[8]; float s = 0.f;
#pragma unroll
        for (int j = 0; j < 8; ++j) { v[j] = xr[64 * j]; s += v[j].x * v[j].x + v[j].y * v[j].y + v[j].z * v[j].z + v[j].w * v[j].w; }
        const float rs = rsqrtf(wave_sum(s) * (1.f / D) + EPS);
        u32x2* o = (u32x2*)(XN + (size_t)m * D) + lane;
#pragma unroll
        for (int j = 0; j < 8; ++j) {
            const f32x4 gg = ((const f32x4*)g)[lane + 64 * j];
            u32x2 w; w.x = (unsigned)f2bf(v[j].x * rs * gg.x) | ((unsigned)f2bf(v[j].y * rs * gg.y) << 16);
            w.y = (unsigned)f2bf(v[j].z * rs * gg.z) | ((unsigned)f2bf(v[j].w * rs * gg.w) << 16);
            o[64 * j] = w;
        }
    }
}
__device__ __forceinline__ void rows_cn(const float* CKR, const float* g, bf16* CN, int gw, int ngw, int lane) {
    for (int m = gw; m < M; m += ngw) {
        const f32x4* xr = (const f32x4*)(CKR + (size_t)m * CL) + lane;
        f32x4 v[2]; float s = 0.f;
#pragma unroll
        for (int j = 0; j < 2; ++j) { v[j] = xr[64 * j]; s += v[j].x * v[j].x + v[j].y * v[j].y + v[j].z * v[j].z + v[j].w * v[j].w; }
        const float rs = rsqrtf(wave_sum(s) * (1.f / CL) + EPS);
        u32x2* o = (u32x2*)(CN + (size_t)m * CL) + lane;
#pragma unroll
        for (int j = 0; j < 2; ++j) {
            const f32x4 gg = ((const f32x4*)g)[lane + 64 * j];
            u32x2 w; w.x = (unsigned)f2bf(v[j].x * rs * gg.x) | ((unsigned)f2bf(v[j].y * rs * gg.y) << 16);
            w.y = (unsigned)f2bf(v[j].z * rs * gg.z) | ((unsigned)f2bf(v[j].w * rs * gg.w) << 16);
            o[64 * j] = w;
        }
    }
}
__device__ __forceinline__ void rows_vst(const bf16* V, float* VST, int gw, int ngw, int lane) {
    for (int m = gw; m < M; m += ngw) {
        const int j = lane >> 1, hf = lane & 1;
        const u32x4* p = (const u32x4*)(V + (size_t)m * D + j * 64 + hf * 32);
        float s = 0.f, q = 0.f;
#pragma unroll
        for (int i = 0; i < 4; ++i) { const u32x4 w = p[i]; const unsigned ww[4] = {w.x, w.y, w.z, w.w};
#pragma unroll
            for (int e = 0; e < 4; ++e) { const float a = __uint_as_float(ww[e] << 16), b = __uint_as_float(ww[e] & 0xffff0000u); s += a + b; q += a * a + b * b; } }
        s += __shfl_xor(s, 1); q += __shfl_xor(q, 1);
        if (hf == 0) { VST[((size_t)m * 32 + j) * 2] = s; VST[((size_t)m * 32 + j) * 2 + 1] = q; }
    }
}
__device__ __forceinline__ void rows_hst(const float* H, float* HST, int gw, int ngw, int lane) {
    for (int m = gw; m < M; m += ngw) {
        const int j = lane >> 1, hf = lane & 1;
        const f32x4* p = (const f32x4*)(H + (size_t)m * D + j * 64 + hf * 32);
        float q = 0.f;
#pragma unroll
        for (int i = 0; i < 8; ++i) { const f32x4 w = p[i]; q += w.x * w.x + w.y * w.y + w.z * w.z + w.w * w.w; }
        q += __shfl_xor(q, 1);
        if (hf == 0) HST[(size_t)m * 32 + j] = q;
    }
}
__device__ __forceinline__ void rows_final(float* H, const float* g, int gw, int ngw, int lane) {
    for (int m = gw; m < M; m += ngw) {
        f32x4* xr = (f32x4*)(H + (size_t)m * D) + lane;
        f32x4 v[8]; float s = 0.f;
#pragma unroll
        for (int j = 0; j < 8; ++j) { v[j] = xr[64 * j]; s += v[j].x * v[j].x + v[j].y * v[j].y + v[j].z * v[j].z + v[j].w * v[j].w; }
        const float rs = rsqrtf(wave_sum(s) * (1.f / D) + EPS);
#pragma unroll
        for (int j = 0; j < 8; ++j) { const f32x4 gg = ((const f32x4*)g)[lane + 64 * j]; xr[64 * j] = v[j] * rs * gg; }
    }
}

__device__ __forceinline__ void naive_gating(float* lds, bf16* U, const bf16* V, const float* VST, const float* ln_g, const float* ln_b,
                                             const float* w_s, const float* b_s, int vb, int nb) {
    float* Wt = lds; float* vn = lds + 128 * 128; float* mr = vn + 128 * 64;
    const int tid = threadIdx.x;
    for (int unit = vb; unit < 2 * 32 * 8 * 4; unit += nb) {
        const int cq = unit & 3, g = (unit >> 2) & 7, n = (unit >> 5) & 31, b = unit >> 10;
        const int row0 = b * SEQ + n * 128, ch0 = g * 256 + cq * 64;
        __syncthreads();
        if (tid < 128) {
            float s = 0.f, q = 0.f;
            for (int j = 0; j < 32; ++j) { s += VST[((size_t)(row0 + tid) * 32 + j) * 2]; q += VST[((size_t)(row0 + tid) * 32 + j) * 2 + 1]; }
            const float mean = s * (1.f / D); const float var = q * (1.f / D) - mean * mean;
            mr[tid * 2] = mean; mr[tid * 2 + 1] = rsqrtf(fmaxf(var, 0.f) + EPS);
        }
        for (int i = tid; i < 128 * 128; i += NTHREADS) { const int p = i >> 7, q = i & 127; Wt[q * 128 + p] = ((q >> 6) <= (p >> 6)) ? w_s[(size_t)g * 16384 + p * 128 + q] : 0.f; }
        __syncthreads();
        for (int i = tid; i < 128 * 64; i += NTHREADS) { const int q = i >> 6, c = i & 63;
            vn[i] = (bf2f(V[(size_t)(row0 + q) * D + ch0 + c]) - mr[q * 2]) * mr[q * 2 + 1] * ln_g[ch0 + c] + ln_b[ch0 + c]; }
        __syncthreads();
        const int c = tid & 63, pg = tid >> 6;
        float acc[16];
#pragma unroll
        for (int i = 0; i < 16; ++i) acc[i] = 0.f;
        for (int q = 0; q < 128; ++q) {
            const float x = vn[q * 64 + c];
#pragma unroll
            for (int i4 = 0; i4 < 4; ++i4) { const f32x4 w = *(const f32x4*)(Wt + q * 128 + pg * 16 + i4 * 4);
                acc[i4 * 4 + 0] += w.x * x; acc[i4 * 4 + 1] += w.y * x; acc[i4 * 4 + 2] += w.z * x; acc[i4 * 4 + 3] += w.w * x; }
        }
#pragma unroll
        for (int i = 0; i < 16; ++i) { const int p = pg * 16 + i; const size_t idx = (size_t)(row0 + p) * D + ch0 + c;
            U[idx] = f2bf(bf2f(U[idx]) * (acc[i] + b_s[g * 128 + p])); }
    }
}

__device__ __forceinline__ void naive_scores(float* lds, const bf16* QI, const bf16* KI, const float* WI, float* SC, int vb, int nb) {
    float* qs = lds;
    float* ws = lds + 1024;
    const int tid = threadIdx.x;
    for (int t = vb; t < M; t += nb) {
        const int b = t / SEQ, pos = t % SEQ, nadm = ((pos >> 6) + 1) * 64;
        __syncthreads();
        for (int i = tid; i < 1024; i += NTHREADS) qs[i] = bf2f(QI[(size_t)t * 1024 + i]);
        if (tid < 16) ws[tid] = WI[(size_t)t * 16 + tid] * 0.25f;
        __syncthreads();
        float* out = SC + sc_off(b, pos);
        for (int s = tid; s < nadm; s += NTHREADS) {
            float k[64];
            const u32x4* kp = (const u32x4*)(KI + (size_t)(b * SEQ + s) * 64);
#pragma unroll
            for (int i = 0; i < 8; ++i) { const u32x4 w = kp[i]; const unsigned ww[4] = {w.x, w.y, w.z, w.w};
#pragma unroll
                for (int e = 0; e < 4; ++e) { k[i * 8 + e * 2] = __uint_as_float(ww[e] << 16); k[i * 8 + e * 2 + 1] = __uint_as_float(ww[e] & 0xffff0000u); } }
            float sc = 0.f;
            for (int h = 0; h < 16; ++h) {
                float l = 0.f;
#pragma unroll
                for (int d = 0; d < 64; ++d) l += qs[h * 64 + d] * k[d];
                sc += ws[h] * fmaxf(l * 0.125f, 0.f);
            }
            out[s] = sc;
        }
    }
}

__device__ __forceinline__ unsigned fkey(float f) { const unsigned u = __float_as_uint(f + 0.0f); return (u & 0x80000000u) ? ~u : (u | 0x80000000u); }
__device__ __forceinline__ void topk_rows(const float* SC, int* SEL, int gw, int ngw, int lane) {
    for (int t = gw; t < M; t += ngw) {
        const int b = t / SEQ, pos = t % SEQ, nadm = ((pos >> 6) + 1) * 64;
        int* sel = SEL + (size_t)t * TOPK;
        if (nadm <= TOPK) { for (int i = lane; i < nadm; i += 64) sel[i] = i; continue; }
        const float* sc = SC + sc_off(b, pos);
        const int nj = nadm >> 6;
        unsigned key[64];
#pragma unroll
        for (int j = 0; j < 64; ++j) key[j] = (j < nj) ? fkey(sc[j * 64 + lane]) : 0u;
        unsigned prefix = 0u;
        for (int bit = 31; bit >= 0; --bit) {
            const unsigned cand = prefix | (1u << bit);
            int cnt = 0;
#pragma unroll
            for (int j4 = 0; j4 < 16; ++j4) {
                if (j4 * 4 < nj) {
#pragma unroll
                    for (int jj = 0; jj < 4; ++jj) cnt += __builtin_popcountll(__ballot(key[j4 * 4 + jj] >= cand));
                }
            }
            if (cnt >= TOPK) prefix = cand;
        }
        int cgt = 0;
#pragma unroll
        for (int j4 = 0; j4 < 16; ++j4) {
            if (j4 * 4 < nj) {
#pragma unroll
                for (int jj = 0; jj < 4; ++jj) cgt += __builtin_popcountll(__ballot(key[j4 * 4 + jj] > prefix));
            }
        }
        int need = TOPK - cgt, obase = 0;
        const unsigned long long lt = (1ull << lane) - 1ull;
#pragma unroll
        for (int j = 0; j < 64; ++j) {
            if (j < nj) {
                const bool gt = key[j] > prefix, eq = key[j] == prefix;
                const unsigned long long me = __ballot(eq);
                const int erank = __builtin_popcountll(me & lt);
                const bool take = gt || (eq && erank < need);
                const unsigned long long ms = __ballot(take);
                if (take) sel[obase + __builtin_popcountll(ms & lt)] = j * 64 + lane;
                obase += __builtin_popcountll(ms);
                const int ne = __builtin_popcountll(me); need -= (ne < need ? ne : need);
            }
        }
    }
}

__device__ __forceinline__ void naive_qlat(float* lds, const bf16* Q, const float* w_uk, bf16* QL, int vb, int nb) {
    float* qs = lds;
    const int tid = threadIdx.x;
    for (int unit = vb; unit < (M / 32) * NH; unit += nb) {
        const int h = unit % NH, t0 = (unit / NH) * 32;
        __syncthreads();
        for (int i = tid; i < 32 * 128; i += NTHREADS) qs[i] = bf2f(Q[(size_t)(t0 + (i >> 7)) * D + h * 128 + (i & 127)]);
        __syncthreads();
        float acc[32];
#pragma unroll
        for (int i = 0; i < 32; ++i) acc[i] = 0.f;
        const f32x4* wr = (const f32x4*)(w_uk + (size_t)tid * 2048 + h * 128);
        for (int d4 = 0; d4 < 32; ++d4) {
            const f32x4 w = wr[d4];
#pragma unroll
            for (int i = 0; i < 32; ++i) { const f32x4 q = *(const f32x4*)(qs + i * 128 + d4 * 4); acc[i] += w.x * q.x + w.y * q.y + w.z * q.z + w.w * q.w; }
        }
#pragma unroll
        for (int i = 0; i < 32; ++i) QL[((size_t)(t0 + i) * NH + h) * CL + tid] = f2bf(acc[i]);
    }
}
__device__ __forceinline__ void naive_yb(float* lds, const bf16* OL, const float* w_uv, bf16* YB, int vb, int nb) {
    float* os = lds;
    const int tid = threadIdx.x, d = tid & 127, tq = tid >> 7;
    for (int unit = vb; unit < (M / 32) * NH; unit += nb) {
        const int h = unit % NH, t0 = (unit / NH) * 32;
        __syncthreads();
        for (int i = tid; i < 32 * 512; i += NTHREADS) os[i] = bf2f(OL[((size_t)(t0 + (i >> 9)) * NH + h) * CL + (i & 511)]);
        __syncthreads();
        float acc[8];
#pragma unroll
        for (int i = 0; i < 8; ++i) acc[i] = 0.f;
        for (int c = 0; c < CL; ++c) {
            const float w = w_uv[(size_t)c * 2048 + h * 128 + d];
#pragma unroll
            for (int i = 0; i < 8; ++i) acc[i] += w * os[(tq * 8 + i) * 512 + c];
        }
#pragma unroll
        for (int i = 0; i < 8; ++i) YB[(size_t)(t0 + tq * 8 + i) * D + h * 128 + d] = f2bf(acc[i]);
    }
}

__device__ __forceinline__ void naive_attn(float* lds, bf16* QL, const bf16* CN, const int* SEL, int vb, int nb) {
    float* qs = lds;
    float* att = lds + 16 * 512;
    int* sl = (int*)(att + 16 * 256);
    const int tid = threadIdx.x, lane = tid & 63, wid = tid >> 6;
    for (int t = vb; t < M; t += nb) {
        const int b = t / SEQ, pos = t % SEQ, nadm = ((pos >> 6) + 1) * 64, nsel = nadm < TOPK ? nadm : TOPK;
        __syncthreads();
        for (int i = tid; i < 16 * 512; i += NTHREADS) qs[i] = bf2f(QL[(size_t)t * 8192 + i]);
        if (tid < 256) sl[tid] = (tid < nsel) ? SEL[(size_t)t * TOPK + tid] : 0;
        __syncthreads();
        {
            const int k = tid & 255, hh = tid >> 8;
            float a[8];
#pragma unroll
            for (int i = 0; i < 8; ++i) a[i] = 0.f;
            if (k < nsel) {
                const u32x4* cp = (const u32x4*)(CN + (size_t)(b * SEQ + sl[k]) * CL);
                for (int c8 = 0; c8 < 64; ++c8) {
                    const u32x4 w = cp[c8]; float cv[8];
                    cv[0] = __uint_as_float(w.x << 16); cv[1] = __uint_as_float(w.x & 0xffff0000u); cv[2] = __uint_as_float(w.y << 16); cv[3] = __uint_as_float(w.y & 0xffff0000u);
                    cv[4] = __uint_as_float(w.z << 16); cv[5] = __uint_as_float(w.z & 0xffff0000u); cv[6] = __uint_as_float(w.w << 16); cv[7] = __uint_as_float(w.w & 0xffff0000u);
#pragma unroll
                    for (int i = 0; i < 8; ++i) { const float* qh = qs + (hh * 8 + i) * 512 + c8 * 8;
                        const f32x4 q0 = *(const f32x4*)qh, q1 = *(const f32x4*)(qh + 4);
                        a[i] += q0.x * cv[0] + q0.y * cv[1] + q0.z * cv[2] + q0.w * cv[3] + q1.x * cv[4] + q1.y * cv[5] + q1.z * cv[6] + q1.w * cv[7]; }
                }
            }
#pragma unroll
            for (int i = 0; i < 8; ++i) att[(hh * 8 + i) * 256 + k] = (k < nsel) ? a[i] * 0.08838834764831845f : -INFINITY;
        }
        __syncthreads();
        {
#pragma unroll
            for (int hi = 0; hi < 2; ++hi) { float* row = att + (wid * 2 + hi) * 256;
                float v[4]; float mx = -INFINITY;
#pragma unroll
                for (int i = 0; i < 4; ++i) { v[i] = row[lane + 64 * i]; mx = fmaxf(mx, v[i]); }
                mx = wave_max(mx); float s = 0.f;
#pragma unroll
                for (int i = 0; i < 4; ++i) { v[i] = __expf(v[i] - mx); s += v[i]; }
                s = wave_sum(s); const float inv = 1.f / s;
#pragma unroll
                for (int i = 0; i < 4; ++i) row[lane + 64 * i] = v[i] * inv; }
        }
        __syncthreads();
        {
            float o[16];
#pragma unroll
            for (int i = 0; i < 16; ++i) o[i] = 0.f;
            for (int k = 0; k < nsel; ++k) {
                const float cv = bf2f(CN[(size_t)(b * SEQ + sl[k]) * CL + tid]);
#pragma unroll
                for (int h = 0; h < 16; ++h) o[h] += att[h * 256 + k] * cv;
            }
#pragma unroll
            for (int h = 0; h < 16; ++h) QL[(size_t)t * 8192 + h * 512 + tid] = f2bf(o[h]);
        }
    }
}

template <int PH> __global__ void __launch_bounds__(NTHREADS, 2) mk_fwd(Args a) {
    extern __shared__ __attribute__((aligned(16))) unsigned char lds_raw[];
    float* lds = (float*)lds_raw;
    const int tid = threadIdx.x, lane = tid & 63, wid = tid >> 6;
    const int G = gridDim.x, vb = blockIdx.x;
    const int gw = vb * NWAVES + wid, ngw = G * NWAVES;
    unsigned char* ws = a.ws;
    const float* x = a.in[0]; const float* norm1_g = a.in[1]; const float* w_in = a.in[2]; const float* a_ln_g = a.in[3]; const float* a_ln_b = a.in[4];
    const float* a_w_s = a.in[5]; const float* a_b_s = a.in[6]; const float* kv_g = a.in[7]; const float* w_uk = a.in[8]; const float* w_uv = a.in[9];
    const float* w_oa = a.in[10]; const float* w_ob = a.in[11]; const float* w_out = a.in[12]; const float* norm2_g = a.in[13];
    const float* w_fg = a.in[14]; const float* w_fu = a.in[15]; const float* w_fd = a.in[16]; const float* final_g = a.in[17];
    float* VST = (float*)(ws + WS_VST); float* HST = (float*)(ws + WS_HST); float* WI = (float*)(ws + WS_WI);
    bf16* KI = (bf16*)(ws + WS_KI); int* SEL = (int*)(ws + WS_SEL); bf16* CN = (bf16*)(ws + WS_CN); float* CKR = (float*)(ws + WS_CKR);
    bf16* QI = (bf16*)(ws + WS_QI); bf16* XN = (bf16*)(ws + WS_XN); float* SC = (float*)(ws + WS_SC); bf16* QL = (bf16*)(ws + WS_QL);
    bf16* U = (bf16*)(ws + WS_U); bf16* V = (bf16*)(ws + WS_V); bf16* Q = (bf16*)(ws + WS_Q); bf16* GA = (bf16*)(ws + WS_GA); bf16* GB = (bf16*)(ws + WS_GB);
    bf16* HB = (bf16*)(ws + WS_HB); bf16* FFB = (bf16*)(ws + WS_FF); bf16* YB = Q;
    float* H = a.out;

    {
        switch (PH) {
        case 0: rows_xn(x, norm1_g, XN, gw, ngw, lane); break;
        case 1: { EpiProj e{U, V, Q, QI, KI, GA, GB, CKR, WI}; naive_gemm<false>(lds, XN, D, w_in, nullptr, NIN, nullptr, M, NIN, D, e, vb, G); } break;
        case 2: rows_cn(CKR, kv_g, CN, gw, ngw, lane); rows_vst(V, VST, gw, ngw, lane); naive_scores(lds, QI, KI, WI, SC, vb, G); break;
        case 3: naive_gating(lds, U, V, VST, a_ln_g, a_ln_b, a_w_s, a_b_s, vb, G); topk_rows(SC, SEL, gw, ngw, lane); break;
        case 4: { EpiGateA e{GA}; naive_gemm<false>(lds, U, D, w_oa, nullptr, D, nullptr, M, D, D, e, vb, G); } break;
        case 5: naive_qlat(lds, Q, w_uk, QL, vb, G); break;
        case 6: naive_attn(lds, QL, CN, SEL, vb, G); break;
        case 7: naive_yb(lds, QL, w_uv, YB, vb, G); break;
        case 8: { EpiGateB e{GA, GB}; naive_gemm<false>(lds, YB, D, w_ob, nullptr, D, nullptr, M, D, D, e, vb, G); } break;
        case 9: { EpiRes e{x, H, HB}; naive_gemm<false>(lds, GA, D, w_out, nullptr, D, nullptr, M, D, D, e, vb, G); } break;
        case 10: rows_hst(H, HST, gw, ngw, lane); break;
        case 11: { EpiSwiglu e{HST, FFB}; naive_gemm<true>(lds, HB, D, w_fg, w_fu, FF, norm2_g, M, FF, D, e, vb, G); } break;
        case 12: { EpiRes2 e{H}; naive_gemm<false>(lds, FFB, FF, w_fd, nullptr, D, nullptr, M, D, FF, e, vb, G); } break;
        case 13: rows_final(H, final_g, gw, ngw, lane); break;
        default: break;
        }
    }
}

constexpr int N_PHASES = 14;

extern "C" void kernel_launch(void* const* d_in, const int* in_sizes, int n_in, void* d_out, int out_size, void* d_ws, size_t ws_size, hipStream_t stream) {
    static int grid = 0;
    if (grid == 0) {
        if (n_in != 18 || out_size != M * D || ws_size < WS_END) { fprintf(stderr, "kernel_launch: unexpected shapes n_in %d out %d ws %zu\n", n_in, out_size, ws_size); grid = -1; return; }
#define SETA(P) (void)hipFuncSetAttribute((const void*)mk_fwd<P>, hipFuncAttributeMaxDynamicSharedMemorySize, LDS_BYTES)
        SETA(0); SETA(1); SETA(2); SETA(3); SETA(4); SETA(5); SETA(6); SETA(7); SETA(8); SETA(9); SETA(10); SETA(11); SETA(12); SETA(13);
        int dev = 0, cus = 0;
        (void)hipGetDevice(&dev); (void)hipDeviceGetAttribute(&cus, hipDeviceAttributeMultiprocessorCount, dev);
        grid = cus > 0 ? cus : 256;
    }
    if (grid < 0) return;
    Args a{};
    for (int i = 0; i < 18; ++i) a.in[i] = (const float*)d_in[i];
    a.out = (float*)d_out; a.ws = (unsigned char*)d_ws;
#define LAUNCH(P) hipLaunchKernelGGL(mk_fwd<P>, dim3(grid), dim3(NTHREADS), LDS_BYTES, stream, a)
    LAUNCH(0); LAUNCH(1); LAUNCH(2); LAUNCH(3); LAUNCH(4); LAUNCH(5); LAUNCH(6); LAUNCH(7); LAUNCH(8); LAUNCH(9); LAUNCH(10); LAUNCH(11); LAUNCH(12); LAUNCH(13);
}
```

```cpp
#include <hip/hip_runtime.h>
#include <cstdio>
#include <cstdint>

constexpr int BATCH = 2, SEQ = 4096, D = 2048, M = BATCH * SEQ, NIN = 11856, FF = 5632;
constexpr int CL = 512, NH = 16, HD = 128, IH = 16, IDM = 64, TOPK = 256, CHUNK = 64;
constexpr int NINP = 12032;
constexpr float EPS = 1e-6f;
constexpr int NTHREADS = 512, NWAVES = 8;

#define LAS __attribute__((address_space(3)))
#define GAS __attribute__((address_space(1)))
typedef unsigned short bf16;
typedef float f32x4 __attribute__((ext_vector_type(4)));
typedef float f32x2 __attribute__((ext_vector_type(2)));
typedef unsigned u32x4 __attribute__((ext_vector_type(4)));
typedef unsigned u32x2 __attribute__((ext_vector_type(2)));

__device__ __forceinline__ float bf2f(bf16 v) { return __uint_as_float(((unsigned)v) << 16); }
__device__ __forceinline__ bf16 f2bf(float f) { unsigned u = __float_as_uint(f); return (bf16)((u + 0x7fffu + ((u >> 16) & 1u)) >> 16); }
__device__ __forceinline__ unsigned pk2(float lo, float hi) { return (unsigned)f2bf(lo) | ((unsigned)f2bf(hi) << 16); }
__device__ __forceinline__ float bflo(unsigned w) { return __uint_as_float(w << 16); }
__device__ __forceinline__ float bfhi(unsigned w) { return __uint_as_float(w & 0xffff0000u); }
__device__ __forceinline__ float wave_sum(float v) {
#pragma unroll
    for (int o = 1; o < 64; o <<= 1) v += __shfl_xor(v, o);
    return v;
}
__device__ __forceinline__ float wave_max(float v) {
#pragma unroll
    for (int o = 1; o < 64; o <<= 1) v = fmaxf(v, __shfl_xor(v, o));
    return v;
}
__device__ __forceinline__ float gelu_tanh(float x) {
    const float u2 = 1.5957691216057308f * (x + 0.044715f * x * x * x);
    return x * __builtin_amdgcn_rcpf(1.f + __expf(-u2));
}
__device__ __forceinline__ float sigmoidf(float x) { return __builtin_amdgcn_rcpf(1.f + __expf(-x)); }

constexpr size_t MiB = 1u << 20;
constexpr size_t WS_CTL = 0, CTL_ZERO_BYTES = 64 * 1024;
constexpr size_t WS_VST = 1 * MiB;
constexpr size_t WS_HST = 3 * MiB;
constexpr size_t WS_WI = 4 * MiB;
constexpr size_t WS_KI = 5 * MiB;
constexpr size_t WS_SEL = 6 * MiB;
constexpr size_t WS_CN = 14 * MiB;
constexpr size_t WS_CKR = 22 * MiB;
constexpr size_t WS_QI = 38 * MiB;
constexpr size_t WS_WUK = 54 * MiB;
constexpr size_t WS_WUV = 56 * MiB;
constexpr size_t WS_WOA = 60 * MiB;
constexpr size_t WS_WOB = 68 * MiB;
constexpr size_t WS_WOUT = 76 * MiB;
constexpr size_t WS_WIN = 86 * MiB;
constexpr size_t WS_XN = 133 * MiB;
constexpr size_t WS_SC = 101 * MiB;
constexpr size_t WS_QL = 102 * MiB;
constexpr size_t WS_U = 166 * MiB;
constexpr size_t WS_V = 198 * MiB;
constexpr size_t WS_Q = 230 * MiB;
constexpr size_t WS_GA = 262 * MiB;
constexpr size_t WS_GB = 294 * MiB;
constexpr size_t WS_WGU = 86 * MiB;
constexpr size_t WS_WD = 130 * MiB;
constexpr size_t WS_HB = 152 * MiB;
constexpr size_t WS_FF = 230 * MiB;
constexpr size_t WS_END = 326 * MiB;

constexpr int RING_BYTES = 131072;
constexpr int LDSCTL_OFF = RING_BYTES, MISC_OFF = LDSCTL_OFF + 320;
constexpr int LDS_BYTES = 147456;
constexpr size_t SC_PER_BATCH = 8519680;

__device__ __forceinline__ size_t sc_off(int b, int pos) {
    const int c = pos >> 6, r = pos & 63;
    return (size_t)b * SC_PER_BATCH + (size_t)2048 * c * (c + 1) + (size_t)r * 64 * (c + 1);
}
namespace pg8 {
#define PG8_LAS __attribute__((address_space(3)))
typedef unsigned short bf16_t;
typedef short bf16x8 __attribute__((ext_vector_type(8)));
typedef float f32x4 __attribute__((ext_vector_type(4)));
typedef unsigned u32x4 __attribute__((ext_vector_type(4)));
constexpr int BM = 256, BK = 64, HALF = 128, HTB = HALF * BK * 2  , STAGE_BYTES = 8 * HTB, NXCD = 8, WGM = 8;

__host__ __device__ __forceinline__ int lds_byte(int r, int c) { const int st = (r >> 4) * 2 + (c >> 5), rr = r & 15, cc = c & 31, ob = rr * 64 + cc * 2; return st * 1024 + (ob ^ (((ob >> 9) & 1) << 5)); }
__host__ __device__ __forceinline__ void stage_rc(int b, int& R, int& C) { const int st = b / 1024, sb = b % 1024, swz = sb ^ (((sb >> 9) & 1) << 5); R = (st >> 1) * 16 + swz / 64; C = (st & 1) * 32 + (swz % 64) / 2; }
__host__ __device__ __forceinline__ int perm32(int rho) { const int n = rho >> 4, i = rho & 15; return 8 * (i >> 2) + 4 * n + (i & 3); }

struct Unit { int pm, pn, h; };
struct Gemm { const bf16_t* A; const bf16_t* Bt; int lda, ldb, K; };

struct StaticOrder {
    int nM, nN, nwg, G, c;
    __host__ __device__ void init(int M_, int N_, int G_, int c_) { nM = M_ / BM; nN = N_ / BM; nwg = nM * nN; G = G_; c = c_; }
    __host__ __device__ bool next(int i, Unit& u) const {
        const long L = (long)i * G + c; if (L >= nwg) return false;
        int wgid = (int)L; { const int q = nwg / NXCD, r = nwg % NXCD, xcd = wgid % NXCD, off = wgid / NXCD; wgid = (xcd < r ? xcd * (q + 1) : r * (q + 1) + (xcd - r) * q) + off; }
        const int nig = WGM * nN, gid = wgid / nig, fm = gid * WGM, gsz = (nM - fm) < WGM ? (nM - fm) : WGM;
        u.pm = fm + ((wgid % nig) % gsz); u.pn = (wgid % nig) / gsz; u.h = 0; return true;
    }
    __device__ __forceinline__ void ptrs(const Unit& u, const Gemm& g, const char*& a, const char*& b) const {
        a = (const char*)g.A + (size_t)u.pm * BM * g.lda * 2; b = (const char*)g.Bt + (size_t)u.pn * BM * g.ldb * 2; }
    __device__ __forceinline__ void a_ready(const Unit&) const {}
    __device__ __forceinline__ void done(const Unit&) const {}
};
struct HeadOrderQ {
    int G, c;
    __device__ bool next(int i, Unit& u) const { const int L = i * G + c; if (L >= 1024) return false; u.h = L >> 6; u.pn = (L >> 5) & 1; u.pm = L & 31; return true; }
    __device__ __forceinline__ void ptrs(const Unit& u, const Gemm& g, const char*& a, const char*& b) const {
        a = (const char*)g.A + ((size_t)u.pm * BM * g.lda + u.h * 128) * 2; b = (const char*)g.Bt + (size_t)(u.h * 512 + u.pn * BM) * g.ldb * 2; }
    __device__ __forceinline__ void a_ready(const Unit&) const {}
    __device__ __forceinline__ void done(const Unit&) const {}
};
struct PairOrderYB {
    int G, c;
    __device__ bool next(int i, Unit& u) const { const int L = i * G + c; if (L >= 256) return false; u.h = 0; u.pn = L >> 5; u.pm = L & 31; return true; }
    __device__ __forceinline__ void ptrs(const Unit& u, const Gemm& g, const char*& a, const char*& b) const {
        a = (const char*)g.A + ((size_t)u.pm * BM * g.lda + u.pn * 1024) * 2; b = (const char*)g.Bt + (size_t)(u.pn * BM) * g.ldb * 2; }
    __device__ __forceinline__ void a_ready(const Unit&) const {}
    __device__ __forceinline__ void done(const Unit&) const {}
};

typedef __bf16 bf16x2_t __attribute__((ext_vector_type(2)));
typedef float f32x2c __attribute__((ext_vector_type(2)));
__device__ __forceinline__ unsigned cvt_pk_bf16(float lo, float hi) { const f32x2c v = {lo, hi}; const bf16x2_t b = __builtin_convertvector(v, bf16x2_t); return __builtin_bit_cast(unsigned, b); }
__device__ __forceinline__ u32x4 pack8(const f32x4 v0, const f32x4 v1) { u32x4 w; w.x = cvt_pk_bf16(v0[0], v0[1]); w.y = cvt_pk_bf16(v0[2], v0[3]); w.z = cvt_pk_bf16(v1[0], v1[1]); w.w = cvt_pk_bf16(v1[2], v1[3]); return w; }
__device__ __forceinline__ float gelu1(float x) { const float u2 = 1.5957691216057308f * (x + 0.044715f * x * x * x); return x * __builtin_amdgcn_rcpf(1.f + __expf(-u2)); }
__device__ __forceinline__ float sigm1(float x) { return __builtin_amdgcn_rcpf(1.f + __expf(-x)); }
template <int ACT> __device__ __forceinline__ f32x4 act4(f32x4 v) {
    if (ACT == 1) { v[0] = gelu1(v[0]); v[1] = gelu1(v[1]); v[2] = gelu1(v[2]); v[3] = gelu1(v[3]); }
    if (ACT == 2) { v[0] = sigm1(v[0]); v[1] = sigm1(v[1]); v[2] = sigm1(v[2]); v[3] = sigm1(v[3]); }
    return v;
}
template <int ACT> __device__ __forceinline__ void store_tile_bf16(const f32x4 (&acc)[2][2][4][2], bf16_t* base, int ld, int row0) {
#pragma unroll
    for (int ai = 0; ai < 2; ++ai)
#pragma unroll
        for (int m = 0; m < 4; ++m) { bf16_t* rowp = base + (size_t)(row0 + ai * HALF + m * 16) * ld;
#pragma unroll
            for (int bj = 0; bj < 2; ++bj) *(u32x4*)(rowp + bj * HALF) = pack8(act4<ACT>(acc[ai][bj][m][0]), act4<ACT>(acc[ai][bj][m][1])); }
}

struct EpiProjF {
    static constexpr bool PERM = true, AFTER_DRAIN = false;
    unsigned char* ws;
    __device__ __forceinline__ void operator()(const f32x4 (&acc)[2][2][4][2], const Unit& u, int wr, int wc, int fr, int fq) const {
        const int pn = u.pn, row0 = u.pm * BM + wr * 64 + fr, c8 = wc * 32 + 8 * fq;
        if (pn < 8) store_tile_bf16<1>(acc, (bf16_t*)(ws + WS_U) + pn * 256 + c8, 2048, row0);
        else if (pn < 16) {
            bf16_t* base = (bf16_t*)(ws + WS_V) + (pn - 8) * 256 + c8; float* VST = (float*)(ws + WS_VST);
#pragma unroll
            for (int ai = 0; ai < 2; ++ai)
#pragma unroll
                for (int m = 0; m < 4; ++m) { const int row = row0 + ai * HALF + m * 16; float s = 0.f, q = 0.f;
#pragma unroll
                    for (int bj = 0; bj < 2; ++bj) { const f32x4 v0 = act4<1>(acc[ai][bj][m][0]), v1 = act4<1>(acc[ai][bj][m][1]);
                        s += (v0[0] + v0[1]) + (v0[2] + v0[3]) + (v1[0] + v1[1]) + (v1[2] + v1[3]);
                        q += (v0[0] * v0[0] + v0[1] * v0[1]) + (v0[2] * v0[2] + v0[3] * v0[3]) + (v1[0] * v1[0] + v1[1] * v1[1]) + (v1[2] * v1[2] + v1[3] * v1[3]);
                        *(u32x4*)(base + (size_t)row * 2048 + bj * HALF) = pack8(v0, v1); }
                    s += __shfl_xor(s, 16); s += __shfl_xor(s, 32); q += __shfl_xor(q, 16); q += __shfl_xor(q, 32);
                    if (fq == 0) *(f32x2*)(VST + ((size_t)row * 32 + (pn - 8) * 4 + wc) * 2) = (f32x2){s, q};
                    asm volatile("" ::: "memory"); }
        }
        else if (pn < 24) store_tile_bf16<0>(acc, (bf16_t*)(ws + WS_Q) + (pn - 16) * 256 + c8, 2048, row0);
        else if (pn < 26) {
            float* base = (float*)(ws + WS_CKR) + (pn - 24) * 256 + c8;
#pragma unroll
            for (int ai = 0; ai < 2; ++ai)
#pragma unroll
                for (int m = 0; m < 4; ++m) { float* rowp = base + (size_t)(row0 + ai * HALF + m * 16) * 512;
#pragma unroll
                    for (int bj = 0; bj < 2; ++bj) { *(f32x4*)(rowp + bj * HALF) = acc[ai][bj][m][0]; *(f32x4*)(rowp + bj * HALF + 4) = acc[ai][bj][m][1]; } }
        }
        else if (pn < 30) store_tile_bf16<0>(acc, (bf16_t*)(ws + WS_QI) + (pn - 26) * 256 + c8, 1024, row0);
        else if (pn == 30) {
            bf16_t* KI = (bf16_t*)(ws + WS_KI); float* WI = (float*)(ws + WS_WI);
#pragma unroll
            for (int ai = 0; ai < 2; ++ai)
#pragma unroll
                for (int m = 0; m < 4; ++m) { const size_t row = row0 + ai * HALF + m * 16;
                    if (c8 < 64) *(u32x4*)(KI + row * 64 + c8) = pack8(acc[ai][0][m][0], acc[ai][0][m][1]);
                    else if (c8 < 80) { *(f32x4*)(WI + row * 16 + (c8 - 64)) = acc[ai][0][m][0]; *(f32x4*)(WI + row * 16 + (c8 - 64) + 4) = acc[ai][0][m][1]; } }
        }
        else store_tile_bf16<2>(acc, (bf16_t*)(ws + WS_GA) + (size_t)(pn >= 39 ? (WS_GB - WS_GA) / 2 : 0) + ((pn - 31) & 7) * 256 + c8, 2048, row0);
    }
};
struct EpiQlatF {
    static constexpr bool PERM = true, AFTER_DRAIN = false;
    bf16_t* QL;
    __device__ __forceinline__ void operator()(const f32x4 (&acc)[2][2][4][2], const Unit& u, int wr, int wc, int fr, int fq) const {
        store_tile_bf16<0>(acc, QL + u.h * 512 + u.pn * 256 + wc * 32 + 8 * fq, 8192, u.pm * BM + wr * 64 + fr); }
};
struct EpiPlainF {
    static constexpr bool PERM = true, AFTER_DRAIN = false;
    bf16_t* O; int ld;
    __device__ __forceinline__ void operator()(const f32x4 (&acc)[2][2][4][2], const Unit& u, int wr, int wc, int fr, int fq) const {
        store_tile_bf16<0>(acc, O + u.pn * 256 + wc * 32 + 8 * fq, ld, u.pm * BM + wr * 64 + fr); }
};
__device__ __forceinline__ float blo(unsigned w) { return __uint_as_float(w << 16); }
__device__ __forceinline__ float bhi(unsigned w) { return __uint_as_float(w & 0xffff0000u); }
struct EpiGateAF {
    static constexpr bool PERM = true, AFTER_DRAIN = false;
    bf16_t* GA;
    __device__ __forceinline__ void operator()(const f32x4 (&acc)[2][2][4][2], const Unit& u, int wr, int wc, int fr, int fq) const {
        bf16_t* base = GA + u.pn * 256 + wc * 32 + 8 * fq; const int row0 = u.pm * BM + wr * 64 + fr;
#pragma unroll
        for (int ai = 0; ai < 2; ++ai)
#pragma unroll
            for (int m = 0; m < 4; ++m) { bf16_t* rowp = base + (size_t)(row0 + ai * HALF + m * 16) * 2048;
#pragma unroll
                for (int bj = 0; bj < 2; ++bj) { const u32x4 g = *(const u32x4*)(rowp + bj * HALF); const f32x4 v0 = acc[ai][bj][m][0], v1 = acc[ai][bj][m][1];
                    const f32x4 o0 = {blo(g.x) * v0[0], bhi(g.x) * v0[1], blo(g.y) * v0[2], bhi(g.y) * v0[3]}, o1 = {blo(g.z) * v1[0], bhi(g.z) * v1[1], blo(g.w) * v1[2], bhi(g.w) * v1[3]};
                    *(u32x4*)(rowp + bj * HALF) = pack8(o0, o1); } }
    }
};
struct EpiGateBF {
    static constexpr bool PERM = true, AFTER_DRAIN = false;
    bf16_t* TMP; const bf16_t* GB;
    __device__ __forceinline__ void operator()(const f32x4 (&acc)[2][2][4][2], const Unit& u, int wr, int wc, int fr, int fq) const {
        const int coff = u.pn * 256 + wc * 32 + 8 * fq, row0 = u.pm * BM + wr * 64 + fr;
#pragma unroll
        for (int ai = 0; ai < 2; ++ai)
#pragma unroll
            for (int m = 0; m < 4; ++m) { const size_t ro = (size_t)(row0 + ai * HALF + m * 16) * 2048 + coff;
#pragma unroll
                for (int bj = 0; bj < 2; ++bj) { const u32x4 g = *(const u32x4*)(GB + ro + bj * HALF), t = *(const u32x4*)(TMP + ro + bj * HALF); const f32x4 v0 = acc[ai][bj][m][0], v1 = acc[ai][bj][m][1];
                    const f32x4 o0 = {blo(t.x) + blo(g.x) * v0[0], bhi(t.x) + bhi(g.x) * v0[1], blo(t.y) + blo(g.y) * v0[2], bhi(t.y) + bhi(g.y) * v0[3]};
                    const f32x4 o1 = {blo(t.z) + blo(g.z) * v1[0], bhi(t.z) + bhi(g.z) * v1[1], blo(t.w) + blo(g.w) * v1[2], bhi(t.w) + bhi(g.w) * v1[3]};
                    *(u32x4*)(TMP + ro + bj * HALF) = pack8(o0, o1); } }
    }
};
struct EpiResF {
    static constexpr bool PERM = true, AFTER_DRAIN = false;
    const float* X; float* H; bf16_t* HB; float* HST;
    __device__ __forceinline__ void operator()(const f32x4 (&acc)[2][2][4][2], const Unit& u, int wr, int wc, int fr, int fq) const {
        const int coff = u.pn * 256 + wc * 32 + 8 * fq, row0 = u.pm * BM + wr * 64 + fr;
#pragma unroll
        for (int ai = 0; ai < 2; ++ai)
#pragma unroll
            for (int m = 0; m < 4; ++m) { const int row = row0 + ai * HALF + m * 16; const size_t ro = (size_t)row * 2048 + coff; float q = 0.f;
#pragma unroll
                for (int bj = 0; bj < 2; ++bj) { const f32x4 x0 = *(const f32x4*)(X + ro + bj * HALF), x1 = *(const f32x4*)(X + ro + bj * HALF + 4);
                    const f32x4 h0 = x0 + acc[ai][bj][m][0], h1 = x1 + acc[ai][bj][m][1];
                    *(f32x4*)(H + ro + bj * HALF) = h0; *(f32x4*)(H + ro + bj * HALF + 4) = h1; *(u32x4*)(HB + ro + bj * HALF) = pack8(h0, h1);
                    q += (h0[0] * h0[0] + h0[1] * h0[1]) + (h0[2] * h0[2] + h0[3] * h0[3]) + (h1[0] * h1[0] + h1[1] * h1[1]) + (h1[2] * h1[2] + h1[3] * h1[3]); }
                q += __shfl_xor(q, 16); q += __shfl_xor(q, 32);
                if (fq == 0) HST[(size_t)row * 32 + u.pn * 4 + wc] = q; }
    }
};
struct EpiSwigluF {
    static constexpr bool PERM = true, AFTER_DRAIN = false;
    const float* HST; bf16_t* FFo;
    __device__ __forceinline__ void operator()(const f32x4 (&acc)[2][2][4][2], const Unit& u, int wr, int wc, int fr, int fq) const {
        const int coff = u.pn * 128 + wc * 32 + 8 * fq, row0 = u.pm * BM + wr * 64 + fr;
#pragma unroll
        for (int ai = 0; ai < 2; ++ai)
#pragma unroll
            for (int m = 0; m < 4; ++m) { const int row = row0 + ai * HALF + m * 16; const f32x4* hp = (const f32x4*)(HST + (size_t)row * 32);
                f32x4 sv = hp[0];
#pragma unroll
                for (int j = 1; j < 8; ++j) sv = sv + hp[j];
                const float rs = rsqrtf(((sv[0] + sv[1]) + (sv[2] + sv[3])) * (1.f / 2048.f) + 1e-6f);
                f32x4 o0, o1;
#pragma unroll
                for (int e = 0; e < 4; ++e) { const float g0 = acc[ai][0][m][0][e] * rs, u0 = acc[ai][1][m][0][e] * rs, g1 = acc[ai][0][m][1][e] * rs, u1 = acc[ai][1][m][1][e] * rs;
                    o0[e] = g0 * sigm1(g0) * u0; o1[e] = g1 * sigm1(g1) * u1; }
                *(u32x4*)(FFo + (size_t)row * 5632 + coff) = pack8(o0, o1); }
    }
};
struct EpiRes2F {
    static constexpr bool PERM = true, AFTER_DRAIN = false;
    float* H;
    __device__ __forceinline__ void operator()(const f32x4 (&acc)[2][2][4][2], const Unit& u, int wr, int wc, int fr, int fq) const {
        const int coff = u.pn * 256 + wc * 32 + 8 * fq, row0 = u.pm * BM + wr * 64 + fr;
#pragma unroll
        for (int ai = 0; ai < 2; ++ai)
#pragma unroll
            for (int m = 0; m < 4; ++m) { float* rp = H + (size_t)(row0 + ai * HALF + m * 16) * 2048 + coff;
#pragma unroll
                for (int bj = 0; bj < 2; ++bj) { const f32x4 h0 = *(const f32x4*)(rp + bj * HALF) + acc[ai][bj][m][0], h1 = *(const f32x4*)(rp + bj * HALF + 4) + acc[ai][bj][m][1];
                    *(f32x4*)(rp + bj * HALF) = h0; *(f32x4*)(rp + bj * HALF + 4) = h1; } }
    }
};

template <class Epi, class Sched, bool ALIGN_EPI = true, bool SP2 = true>
__device__ __forceinline__ void gemm_phase(PG8_LAS unsigned char* lds, const Gemm g, const Sched& S, const Epi& E) {
    const int tid = threadIdx.x, wid = __builtin_amdgcn_readfirstlane(tid >> 6), lane = tid & 63, wr = wid >> 2, wc = wid & 3, fr = lane & 15, fq = lane >> 4;
    const int K = g.K, nt = K / BK;
    unsigned voffA[2], voffB[2];
#pragma unroll
    for (int i = 0; i < 2; ++i) { int R, C; stage_rc(tid * 16 + i * 8192, R, C); const int Rb = Epi::PERM ? ((R & ~31) + perm32(R & 31)) : R;
        voffA[i] = (unsigned)(R * g.lda + C) * 2u; voffB[i] = (unsigned)(Rb * g.ldb + C) * 2u; }
    const size_t kstep = (size_t)(BK * 2);
    const size_t hsA = (size_t)HALF * g.lda * 2, hsB = (size_t)HALF * g.ldb * 2;
    const unsigned ldsw = (unsigned)wid * 1024u;
    const int aoff = lds_byte(wr * 64 + fr, fq * 8), boff = lds_byte(wc * 32 + fr, fq * 8);
#define PG8_SA(b, h) (((b) * 2 + (h)) * HTB)
#define PG8_SB(b, h) ((4 + (b) * 2 + (h)) * HTB)
#define PG8_STAGE(bufoff, gbase, voff) do { _Pragma("unroll") for (int _i = 0; _i < 2; ++_i) \
        __builtin_amdgcn_global_load_lds((const unsigned*)((const char*)(gbase) + (voff)[_i]), (PG8_LAS unsigned*)(lds + (bufoff) + ldsw + _i * 8192), 16, 0, 0); } while (0)
#define PG8_LDA(dst, b, h) do { _Pragma("unroll") for (int m = 0; m < 4; ++m) _Pragma("unroll") for (int k = 0; k < 2; ++k) dst[m][k] = *(const PG8_LAS bf16x8*)(lds + PG8_SA(b, h) + aoff + m * 2048 + k * 1024); } while (0)
#define PG8_LDB(dst, b, h) do { _Pragma("unroll") for (int n = 0; n < 2; ++n) _Pragma("unroll") for (int k = 0; k < 2; ++k) dst[n][k] = *(const PG8_LAS bf16x8*)(lds + PG8_SB(b, h) + boff + n * 2048 + k * 1024); } while (0)
#define PG8_MMA(ai, bj, At, Bt) do { __builtin_amdgcn_s_setprio(1); _Pragma("unroll") for (int m = 0; m < 4; ++m) _Pragma("unroll") for (int n = 0; n < 2; ++n) _Pragma("unroll") for (int k = 0; k < 2; ++k) \
        acc[ai][bj][m][n] = __builtin_amdgcn_mfma_f32_16x16x32_bf16(Bt[n][k], At[m][k], acc[ai][bj][m][n], 0, 0, 0); __builtin_amdgcn_s_setprio(0); } while (0)
#define PG8_WAIT_V(n) asm volatile("s_waitcnt vmcnt(" #n ")" ::: "memory")
#define PG8_WAIT_L(n) asm volatile("s_waitcnt lgkmcnt(" #n ")" ::: "memory")
#define PG8_BAR __builtin_amdgcn_s_barrier()
#define PG8_SCHED __builtin_amdgcn_sched_barrier(0)
    Unit cur, nxt; int ui = 0;
    if (!S.next(0, cur)) return;
    f32x4 acc[2][2][4][2];
#pragma unroll
    for (int a = 0; a < 2; ++a)
#pragma unroll
        for (int b = 0; b < 2; ++b)
#pragma unroll
            for (int m = 0; m < 4; ++m)
#pragma unroll
                for (int n = 0; n < 2; ++n) acc[a][b][m][n] = (f32x4){0.f, 0.f, 0.f, 0.f};
    bf16x8 At[4][2], B0[2][2], B1[2][2];
    const char* cA; const char* cB; S.ptrs(cur, g, cA, cB);
    S.a_ready(cur);
    if constexpr (SP2) {
        PG8_STAGE(PG8_SB(0, 0), cB, voffB); PG8_STAGE(PG8_SB(0, 1), cB + hsB, voffB); PG8_STAGE(PG8_SA(0, 0), cA, voffA); PG8_STAGE(PG8_SA(0, 1), cA + hsA, voffA);
        if (wr == 1) PG8_BAR;
        PG8_WAIT_V(2); PG8_BAR;
        PG8_STAGE(PG8_SB(1, 0), cB + kstep, voffB); PG8_STAGE(PG8_SA(1, 0), cA + kstep, voffA); PG8_STAGE(PG8_SB(1, 1), cB + hsB + kstep, voffB);
        PG8_WAIT_V(6); PG8_BAR;
    } else {
        PG8_STAGE(PG8_SB(0, 0), cB, voffB); PG8_STAGE(PG8_SA(0, 0), cA, voffA); PG8_STAGE(PG8_SB(0, 1), cB + hsB, voffB); PG8_STAGE(PG8_SA(0, 1), cA + hsA, voffA);
        if (wr == 1) PG8_BAR;
        PG8_WAIT_V(4); PG8_BAR;
        PG8_STAGE(PG8_SB(1, 0), cB + kstep, voffB); PG8_STAGE(PG8_SA(1, 0), cA + kstep, voffA); PG8_STAGE(PG8_SB(1, 1), cB + hsB + kstep, voffB);
        PG8_WAIT_V(6); PG8_BAR;
    }
    for (;;) {
        const bool has_next = S.next(ui + 1, nxt);
        const char* nA = cA; const char* nB = cB; if (has_next) S.ptrs(nxt, g, nA, nB);
        for (int t = 0; t < nt; t += 2) {
            const bool last = (t == nt - 2);
            const char* a1 = cA + (size_t)(t + 1) * kstep;
            const char* a2 = last ? nA : cA + (size_t)(t + 2) * kstep; const char* b2 = last ? nB : cB + (size_t)(t + 2) * kstep;
            const char* a3 = a2 + kstep; const char* b3 = b2 + kstep;
            if (last && has_next) S.a_ready(nxt);
            if constexpr (SP2) {
            PG8_LDB(B0, 0, 0); PG8_LDB(B1, 0, 1); PG8_SCHED; PG8_LDA(At, 0, 0); PG8_STAGE(PG8_SA(1, 1), a1 + hsA, voffA);
            PG8_WAIT_V(8); PG8_WAIT_L(0); PG8_BAR; PG8_MMA(0, 0, At, B0); PG8_MMA(0, 1, At, B1); PG8_BAR; PG8_SCHED;
            PG8_LDA(At, 0, 1); PG8_STAGE(PG8_SB(0, 0), b2, voffB); PG8_STAGE(PG8_SB(0, 1), b2 + hsB, voffB); PG8_STAGE(PG8_SA(0, 0), a2, voffA);
            PG8_WAIT_V(8); PG8_WAIT_L(0); PG8_BAR; PG8_MMA(1, 0, At, B0); PG8_MMA(1, 1, At, B1); PG8_BAR; PG8_SCHED;
            PG8_LDB(B0, 1, 0); PG8_LDB(B1, 1, 1); PG8_SCHED; PG8_LDA(At, 1, 0); PG8_STAGE(PG8_SA(0, 1), a2 + hsA, voffA);
            PG8_WAIT_V(8); PG8_WAIT_L(0); PG8_BAR; PG8_MMA(0, 0, At, B0); PG8_MMA(0, 1, At, B1); PG8_BAR; PG8_SCHED;
            PG8_LDA(At, 1, 1); PG8_STAGE(PG8_SB(1, 0), b3, voffB); PG8_STAGE(PG8_SB(1, 1), b3 + hsB, voffB); PG8_STAGE(PG8_SA(1, 0), a3, voffA);
            PG8_WAIT_V(8); PG8_WAIT_L(0); PG8_BAR; PG8_MMA(1, 0, At, B0); PG8_MMA(1, 1, At, B1); PG8_BAR; PG8_SCHED;
            } else {
            PG8_LDB(B0, 0, 0); PG8_SCHED; PG8_LDA(At, 0, 0); PG8_STAGE(PG8_SA(1, 1), a1 + hsA, voffA);
            PG8_WAIT_L(8); PG8_BAR; PG8_WAIT_L(0); PG8_MMA(0, 0, At, B0); PG8_BAR; PG8_SCHED;
            PG8_LDB(B1, 0, 1); PG8_STAGE(PG8_SB(0, 0), b2, voffB);
            PG8_BAR; PG8_WAIT_L(0); PG8_MMA(0, 1, At, B1); PG8_BAR;
            PG8_LDA(At, 0, 1); PG8_STAGE(PG8_SA(0, 0), a2, voffA);
            PG8_BAR; PG8_WAIT_L(0); PG8_MMA(1, 0, At, B0); PG8_BAR; PG8_SCHED;
            PG8_STAGE(PG8_SB(0, 1), b2 + hsB, voffB);
            PG8_WAIT_V(6); PG8_BAR; PG8_MMA(1, 1, At, B1); PG8_BAR;
            PG8_LDB(B0, 1, 0); PG8_SCHED; PG8_LDA(At, 1, 0); PG8_STAGE(PG8_SA(0, 1), a2 + hsA, voffA);
            PG8_WAIT_L(8); PG8_BAR; PG8_WAIT_L(0); PG8_MMA(0, 0, At, B0); PG8_BAR; PG8_SCHED;
            PG8_LDB(B1, 1, 1); PG8_STAGE(PG8_SB(1, 0), b3, voffB);
            PG8_BAR; PG8_WAIT_L(0); PG8_MMA(0, 1, At, B1); PG8_BAR;
            PG8_LDA(At, 1, 1); PG8_STAGE(PG8_SA(1, 0), a3, voffA);
            PG8_BAR; PG8_WAIT_L(0); PG8_MMA(1, 0, At, B0); PG8_BAR; PG8_SCHED;
            PG8_STAGE(PG8_SB(1, 1), b3 + hsB, voffB);
            PG8_WAIT_V(6); PG8_BAR; PG8_MMA(1, 1, At, B1); PG8_BAR;
            }
        }
        if constexpr (ALIGN_EPI) { if (wr == 0) PG8_BAR; }
        if constexpr (!Epi::AFTER_DRAIN) { E(acc, cur, wr, wc, fr, fq); S.done(cur); }
        if (!has_next) break;
#pragma unroll
        for (int a = 0; a < 2; ++a)
#pragma unroll
            for (int b = 0; b < 2; ++b)
#pragma unroll
                for (int m = 0; m < 4; ++m)
#pragma unroll
                    for (int n = 0; n < 2; ++n) acc[a][b][m][n] = (f32x4){0.f, 0.f, 0.f, 0.f};
        cur = nxt; cA = nA; cB = nB; ++ui;
        if constexpr (ALIGN_EPI) { if (wr == 1) PG8_BAR; }
    }
    PG8_WAIT_V(0);
    if constexpr (!ALIGN_EPI) { if (wr == 0) PG8_BAR; }
    PG8_BAR;
    if constexpr (Epi::AFTER_DRAIN) { E.fused(acc, cur, wr, wc, fr, fq, lds, wid, lane); S.done(cur); }
#undef PG8_SA
#undef PG8_SB
#undef PG8_STAGE
#undef PG8_LDA
#undef PG8_LDB
#undef PG8_MMA
#undef PG8_WAIT_V
#undef PG8_WAIT_L
#undef PG8_BAR
#undef PG8_SCHED
}
}

__device__ __forceinline__ void rows_xn(const float* x, const float* g, bf16* XN, int gw, int ngw, int lane) {
    for (int m = gw; m < M; m += ngw) {
        const f32x4* xr = (const f32x4*)(x + (size_t)m * D) + lane;
        f32x4 v[8]; float s = 0.f;
#pragma unroll
        for (int j = 0; j < 8; ++j) { v[j] = xr[64 * j]; s += v[j].x * v[j].x + v[j].y * v[j].y + v[j].z * v[j].z + v[j].w * v[j].w; }
        const float rs = rsqrtf(wave_sum(s) * (1.f / D) + EPS);
        u32x2* o = (u32x2*)(XN + (size_t)m * D) + lane;
#pragma unroll
        for (int j = 0; j < 8; ++j) {
            const f32x4 gg = ((const f32x4*)g)[lane + 64 * j];
            u32x2 w; w.x = (unsigned)f2bf(v[j].x * rs * gg.x) | ((unsigned)f2bf(v[j].y * rs * gg.y) << 16);
            w.y = (unsigned)f2bf(v[j].z * rs * gg.z) | ((unsigned)f2bf(v[j].w * rs * gg.w) << 16);
            o[64 * j] = w;
        }
    }
}
__device__ __forceinline__ void rows_cn(const float* CKR, const float* g, bf16* CN, int gw, int ngw, int lane) {
    for (int m = gw; m < M; m += ngw) {
        const f32x4* xr = (const f32x4*)(CKR + (size_t)m * CL) + lane;
        f32x4 v[2]; float s = 0.f;
#pragma unroll
        for (int j = 0; j < 2; ++j) { v[j] = xr[64 * j]; s += v[j].x * v[j].x + v[j].y * v[j].y + v[j].z * v[j].z + v[j].w * v[j].w; }
        const float rs = rsqrtf(wave_sum(s) * (1.f / CL) + EPS);
        u32x2* o = (u32x2*)(CN + (size_t)m * CL) + lane;
#pragma unroll
        for (int j = 0; j < 2; ++j) {
            const f32x4 gg = ((const f32x4*)g)[lane + 64 * j];
            u32x2 w; w.x = (unsigned)f2bf(v[j].x * rs * gg.x) | ((unsigned)f2bf(v[j].y * rs * gg.y) << 16);
            w.y = (unsigned)f2bf(v[j].z * rs * gg.z) | ((unsigned)f2bf(v[j].w * rs * gg.w) << 16);
            o[64 * j] = w;
        }
    }
}
__device__ __forceinline__ void rows_final(float* H, const float* g, int gw, int ngw, int lane) {
    for (int m = gw; m < M; m += ngw) {
        f32x4* xr = (f32x4*)(H + (size_t)m * D) + lane;
        f32x4 v[8]; float s = 0.f;
#pragma unroll
        for (int j = 0; j < 8; ++j) { v[j] = xr[64 * j]; s += v[j].x * v[j].x + v[j].y * v[j].y + v[j].z * v[j].z + v[j].w * v[j].w; }
        const float rs = rsqrtf(wave_sum(s) * (1.f / D) + EPS);
#pragma unroll
        for (int j = 0; j < 8; ++j) { const f32x4 gg = ((const f32x4*)g)[lane + 64 * j]; xr[64 * j] = v[j] * rs * gg; }
    }
}

__device__ __forceinline__ void naive_gating(float* lds, bf16* U, const bf16* V, const float* VST, const float* ln_g, const float* ln_b,
                                             const float* w_s, const float* b_s, int vb, int nb) {
    float* Wt = lds; float* vn = lds + 128 * 128; float* mr = vn + 128 * 64;
    const int tid = threadIdx.x;
    for (int unit = vb; unit < 2 * 32 * 8 * 4; unit += nb) {
        const int cq = unit & 3, g = (unit >> 2) & 7, n = (unit >> 5) & 31, b = unit >> 10;
        const int row0 = b * SEQ + n * 128, ch0 = g * 256 + cq * 64;
        __syncthreads();
        if (tid < 128) {
            float s = 0.f, q = 0.f;
            for (int j = 0; j < 32; ++j) { s += VST[((size_t)(row0 + tid) * 32 + j) * 2]; q += VST[((size_t)(row0 + tid) * 32 + j) * 2 + 1]; }
            const float mean = s * (1.f / D); const float var = q * (1.f / D) - mean * mean;
            mr[tid * 2] = mean; mr[tid * 2 + 1] = rsqrtf(fmaxf(var, 0.f) + EPS);
        }
        for (int i = tid; i < 128 * 128; i += NTHREADS) { const int p = i >> 7, q = i & 127; Wt[q * 128 + p] = ((q >> 6) <= (p >> 6)) ? w_s[(size_t)g * 16384 + p * 128 + q] : 0.f; }
        __syncthreads();
        for (int i = tid; i < 128 * 64; i += NTHREADS) { const int q = i >> 6, c = i & 63;
            vn[i] = (bf2f(V[(size_t)(row0 + q) * D + ch0 + c]) - mr[q * 2]) * mr[q * 2 + 1] * ln_g[ch0 + c] + ln_b[ch0 + c]; }
        __syncthreads();
        const int c = tid & 63, pg = tid >> 6;
        float acc[16];
#pragma unroll
        for (int i = 0; i < 16; ++i) acc[i] = 0.f;
        for (int q = 0; q < 128; ++q) {
            const float x = vn[q * 64 + c];
#pragma unroll
            for (int i4 = 0; i4 < 4; ++i4) { const f32x4 w = *(const f32x4*)(Wt + q * 128 + pg * 16 + i4 * 4);
                acc[i4 * 4 + 0] += w.x * x; acc[i4 * 4 + 1] += w.y * x; acc[i4 * 4 + 2] += w.z * x; acc[i4 * 4 + 3] += w.w * x; }
        }
#pragma unroll
        for (int i = 0; i < 16; ++i) { const int p = pg * 16 + i; const size_t idx = (size_t)(row0 + p) * D + ch0 + c;
            U[idx] = f2bf(bf2f(U[idx]) * (acc[i] + b_s[g * 128 + p])); }
    }
}

__device__ __forceinline__ void naive_scores(float* lds, const bf16* QI, const bf16* KI, const float* WI, float* SC, int vb, int nb) {
    float* qs = lds;
    float* ws = lds + 1024;
    const int tid = threadIdx.x;
    for (int t = vb; t < M; t += nb) {
        const int b = t / SEQ, pos = t % SEQ, nadm = ((pos >> 6) + 1) * 64;
        __syncthreads();
        for (int i = tid; i < 1024; i += NTHREADS) qs[i] = bf2f(QI[(size_t)t * 1024 + i]);
        if (tid < 16) ws[tid] = WI[(size_t)t * 16 + tid] * 0.25f;
        __syncthreads();
        float* out = SC + sc_off(b, pos);
        for (int s = tid; s < nadm; s += NTHREADS) {
            float k[64];
            const u32x4* kp = (const u32x4*)(KI + (size_t)(b * SEQ + s) * 64);
#pragma unroll
            for (int i = 0; i < 8; ++i) { const u32x4 w = kp[i]; const unsigned ww[4] = {w.x, w.y, w.z, w.w};
#pragma unroll
                for (int e = 0; e < 4; ++e) { k[i * 8 + e * 2] = __uint_as_float(ww[e] << 16); k[i * 8 + e * 2 + 1] = __uint_as_float(ww[e] & 0xffff0000u); } }
            float sc = 0.f;
            for (int h = 0; h < 16; ++h) {
                float l = 0.f;
#pragma unroll
                for (int d = 0; d < 64; ++d) l += qs[h * 64 + d] * k[d];
                sc += ws[h] * fmaxf(l * 0.125f, 0.f);
            }
            out[s] = sc;
        }
    }
}

__device__ __forceinline__ unsigned fkey(float f) { const unsigned u = __float_as_uint(f + 0.0f); return (u & 0x80000000u) ? ~u : (u | 0x80000000u); }
__device__ __forceinline__ void topk_rows(const float* SC, int* SEL, int gw, int ngw, int lane) {
    for (int t = gw; t < M; t += ngw) {
        const int b = t / SEQ, pos = t % SEQ, nadm = ((pos >> 6) + 1) * 64;
        int* sel = SEL + (size_t)t * TOPK;
        if (nadm <= TOPK) { for (int i = lane; i < nadm; i += 64) sel[i] = i; continue; }
        const float* sc = SC + sc_off(b, pos);
        const int nj = nadm >> 6;
        unsigned key[64];
#pragma unroll
        for (int j = 0; j < 64; ++j) key[j] = (j < nj) ? fkey(sc[j * 64 + lane]) : 0u;
        unsigned prefix = 0u;
        for (int bit = 31; bit >= 0; --bit) {
            const unsigned cand = prefix | (1u << bit);
            int cnt = 0;
#pragma unroll
            for (int j4 = 0; j4 < 16; ++j4) {
                if (j4 * 4 < nj) {
#pragma unroll
                    for (int jj = 0; jj < 4; ++jj) cnt += __builtin_popcountll(__ballot(key[j4 * 4 + jj] >= cand));
                }
            }
            if (cnt >= TOPK) prefix = cand;
        }
        int cgt = 0;
#pragma unroll
        for (int j4 = 0; j4 < 16; ++j4) {
            if (j4 * 4 < nj) {
#pragma unroll
                for (int jj = 0; jj < 4; ++jj) cgt += __builtin_popcountll(__ballot(key[j4 * 4 + jj] > prefix));
            }
        }
        int need = TOPK - cgt, obase = 0;
        const unsigned long long lt = (1ull << lane) - 1ull;
#pragma unroll
        for (int j = 0; j < 64; ++j) {
            if (j < nj) {
                const bool gt = key[j] > prefix, eq = key[j] == prefix;
                const unsigned long long me = __ballot(eq);
                const int erank = __builtin_popcountll(me & lt);
                const bool take = gt || (eq && erank < need);
                const unsigned long long ms = __ballot(take);
                if (take) sel[obase + __builtin_popcountll(ms & lt)] = j * 64 + lane;
                obase += __builtin_popcountll(ms);
                const int ne = __builtin_popcountll(me); need -= (ne < need ? ne : need);
            }
        }
    }
}

__device__ __forceinline__ void naive_attn(float* lds, bf16* QL, const bf16* CN, const int* SEL, int vb, int nb) {
    float* qs = lds;
    float* att = lds + 16 * 512;
    int* sl = (int*)(att + 16 * 256);
    const int tid = threadIdx.x, lane = tid & 63, wid = tid >> 6;
    for (int t = vb; t < M; t += nb) {
        const int b = t / SEQ, pos = t % SEQ, nadm = ((pos >> 6) + 1) * 64, nsel = nadm < TOPK ? nadm : TOPK;
        __syncthreads();
        for (int i = tid; i < 16 * 512; i += NTHREADS) qs[i] = bf2f(QL[(size_t)t * 8192 + i]);
        if (tid < 256) sl[tid] = (tid < nsel) ? SEL[(size_t)t * TOPK + tid] : 0;
        __syncthreads();
        {
            const int k = tid & 255, hh = tid >> 8;
            float a[8];
#pragma unroll
            for (int i = 0; i < 8; ++i) a[i] = 0.f;
            if (k < nsel) {
                const u32x4* cp = (const u32x4*)(CN + (size_t)(b * SEQ + sl[k]) * CL);
                for (int c8 = 0; c8 < 64; ++c8) {
                    const u32x4 w = cp[c8]; float cv[8];
                    cv[0] = __uint_as_float(w.x << 16); cv[1] = __uint_as_float(w.x & 0xffff0000u); cv[2] = __uint_as_float(w.y << 16); cv[3] = __uint_as_float(w.y & 0xffff0000u);
                    cv[4] = __uint_as_float(w.z << 16); cv[5] = __uint_as_float(w.z & 0xffff0000u); cv[6] = __uint_as_float(w.w << 16); cv[7] = __uint_as_float(w.w & 0xffff0000u);
#pragma unroll
                    for (int i = 0; i < 8; ++i) { const float* qh = qs + (hh * 8 + i) * 512 + c8 * 8;
                        const f32x4 q0 = *(const f32x4*)qh, q1 = *(const f32x4*)(qh + 4);
                        a[i] += q0.x * cv[0] + q0.y * cv[1] + q0.z * cv[2] + q0.w * cv[3] + q1.x * cv[4] + q1.y * cv[5] + q1.z * cv[6] + q1.w * cv[7]; }
                }
            }
#pragma unroll
            for (int i = 0; i < 8; ++i) att[(hh * 8 + i) * 256 + k] = (k < nsel) ? a[i] * 0.08838834764831845f : -INFINITY;
        }
        __syncthreads();
        {
#pragma unroll
            for (int hi = 0; hi < 2; ++hi) { float* row = att + (wid * 2 + hi) * 256;
                float v[4]; float mx = -INFINITY;
#pragma unroll
                for (int i = 0; i < 4; ++i) { v[i] = row[lane + 64 * i]; mx = fmaxf(mx, v[i]); }
                mx = wave_max(mx); float s = 0.f;
#pragma unroll
                for (int i = 0; i < 4; ++i) { v[i] = __expf(v[i] - mx); s += v[i]; }
                s = wave_sum(s); const float inv = 1.f / s;
#pragma unroll
                for (int i = 0; i < 4; ++i) row[lane + 64 * i] = v[i] * inv; }
        }
        __syncthreads();
        {
            float o[16];
#pragma unroll
            for (int i = 0; i < 16; ++i) o[i] = 0.f;
            for (int k = 0; k < nsel; ++k) {
                const float cv = bf2f(CN[(size_t)(b * SEQ + sl[k]) * CL + tid]);
#pragma unroll
                for (int h = 0; h < 16; ++h) o[h] += att[h * 256 + k] * cv;
            }
#pragma unroll
            for (int h = 0; h < 16; ++h) QL[(size_t)t * 8192 + h * 512 + tid] = f2bf(o[h]);
        }
    }
}


#ifdef NAIVEMASK
template <bool DUAL, class Epi>
__device__ __forceinline__ void naive_gemm(float* lds, const bf16* A, int lda, const float* W, const float* W2, int ldw, const float* kscale,
                                           int Mrows, int N, int K, const Epi& epi, int vb, int nb) {
    float* As = lds;
    float* Ws = lds + 16 * 132;
    float* Ws2 = lds + 32 * 132;
    const int tid = threadIdx.x, tx = tid & 31, ty = tid >> 5;
    const int ntn = (N + 127) / 128, ntm = Mrows / 128;
    for (int tile = vb; tile < ntm * ntn; tile += nb) {
        const int tm = tile / ntn, tn = tile % ntn;
        const int row0 = tm * 128, col0 = tn * 128;
        float acc[8][4], acc2[8][4];
#pragma unroll
        for (int i = 0; i < 8; ++i)
#pragma unroll
            for (int j = 0; j < 4; ++j) { acc[i][j] = 0.f; acc2[i][j] = 0.f; }
        for (int k0 = 0; k0 < K; k0 += 16) {
            {
                const int r = tid >> 2, k4 = (tid & 3) * 4;
                const u32x2 raw = *(const u32x2*)(A + (size_t)(row0 + r) * lda + k0 + k4);
                As[(k4 + 0) * 132 + r] = __uint_as_float(raw.x << 16);
                As[(k4 + 1) * 132 + r] = __uint_as_float(raw.x & 0xffff0000u);
                As[(k4 + 2) * 132 + r] = __uint_as_float(raw.y << 16);
                As[(k4 + 3) * 132 + r] = __uint_as_float(raw.y & 0xffff0000u);
            }
            {
                const int k = tid >> 5, c4 = (tid & 31) * 4;
                f32x4 w = {0.f, 0.f, 0.f, 0.f}, w2 = {0.f, 0.f, 0.f, 0.f};
                if (col0 + c4 < N) {
                    w = *(const f32x4*)(W + (size_t)(k0 + k) * ldw + col0 + c4);
                    if (DUAL) w2 = *(const f32x4*)(W2 + (size_t)(k0 + k) * ldw + col0 + c4);
                    if (kscale) { const float s = kscale[k0 + k]; w = w * s; w2 = w2 * s; }
                }
                *(f32x4*)(Ws + k * 132 + c4) = w;
                if (DUAL) *(f32x4*)(Ws2 + k * 132 + c4) = w2;
            }
            __syncthreads();
#pragma unroll
            for (int k = 0; k < 16; ++k) {
                const f32x4 a0 = *(const f32x4*)(As + k * 132 + ty * 8), a1 = *(const f32x4*)(As + k * 132 + ty * 8 + 4);
                const f32x4 w = *(const f32x4*)(Ws + k * 132 + tx * 4);
                const float a[8] = {a0.x, a0.y, a0.z, a0.w, a1.x, a1.y, a1.z, a1.w};
#pragma unroll
                for (int i = 0; i < 8; ++i) { acc[i][0] += a[i] * w.x; acc[i][1] += a[i] * w.y; acc[i][2] += a[i] * w.z; acc[i][3] += a[i] * w.w; }
                if (DUAL) {
                    const f32x4 w2 = *(const f32x4*)(Ws2 + k * 132 + tx * 4);
#pragma unroll
                    for (int i = 0; i < 8; ++i) { acc2[i][0] += a[i] * w2.x; acc2[i][1] += a[i] * w2.y; acc2[i][2] += a[i] * w2.z; acc2[i][3] += a[i] * w2.w; }
                }
            }
            __syncthreads();
        }
#pragma unroll
        for (int i = 0; i < 8; ++i)
#pragma unroll
            for (int j = 0; j < 4; ++j) { const int r = row0 + ty * 8 + i, c = col0 + tx * 4 + j; if (c < N) epi(r, c, acc[i][j], acc2[i][j]); }
    }
}

struct EpiProj {
    bf16 *U, *V, *Q, *QI, *KI, *GA, *GB; float *CKR, *WI; int coff;
    __device__ __forceinline__ void operator()(int r, int c, float v, float) const {
        c += coff;
        if (c < 2048) U[(size_t)r * 2048 + c] = f2bf(gelu_tanh(v));
        else if (c < 4096) V[(size_t)r * 2048 + c - 2048] = f2bf(gelu_tanh(v));
        else if (c < 6144) Q[(size_t)r * 2048 + c - 4096] = f2bf(v);
        else if (c < 6656) CKR[(size_t)r * 512 + c - 6144] = v;
        else if (c < 7680) QI[(size_t)r * 1024 + c - 6656] = f2bf(v);
        else if (c < 7744) KI[(size_t)r * 64 + c - 7680] = f2bf(v);
        else if (c < 7760) WI[(size_t)r * 16 + c - 7744] = v;
        else if (c < 9808) GA[(size_t)r * 2048 + c - 7760] = f2bf(sigmoidf(v));
        else GB[(size_t)r * 2048 + c - 9808] = f2bf(sigmoidf(v));
    }
};
struct EpiGateA {
    bf16* GA;
    __device__ __forceinline__ void operator()(int r, int c, float v, float) const { const size_t i = (size_t)r * 2048 + c; GA[i] = f2bf(bf2f(GA[i]) * v); }
};
struct EpiGateB {
    bf16* TMP; const bf16* GB;
    __device__ __forceinline__ void operator()(int r, int c, float v, float) const { const size_t i = (size_t)r * 2048 + c; TMP[i] = f2bf(bf2f(TMP[i]) + bf2f(GB[i]) * v); }
};
struct EpiRes {
    const float* X; float* H; bf16* HB;
    __device__ __forceinline__ void operator()(int r, int c, float v, float) const { const size_t i = (size_t)r * 2048 + c; const float h = X[i] + v; H[i] = h; HB[i] = f2bf(h); }
};
struct EpiSwiglu {
    const float* HST; bf16* FFo;
    __device__ __forceinline__ void operator()(int r, int c, float g, float u) const {
        float ss = 0.f;
        for (int j = 0; j < 32; ++j) ss += HST[(size_t)r * 32 + j];
        const float rs = rsqrtf(ss * (1.f / D) + EPS);
        const float gg = g * rs, uu = u * rs;
        FFo[(size_t)r * FF + c] = f2bf(gg * sigmoidf(gg) * uu);
    }
};
struct EpiRes2 {
    float* H;
    __device__ __forceinline__ void operator()(int r, int c, float v, float) const { const size_t i = (size_t)r * 2048 + c; H[i] = H[i] + v; }
};

__device__ __forceinline__ void rows_vst(const bf16* V, float* VST, int gw, int ngw, int lane) {
    for (int m = gw; m < M; m += ngw) {
        const int j = lane >> 1, hf = lane & 1;
        const u32x4* p = (const u32x4*)(V + (size_t)m * D + j * 64 + hf * 32);
        float s = 0.f, q = 0.f;
#pragma unroll
        for (int i = 0; i < 4; ++i) { const u32x4 w = p[i]; const unsigned ww[4] = {w.x, w.y, w.z, w.w};
#pragma unroll
            for (int e = 0; e < 4; ++e) { const float a = __uint_as_float(ww[e] << 16), b = __uint_as_float(ww[e] & 0xffff0000u); s += a + b; q += a * a + b * b; } }
        s += __shfl_xor(s, 1); q += __shfl_xor(q, 1);
        if (hf == 0) { VST[((size_t)m * 32 + j) * 2] = s; VST[((size_t)m * 32 + j) * 2 + 1] = q; }
    }
}
__device__ __forceinline__ void rows_hst(const float* H, float* HST, int gw, int ngw, int lane) {
    for (int m = gw; m < M; m += ngw) {
        const int j = lane >> 1, hf = lane & 1;
        const f32x4* p = (const f32x4*)(H + (size_t)m * D + j * 64 + hf * 32);
        float q = 0.f;
#pragma unroll
        for (int i = 0; i < 8; ++i) { const f32x4 w = p[i]; q += w.x * w.x + w.y * w.y + w.z * w.z + w.w * w.w; }
        q += __shfl_xor(q, 1);
        if (hf == 0) HST[(size_t)m * 32 + j] = q;
    }
}
__device__ __forceinline__ void naive_qlat(float* lds, const bf16* Q, const float* w_uk, bf16* QL, int vb, int nb) {
    float* qs = lds;
    const int tid = threadIdx.x;
    for (int unit = vb; unit < (M / 32) * NH; unit += nb) {
        const int h = unit % NH, t0 = (unit / NH) * 32;
        __syncthreads();
        for (int i = tid; i < 32 * 128; i += NTHREADS) qs[i] = bf2f(Q[(size_t)(t0 + (i >> 7)) * D + h * 128 + (i & 127)]);
        __syncthreads();
        float acc[32];
#pragma unroll
        for (int i = 0; i < 32; ++i) acc[i] = 0.f;
        const f32x4* wr = (const f32x4*)(w_uk + (size_t)tid * 2048 + h * 128);
        for (int d4 = 0; d4 < 32; ++d4) {
            const f32x4 w = wr[d4];
#pragma unroll
            for (int i = 0; i < 32; ++i) { const f32x4 q = *(const f32x4*)(qs + i * 128 + d4 * 4); acc[i] += w.x * q.x + w.y * q.y + w.z * q.z + w.w * q.w; }
        }
#pragma unroll
        for (int i = 0; i < 32; ++i) QL[((size_t)(t0 + i) * NH + h) * CL + tid] = f2bf(acc[i]);
    }
}
__device__ __forceinline__ void naive_yb(float* lds, const bf16* OL, const float* w_uv, bf16* YB, int vb, int nb) {
    float* os = lds;
    const int tid = threadIdx.x, d = tid & 127, tq = tid >> 7;
    for (int unit = vb; unit < (M / 32) * NH; unit += nb) {
        const int h = unit % NH, t0 = (unit / NH) * 32;
        __syncthreads();
        for (int i = tid; i < 32 * 512; i += NTHREADS) os[i] = bf2f(OL[((size_t)(t0 + (i >> 9)) * NH + h) * CL + (i & 511)]);
        __syncthreads();
        float acc[8];
#pragma unroll
        for (int i = 0; i < 8; ++i) acc[i] = 0.f;
        for (int c = 0; c < CL; ++c) {
            const float w = w_uv[(size_t)c * 2048 + h * 128 + d];
#pragma unroll
            for (int i = 0; i < 8; ++i) acc[i] += w * os[(tq * 8 + i) * 512 + c];
        }
#pragma unroll
        for (int i = 0; i < 8; ++i) YB[(size_t)(t0 + tq * 8 + i) * D + h * 128 + d] = f2bf(acc[i]);
    }
}

#endif
#define XB_TMO      128
#define XB_XCNT(j)  (256  + 64 * (j))
#define XB_XSUB(j)  (1280 + 64 * (j))
#define XB_XGEN(j)  (2304 + 64 * (j))
#define XB_TOP      3328
#define XB_TOPGEN   3392
#define XCD_BAR_WORDS 3456
#define XB_SPIN_CAP (1u << 18)

__device__ __forceinline__ unsigned xb_ld(unsigned* p)              { return __hip_atomic_load(p, __ATOMIC_RELAXED, __HIP_MEMORY_SCOPE_AGENT); }
__device__ __forceinline__ unsigned xb_add(unsigned* p, unsigned v) { return __hip_atomic_fetch_add(p, v, __ATOMIC_RELAXED, __HIP_MEMORY_SCOPE_AGENT); }
__device__ __forceinline__ unsigned xb_xcc_id() { return (unsigned)__builtin_amdgcn_s_getreg((3 << 11) | 20) & 0xFu; }
#define XB_SPIN(cond, bar) do { unsigned _sp = 0; while (cond) { __builtin_amdgcn_s_sleep(1); \
    if ((++_sp & 255u) == 0u) { if (xb_ld(&(bar)[XB_TMO])) break; if (_sp > XB_SPIN_CAP) { atomicAdd(&(bar)[XB_TMO], 1u); break; } } } } while (0)

struct XcdBarrier {
    unsigned* bar; unsigned x;
    volatile LAS unsigned* st;
};

__device__ __forceinline__ XcdBarrier xcd_barrier_post(unsigned* bar, volatile LAS unsigned* st) {
    XcdBarrier b; b.bar = bar; b.x = xb_xcc_id(); b.st = st;
    if (threadIdx.x == 0) (void)xb_add(&bar[XB_XCNT(b.x)], 1u);
    return b;
}
__device__ __forceinline__ void xcd_barrier_complete(unsigned* bar, unsigned x, unsigned& nloc, unsigned& nx) {
    const unsigned G = gridDim.x * gridDim.y * gridDim.z;
    unsigned sum, cnt, mine, sp = 0u;
    for (;;) {
        sum = 0u; cnt = 0u; mine = 0u;
#pragma unroll
        for (unsigned j = 0; j < 16; ++j) { const unsigned c = xb_ld(&bar[XB_XCNT(j)]); sum += c; cnt += (c > 0u) ? 1u : 0u; mine = (j == x) ? c : mine; }
        if (sum == G) break;
        __builtin_amdgcn_s_sleep(1);
        if ((++sp & 255u) == 0u) { if (xb_ld(&bar[XB_TMO])) break; if (sp > XB_SPIN_CAP) { atomicAdd(&bar[XB_TMO], 1u); break; } }
    }
    nloc = mine > 0u ? mine : 1u; nx = cnt > 0u ? cnt : 1u;
}

__device__ __forceinline__ void xcd_barrier(const XcdBarrier& b) {
    asm volatile("s_waitcnt vmcnt(0)" ::: "memory");
    __syncthreads();
    if (threadIdx.x == 0) {
        unsigned* bar = b.bar;
        __builtin_amdgcn_s_waitcnt(0);
        unsigned nloc = b.st[0], nx = b.st[1];
        if (nloc == 0u) { xcd_barrier_complete(bar, b.x, nloc, nx); b.st[0] = nloc; b.st[1] = nx; }
        const unsigned old = xb_add(&bar[XB_XSUB(b.x)], 1u);
        const unsigned gen = old / nloc;
        if (old + 1u == (gen + 1u) * nloc) {
            __builtin_amdgcn_fence(__ATOMIC_RELEASE, "agent");
            asm volatile("s_waitcnt vmcnt(0)" ::: "memory");
            const unsigned og = xb_add(&bar[XB_TOP], 1u);
            const unsigned tg = og / nx;
            if (og + 1u == (tg + 1u) * nx) xb_add(&bar[XB_TOPGEN], 1u);
            else XB_SPIN(xb_ld(&bar[XB_TOPGEN]) == tg, bar);
            __builtin_amdgcn_fence(__ATOMIC_ACQUIRE, "agent");
            xb_add(&bar[XB_XGEN(b.x)], 1u);
            asm volatile("s_waitcnt vmcnt(0)" ::: "memory");
        } else {
            XB_SPIN(xb_ld(&bar[XB_XGEN(b.x)]) == gen, bar);
            __builtin_amdgcn_fence(__ATOMIC_ACQUIRE, "agent");
            asm volatile("s_waitcnt vmcnt(0)" ::: "memory");
        }
    }
    __syncthreads();
}

#define LDS_WAIT() asm volatile("s_waitcnt lgkmcnt(0)" ::: "memory")
#define VM_WAIT() asm volatile("s_waitcnt vmcnt(0)" ::: "memory")
template <class ColMap>
__device__ __forceinline__ void transpose_item(const float* W, int ldw, int ks0, bf16* WT, int ldd, int kd0, int n0, const ColMap& cm, const float* kscale, LAS float* scr, int lane) {
    const int sc = cm(n0 + (lane & 31));
#pragma unroll 8
    for (int i = 0; i < 32; ++i) { const int kk = 2 * i + (lane >> 5); float v = 0.f;
        if (sc >= 0) { v = W[(size_t)(ks0 + kk) * ldw + sc]; if (kscale) v *= kscale[ks0 + kk]; }
        scr[kk * 33 + (lane & 31)] = v; }
    LDS_WAIT(); asm volatile("" ::: "memory");
    const int c = lane & 7;
#pragma unroll
    for (int j = 0; j < 4; ++j) { const int n = (lane >> 3) + 8 * j; const LAS float* s = scr + (8 * c) * 33 + n;
        u32x4 o; o.x = pk2(s[0 * 33], s[1 * 33]); o.y = pk2(s[2 * 33], s[3 * 33]); o.z = pk2(s[4 * 33], s[5 * 33]); o.w = pk2(s[6 * 33], s[7 * 33]);
        *(u32x4*)(WT + (size_t)(n0 + n) * ldd + kd0 + 8 * c) = o; }
    LDS_WAIT(); asm volatile("" ::: "memory");
}
struct CmIdent { __device__ __forceinline__ int operator()(int n) const { return n; } };
struct CmWin { __device__ __forceinline__ int operator()(int n) const { return n < 7760 ? n : (n < 7936 ? -1 : n - 176); } };
struct CmGU { __device__ __forceinline__ int operator()(int n) const { return (n >> 8) * 128 + (n & 127); } };

__device__ __forceinline__ void p0_prologue(LAS unsigned char* lds, const float* x, const float* norm1_g, const float* w_in, const float* w_uk, const float* w_uv,
                                            const float* w_oa, const float* w_ob, const float* w_out, bf16* XN, bf16* WIN, bf16* WUK, bf16* WUV, bf16* WOA, bf16* WOB, bf16* WOUT,
                                            int gw, int ngw, int wave, int lane) {
    LAS float* scr = (LAS float*)(lds + wave * 16384);
    constexpr int I_IN = 32 * (NINP / 32), I_SQ = 32 * 64, I_UV = 16 * 64;
    constexpr int NITEMS = I_IN + 3 * I_SQ + I_UV;
    for (int it = gw; it < NITEMS; it += ngw) {
        int r = it;
        if (r < I_IN) { const int nb = r % (NINP / 32), kb = r / (NINP / 32); transpose_item(w_in, NIN, kb * 64, WIN, D, kb * 64, nb * 32, CmWin(), nullptr, scr, lane); continue; } r -= I_IN;
        if (r < I_SQ) { transpose_item(w_oa, D, (r / 64) * 64, WOA, D, (r / 64) * 64, (r % 64) * 32, CmIdent(), nullptr, scr, lane); continue; } r -= I_SQ;
        if (r < I_SQ) { transpose_item(w_ob, D, (r / 64) * 64, WOB, D, (r / 64) * 64, (r % 64) * 32, CmIdent(), nullptr, scr, lane); continue; } r -= I_SQ;
        if (r < I_SQ) { transpose_item(w_out, D, (r / 64) * 64, WOUT, D, (r / 64) * 64, (r % 64) * 32, CmIdent(), nullptr, scr, lane); continue; } r -= I_SQ;
        {
            const int nb = r % 64, kb = r / 64, h = nb >> 2; const bool data = (kb >> 3) == (h & 1);
            if (data) transpose_item(w_uv, D, (kb & 7) * 64, WUV, 1024, kb * 64, nb * 32, CmIdent(), nullptr, scr, lane);
            else { const int c = lane & 7;
#pragma unroll
                for (int j = 0; j < 4; ++j) { const int n = (lane >> 3) + 8 * j; *(u32x4*)(WUV + (size_t)(nb * 32 + n) * 1024 + kb * 64 + 8 * c) = (u32x4){0u, 0u, 0u, 0u}; } }
        }
    }
    for (int i = gw * 64 + lane; i < 16 * 512 * 16; i += ngw * 64) { const int d8 = i & 15, c = (i >> 4) & 511, h = i >> 13;
        const f32x4* s = (const f32x4*)(w_uk + (size_t)c * 2048 + h * 128 + d8 * 8); const f32x4 a = s[0], b = s[1];
        u32x4 o; o.x = pk2(a[0], a[1]); o.y = pk2(a[2], a[3]); o.z = pk2(b[0], b[1]); o.w = pk2(b[2], b[3]);
        *(u32x4*)(WUK + ((size_t)h * 512 + c) * 128 + d8 * 8) = o; }
    rows_xn(x, norm1_g, XN, gw, ngw, lane);
}
__device__ __forceinline__ void p_convert_ffn(LAS unsigned char* lds, const float* w_fg, const float* w_fu, const float* w_fd, const float* norm2_g, bf16* WGU, bf16* WD, int gw, int ngw, int wave, int lane) {
    LAS float* scr = (LAS float*)(lds + wave * 16384);
    constexpr int I_GU = 32 * (11264 / 32), I_D = 88 * 64;
    for (int it = gw; it < I_GU + I_D; it += ngw) {
        int r = it;
        if (r < I_GU) { const int nb = r % 352, kb = r / 352; const bool up = ((nb * 32) & 128) != 0;
            transpose_item(up ? w_fu : w_fg, FF, kb * 64, WGU, D, kb * 64, nb * 32, CmGU(), norm2_g, scr, lane); continue; } r -= I_GU;
        transpose_item(w_fd, D, (r / 64) * 64, WD, FF, (r / 64) * 64, (r % 64) * 32, CmIdent(), nullptr, scr, lane);
    }
}


#define P_X ((const float*)ka->in[0])
#define P_NORM1 ((const float*)ka->in[1])
#define P_WIN_F ((const float*)ka->in[2])
#define P_LNG ((const float*)ka->in[3])
#define P_LNB ((const float*)ka->in[4])
#define P_WS_F ((const float*)ka->in[5])
#define P_BS_F ((const float*)ka->in[6])
#define P_KVG ((const float*)ka->in[7])
#define P_WUK_F ((const float*)ka->in[8])
#define P_WUV_F ((const float*)ka->in[9])
#define P_WOA_F ((const float*)ka->in[10])
#define P_WOB_F ((const float*)ka->in[11])
#define P_WOUT_F ((const float*)ka->in[12])
#define P_NORM2 ((const float*)ka->in[13])
#define P_WFG ((const float*)ka->in[14])
#define P_WFU ((const float*)ka->in[15])
#define P_WFD ((const float*)ka->in[16])
#define P_FING ((const float*)ka->in[17])
#define B16(off) ((bf16*)(ws + (off)))
#define F32(off) ((float*)(ws + (off)))
constexpr int CW_BAR = 4096;
struct Args { const float* in[18]; float* out; unsigned char* ws; int ph_lo, ph_hi, use_bar, pad; };
constexpr int N_PHASES = 12;

template <int ONLY> __global__ void __launch_bounds__(NTHREADS, 2) mk_fwd(Args a) {
    extern __shared__ __attribute__((aligned(16))) unsigned char lds_g[];
    LAS unsigned char* lds = (LAS unsigned char*)lds_g;
    float* ldsf = (float*)lds_g;
    const int tid = threadIdx.x, lane = tid & 63, wave = __builtin_amdgcn_readfirstlane(tid >> 6);
    const int G = gridDim.x, vb = blockIdx.x;
    const int gw = vb * NWAVES + wave, ngw = G * NWAVES;
    const __attribute__((address_space(4))) Args* ka = (const __attribute__((address_space(4))) Args*)__builtin_amdgcn_kernarg_segment_ptr();
    unsigned char* const ws = a.ws;
    for (int u = tid; u < (LDS_BYTES - LDSCTL_OFF) / 4; u += NTHREADS) ((LAS unsigned*)(lds + LDSCTL_OFF))[u] = 0u;
    __syncthreads();
    XcdBarrier bar; bar.bar = (unsigned*)(ws + WS_CTL) + CW_BAR; bar.x = 0; bar.st = nullptr;
    if (a.use_bar) bar = xcd_barrier_post((unsigned*)(ws + WS_CTL) + CW_BAR, (volatile LAS unsigned*)(lds + MISC_OFF) + 8);
    const int lo = a.ph_lo, hi = a.ph_hi;
#ifndef SKIPMASK
#define SKIPMASK 0
#endif
#define IN(k) (!((SKIPMASK >> (k)) & 1) && (ONLY < 0 || ONLY == (k)) && lo <= (k) && (k) < hi)
#define SEAM(k) do { if (IN(k) && IN((k) + 1)) xcd_barrier(bar); } while (0)

    if (IN(0)) { p0_prologue(lds, P_X, P_NORM1, P_WIN_F, P_WUK_F, P_WUV_F, P_WOA_F, P_WOB_F, P_WOUT_F, B16(WS_XN), B16(WS_WIN), B16(WS_WUK), B16(WS_WUV), B16(WS_WOA), B16(WS_WOB), B16(WS_WOUT), gw, ngw, wave, lane); }
    SEAM(0);
#if defined(NAIVEMASK) && (NAIVEMASK & (1 << 1))
    if (IN(1)) { EpiProj e{B16(WS_U), B16(WS_V), B16(WS_Q), B16(WS_QI), B16(WS_KI), B16(WS_GA), B16(WS_GB), F32(WS_CKR), F32(WS_WI), 0}; naive_gemm<false>(ldsf, B16(WS_XN), D, P_WIN_F, nullptr, NIN, nullptr, M, NIN, D, e, vb, G); }
#else
    if (IN(1)) { pg8::Gemm g{B16(WS_XN), B16(WS_WIN), D, D, D}; pg8::StaticOrder S; S.init(M, NINP, G, vb);
        pg8::EpiProjF E{ws};
        pg8::gemm_phase<pg8::EpiProjF, pg8::StaticOrder, true, true>(lds, g, S, E); }
#endif
    SEAM(1);
#if defined(NAIVEMASK)
    if (ONLY == 101) { rows_vst(B16(WS_V), F32(WS_VST), gw, ngw, lane); }
    if (ONLY == 102) { rows_hst(ka->out, F32(WS_HST), gw, ngw, lane); }
#endif
    if (IN(2)) { rows_cn(F32(WS_CKR), P_KVG, B16(WS_CN), gw, ngw, lane); naive_gating(ldsf, B16(WS_U), B16(WS_V), F32(WS_VST), P_LNG, P_LNB, P_WS_F, P_BS_F, vb, G); naive_scores(ldsf, B16(WS_QI), B16(WS_KI), F32(WS_WI), F32(WS_SC), vb, G); __syncthreads(); }
    SEAM(2);
#if defined(NAIVEMASK) && (NAIVEMASK & (1 << 3))
    if (IN(3)) { EpiGateA e{B16(WS_GA)}; naive_gemm<false>(ldsf, B16(WS_U), D, P_WOA_F, nullptr, D, nullptr, M, D, D, e, vb, G); topk_rows(F32(WS_SC), (int*)(ws + WS_SEL), gw, ngw, lane); }
#else
    if (IN(3)) { pg8::Gemm g{B16(WS_U), B16(WS_WOA), D, D, D}; pg8::StaticOrder S; S.init(M, D, G, vb); pg8::EpiGateAF E{B16(WS_GA)};
        pg8::gemm_phase<pg8::EpiGateAF, pg8::StaticOrder, true, true>(lds, g, S, E);
        topk_rows(F32(WS_SC), (int*)(ws + WS_SEL), gw, ngw, lane); }
#endif
    SEAM(3);
#if defined(NAIVEMASK) && (NAIVEMASK & (1 << 4))
    if (IN(4)) { naive_qlat(ldsf, B16(WS_Q), P_WUK_F, B16(WS_QL), vb, G); }
#else
    if (IN(4)) { int kq = 128; asm volatile("" : "+s"(kq)); pg8::Gemm g{B16(WS_Q), B16(WS_WUK), D, 128, kq}; pg8::HeadOrderQ S{G, vb}; pg8::EpiQlatF E{B16(WS_QL)};
        pg8::gemm_phase<pg8::EpiQlatF, pg8::HeadOrderQ, true, true>(lds, g, S, E); }
#endif
    SEAM(4);
    if (IN(5)) { naive_attn(ldsf, B16(WS_QL), B16(WS_CN), (const int*)(ws + WS_SEL), vb, G); __syncthreads(); }
    SEAM(5);
#if defined(NAIVEMASK) && (NAIVEMASK & (1 << 6))
    if (IN(6)) { naive_yb(ldsf, B16(WS_QL), P_WUV_F, B16(WS_Q), vb, G); }
#else
    if (IN(6)) { pg8::Gemm g{B16(WS_QL), B16(WS_WUV), 8192, 1024, 1024}; pg8::PairOrderYB S{G, vb}; pg8::EpiPlainF E{B16(WS_Q), D};
        pg8::gemm_phase<pg8::EpiPlainF, pg8::PairOrderYB, true, true>(lds, g, S, E); }
#endif
    SEAM(6);
#if defined(NAIVEMASK) && (NAIVEMASK & (1 << 7))
    if (IN(7)) { EpiGateB e{B16(WS_GA), B16(WS_GB)}; naive_gemm<false>(ldsf, B16(WS_Q), D, P_WOB_F, nullptr, D, nullptr, M, D, D, e, vb, G); p_convert_ffn(lds, P_WFG, P_WFU, P_WFD, P_NORM2, B16(WS_WGU), B16(WS_WD), gw, ngw, wave, lane); }
#else
    if (IN(7)) { pg8::Gemm g{B16(WS_Q), B16(WS_WOB), D, D, D}; pg8::StaticOrder S; S.init(M, D, G, vb); pg8::EpiGateBF E{B16(WS_GA), B16(WS_GB)};
        pg8::gemm_phase<pg8::EpiGateBF, pg8::StaticOrder, true, true>(lds, g, S, E);
        p_convert_ffn(lds, P_WFG, P_WFU, P_WFD, P_NORM2, B16(WS_WGU), B16(WS_WD), gw, ngw, wave, lane); }
#endif
    SEAM(7);
#if defined(NAIVEMASK) && (NAIVEMASK & (1 << 8))
    if (IN(8)) { EpiRes e{P_X, ka->out, B16(WS_HB)}; naive_gemm<false>(ldsf, B16(WS_GA), D, P_WOUT_F, nullptr, D, nullptr, M, D, D, e, vb, G); }
#else
    if (IN(8)) { pg8::Gemm g{B16(WS_GA), B16(WS_WOUT), D, D, D}; pg8::StaticOrder S; S.init(M, D, G, vb); pg8::EpiResF E{P_X, ka->out, B16(WS_HB), F32(WS_HST)};
        pg8::gemm_phase<pg8::EpiResF, pg8::StaticOrder, true, true>(lds, g, S, E); }
#endif
    SEAM(8);
#if defined(NAIVEMASK) && (NAIVEMASK & (1 << 9))
    if (IN(9)) { EpiSwiglu e{F32(WS_HST), B16(WS_FF)}; naive_gemm<true>(ldsf, B16(WS_HB), D, P_WFG, P_WFU, FF, P_NORM2, M, FF, D, e, vb, G); }
#else
    if (IN(9)) { pg8::Gemm g{B16(WS_HB), B16(WS_WGU), D, D, D}; pg8::StaticOrder S; S.init(M, 11264, G, vb); pg8::EpiSwigluF E{F32(WS_HST), B16(WS_FF)};
        pg8::gemm_phase<pg8::EpiSwigluF, pg8::StaticOrder, true, true>(lds, g, S, E); }
#endif
    SEAM(9);
#if defined(NAIVEMASK) && (NAIVEMASK & (1 << 10))
    if (IN(10)) { EpiRes2 e{ka->out}; naive_gemm<false>(ldsf, B16(WS_FF), FF, P_WFD, nullptr, D, nullptr, M, D, FF, e, vb, G); }
#else
    if (IN(10)) { pg8::Gemm g{B16(WS_FF), B16(WS_WD), FF, FF, FF}; pg8::StaticOrder S; S.init(M, D, G, vb); pg8::EpiRes2F E{ka->out};
        pg8::gemm_phase<pg8::EpiRes2F, pg8::StaticOrder, true, true>(lds, g, S, E); }
#endif
    SEAM(10);
    if (IN(11)) rows_final(ka->out, P_FING, gw, ngw, lane);
#undef IN
#undef SEAM
}

#ifndef MK_N_LAUNCHES
#define MK_N_LAUNCHES 1
#endif

template <int P> static void launch_one(int grid, Args a, hipStream_t stream) {
    static bool attr = false;
    if (!attr) { (void)hipFuncSetAttribute((const void*)mk_fwd<P>, hipFuncAttributeMaxDynamicSharedMemorySize, LDS_BYTES); attr = true; }
    a.ph_lo = (P < 0 || P > 99) ? 0 : P; a.ph_hi = (P < 0) ? N_PHASES : ((P > 99) ? 0 : P + 1); a.use_bar = (P < 0) ? 1 : 0;
    hipLaunchKernelGGL(mk_fwd<P>, dim3(grid), dim3(NTHREADS), LDS_BYTES, stream, a);
}
extern "C" void kernel_launch(void* const* d_in, const int* in_sizes, int n_in, void* d_out, int out_size, void* d_ws, size_t ws_size, hipStream_t stream) {
    static int grid = 0;
    if (grid == 0) {
        if (n_in != 18 || out_size != M * D || ws_size < WS_END) { fprintf(stderr, "kernel_launch: unexpected shapes n_in %d out %d ws %zu\n", n_in, out_size, ws_size); grid = -1; return; }
        int dev = 0, cus = 0;
        (void)hipGetDevice(&dev); (void)hipDeviceGetAttribute(&cus, hipDeviceAttributeMultiprocessorCount, dev);
        grid = cus > 0 ? cus : 256;
    }
    if (grid < 0) return;
    (void)hipMemsetAsync((char*)d_ws + WS_CTL, 0, CTL_ZERO_BYTES, stream);
    Args a{};
    for (int i = 0; i < 18; ++i) a.in[i] = (const float*)d_in[i];
    a.out = (float*)d_out; a.ws = (unsigned char*)d_ws;
#if MK_N_LAUNCHES == 1
    launch_one<-1>(grid, a, stream);
#else
    launch_one<0>(grid, a, stream); launch_one<1>(grid, a, stream);
#if defined(NAIVEMASK) && (NAIVEMASK & 2)
    launch_one<101>(grid, a, stream);
#endif
    launch_one<2>(grid, a, stream); launch_one<3>(grid, a, stream); launch_one<4>(grid, a, stream); launch_one<5>(grid, a, stream);
    launch_one<6>(grid, a, stream); launch_one<7>(grid, a, stream); launch_one<8>(grid, a, stream);
#if defined(NAIVEMASK) && (NAIVEMASK & (1 << 8))
    launch_one<102>(grid, a, stream);
#endif
    launch_one<9>(grid, a, stream); launch_one<10>(grid, a, stream); launch_one<11>(grid, a, stream);
#endif
}
```

```cpp
#include <hip/hip_runtime.h>
#include <cstdio>
#include <cstdint>

constexpr int BATCH = 2, SEQ = 4096, D = 2048, M = BATCH * SEQ, NIN = 11856, FF = 5632;
constexpr int CL = 512, NH = 16, HD = 128, IH = 16, IDM = 64, TOPK = 256, CHUNK = 64;
constexpr int NINP = 12032;
constexpr float EPS = 1e-6f;
constexpr int NTHREADS = 512, NWAVES = 8;

#define LAS __attribute__((address_space(3)))
#define GAS __attribute__((address_space(1)))
typedef unsigned short bf16;
typedef float f32x4 __attribute__((ext_vector_type(4)));
typedef float f32x2 __attribute__((ext_vector_type(2)));
typedef unsigned u32x4 __attribute__((ext_vector_type(4)));
typedef unsigned u32x2 __attribute__((ext_vector_type(2)));

__device__ __forceinline__ float bf2f(bf16 v) { return __uint_as_float(((unsigned)v) << 16); }
__device__ __forceinline__ bf16 f2bf(float f) { unsigned u = __float_as_uint(f); return (bf16)((u + 0x7fffu + ((u >> 16) & 1u)) >> 16); }
__device__ __forceinline__ unsigned pk2(float lo, float hi) { return (unsigned)f2bf(lo) | ((unsigned)f2bf(hi) << 16); }
__device__ __forceinline__ float bflo(unsigned w) { return __uint_as_float(w << 16); }
__device__ __forceinline__ float bfhi(unsigned w) { return __uint_as_float(w & 0xffff0000u); }
__device__ __forceinline__ float wave_sum(float v) {
#pragma unroll
    for (int o = 1; o < 64; o <<= 1) v += __shfl_xor(v, o);
    return v;
}
__device__ __forceinline__ float wave_max(float v) {
#pragma unroll
    for (int o = 1; o < 64; o <<= 1) v = fmaxf(v, __shfl_xor(v, o));
    return v;
}
__device__ __forceinline__ float gelu_tanh(float x) {
    const float u2 = 1.5957691216057308f * (x + 0.044715f * x * x * x);
    return x * __builtin_amdgcn_rcpf(1.f + __expf(-u2));
}
__device__ __forceinline__ float sigmoidf(float x) { return __builtin_amdgcn_rcpf(1.f + __expf(-x)); }

constexpr size_t MiB = 1u << 20;
constexpr size_t WS_CTL = 0, CTL_ZERO_BYTES = 64 * 1024;
constexpr size_t WS_VST = 1 * MiB;
constexpr size_t WS_HST = 3 * MiB;
constexpr size_t WS_WI = 4 * MiB;
constexpr size_t WS_KI = 5 * MiB;
constexpr size_t WS_SEL = 6 * MiB;
constexpr size_t WS_CN = 14 * MiB;
constexpr size_t WS_CKR = 22 * MiB;
constexpr size_t WS_QI = 38 * MiB;
constexpr size_t WS_WUK = 54 * MiB;
constexpr size_t WS_WUV = 56 * MiB;
constexpr size_t WS_WOA = 60 * MiB;
constexpr size_t WS_WOB = 68 * MiB;
constexpr size_t WS_WOUT = 76 * MiB;
constexpr size_t WS_WIN = 86 * MiB;
constexpr size_t WS_XN = 133 * MiB;
constexpr size_t WS_SC = 101 * MiB;
constexpr size_t WS_QL = 102 * MiB;
constexpr size_t WS_U = 166 * MiB;
constexpr size_t WS_V = 198 * MiB;
constexpr size_t WS_Q = 230 * MiB;
constexpr size_t WS_GA = 262 * MiB;
constexpr size_t WS_GB = 294 * MiB;
constexpr size_t WS_WGU = 86 * MiB;
constexpr size_t WS_WD = 130 * MiB;
constexpr size_t WS_HB = 152 * MiB;
constexpr size_t WS_FF = 230 * MiB;
constexpr size_t WS_END = 326 * MiB;

constexpr int RING_BYTES = 131072;
constexpr int LDS_BYTES = 163840;
constexpr int LDSCTL_OFF = LDS_BYTES - 512, MISC_OFF = LDSCTL_OFF + 320;
constexpr size_t SC_PER_BATCH = 8519680;

__device__ __forceinline__ size_t sc_off(int b, int pos) {
    const int c = pos >> 6, r = pos & 63;
    return (size_t)b * SC_PER_BATCH + (size_t)2048 * c * (c + 1) + (size_t)r * 64 * (c + 1);
}
namespace pg8 {
#define PG8_LAS __attribute__((address_space(3)))
typedef unsigned short bf16_t;
typedef short bf16x8 __attribute__((ext_vector_type(8)));
typedef float f32x4 __attribute__((ext_vector_type(4)));
typedef unsigned u32x4 __attribute__((ext_vector_type(4)));
constexpr int BM = 256, BK = 64, HALF = 128, HTB = HALF * BK * 2  , STAGE_BYTES = 8 * HTB, NXCD = 8, WGM = 8;

__host__ __device__ __forceinline__ int lds_byte(int r, int c) { const int st = (r >> 4) * 2 + (c >> 5), rr = r & 15, cc = c & 31, ob = rr * 64 + cc * 2; return st * 1024 + (ob ^ (((ob >> 9) & 1) << 5)); }
__host__ __device__ __forceinline__ void stage_rc(int b, int& R, int& C) { const int st = b / 1024, sb = b % 1024, swz = sb ^ (((sb >> 9) & 1) << 5); R = (st >> 1) * 16 + swz / 64; C = (st & 1) * 32 + (swz % 64) / 2; }
__host__ __device__ __forceinline__ int perm32(int rho) { const int n = rho >> 4, i = rho & 15; return 8 * (i >> 2) + 4 * n + (i & 3); }

struct Unit { int pm, pn, h; };
struct Gemm { const bf16_t* A; const bf16_t* Bt; int lda, ldb, K; };

struct StaticOrder {
    int nM, nN, nwg, G, c;
    __host__ __device__ void init(int M_, int N_, int G_, int c_) { nM = M_ / BM; nN = N_ / BM; nwg = nM * nN; G = G_; c = c_; }
    __host__ __device__ bool next(int i, Unit& u) const {
        const long L = (long)i * G + c; if (L >= nwg) return false;
        int wgid = (int)L; { const int q = nwg / NXCD, r = nwg % NXCD, xcd = wgid % NXCD, off = wgid / NXCD; wgid = (xcd < r ? xcd * (q + 1) : r * (q + 1) + (xcd - r) * q) + off; }
        const int nig = WGM * nN, gid = wgid / nig, fm = gid * WGM, gsz = (nM - fm) < WGM ? (nM - fm) : WGM;
        u.pm = fm + ((wgid % nig) % gsz); u.pn = (wgid % nig) / gsz; u.h = 0; return true;
    }
    __device__ __forceinline__ void ptrs(const Unit& u, const Gemm& g, const char*& a, const char*& b) const {
        a = (const char*)g.A + (size_t)u.pm * BM * g.lda * 2; b = (const char*)g.Bt + (size_t)u.pn * BM * g.ldb * 2; }
    __device__ __forceinline__ void a_ready(const Unit&) const {}
    __device__ __forceinline__ void done(const Unit&) const {}
};
struct HeadOrderQ {
    int G, c;
    __device__ bool next(int i, Unit& u) const { const int L = i * G + c; if (L >= 1024) return false; u.h = L >> 6; u.pn = (L >> 5) & 1; u.pm = L & 31; return true; }
    __device__ __forceinline__ void ptrs(const Unit& u, const Gemm& g, const char*& a, const char*& b) const {
        a = (const char*)g.A + ((size_t)u.pm * BM * g.lda + u.h * 128) * 2; b = (const char*)g.Bt + (size_t)(u.h * 512 + u.pn * BM) * g.ldb * 2; }
    __device__ __forceinline__ void a_ready(const Unit&) const {}
    __device__ __forceinline__ void done(const Unit&) const {}
};
struct PairOrderYB {
    int G, c;
    __device__ bool next(int i, Unit& u) const { const int L = i * G + c; if (L >= 256) return false; u.h = 0; u.pn = L >> 5; u.pm = L & 31; return true; }
    __device__ __forceinline__ void ptrs(const Unit& u, const Gemm& g, const char*& a, const char*& b) const {
        a = (const char*)g.A + ((size_t)u.pm * BM * g.lda + u.pn * 1024) * 2; b = (const char*)g.Bt + (size_t)(u.pn * BM) * g.ldb * 2; }
    __device__ __forceinline__ void a_ready(const Unit&) const {}
    __device__ __forceinline__ void done(const Unit&) const {}
};

typedef __bf16 bf16x2_t __attribute__((ext_vector_type(2)));
typedef float f32x2c __attribute__((ext_vector_type(2)));
__device__ __forceinline__ unsigned cvt_pk_bf16(float lo, float hi) { const f32x2c v = {lo, hi}; const bf16x2_t b = __builtin_convertvector(v, bf16x2_t); return __builtin_bit_cast(unsigned, b); }
__device__ __forceinline__ u32x4 pack8(const f32x4 v0, const f32x4 v1) { u32x4 w; w.x = cvt_pk_bf16(v0[0], v0[1]); w.y = cvt_pk_bf16(v0[2], v0[3]); w.z = cvt_pk_bf16(v1[0], v1[1]); w.w = cvt_pk_bf16(v1[2], v1[3]); return w; }
__device__ __forceinline__ float gelu1(float x) { const float u2 = 1.5957691216057308f * (x + 0.044715f * x * x * x); return x * __builtin_amdgcn_rcpf(1.f + __expf(-u2)); }
__device__ __forceinline__ float sigm1(float x) { return __builtin_amdgcn_rcpf(1.f + __expf(-x)); }
template <int ACT> __device__ __forceinline__ f32x4 act4(f32x4 v) {
    if (ACT == 1) { v[0] = gelu1(v[0]); v[1] = gelu1(v[1]); v[2] = gelu1(v[2]); v[3] = gelu1(v[3]); }
    if (ACT == 2) { v[0] = sigm1(v[0]); v[1] = sigm1(v[1]); v[2] = sigm1(v[2]); v[3] = sigm1(v[3]); }
    return v;
}
template <int ACT> __device__ __forceinline__ void store_tile_bf16(const f32x4 (&acc)[2][2][4][2], bf16_t* base, int ld, int row0) {
#pragma unroll
    for (int ai = 0; ai < 2; ++ai)
#pragma unroll
        for (int m = 0; m < 4; ++m) { bf16_t* rowp = base + (size_t)(row0 + ai * HALF + m * 16) * ld;
#pragma unroll
            for (int bj = 0; bj < 2; ++bj) *(u32x4*)(rowp + bj * HALF) = pack8(act4<ACT>(acc[ai][bj][m][0]), act4<ACT>(acc[ai][bj][m][1])); }
}

struct EpiProjF {
    static constexpr bool PERM = true, AFTER_DRAIN = false;
    unsigned char* ws;
    __device__ __forceinline__ void operator()(const f32x4 (&acc)[2][2][4][2], const Unit& u, int wr, int wc, int fr, int fq) const {
        const int pn = u.pn, row0 = u.pm * BM + wr * 64 + fr, c8 = wc * 32 + 8 * fq;
        if (pn < 8) store_tile_bf16<1>(acc, (bf16_t*)(ws + WS_U) + pn * 256 + c8, 2048, row0);
        else if (pn < 16) {
            bf16_t* base = (bf16_t*)(ws + WS_V) + (pn - 8) * 256 + c8; float* VST = (float*)(ws + WS_VST);
#pragma unroll
            for (int ai = 0; ai < 2; ++ai)
#pragma unroll
                for (int m = 0; m < 4; ++m) { const int row = row0 + ai * HALF + m * 16; float s = 0.f, q = 0.f;
#pragma unroll
                    for (int bj = 0; bj < 2; ++bj) { const f32x4 v0 = act4<1>(acc[ai][bj][m][0]), v1 = act4<1>(acc[ai][bj][m][1]);
                        s += (v0[0] + v0[1]) + (v0[2] + v0[3]) + (v1[0] + v1[1]) + (v1[2] + v1[3]);
                        q += (v0[0] * v0[0] + v0[1] * v0[1]) + (v0[2] * v0[2] + v0[3] * v0[3]) + (v1[0] * v1[0] + v1[1] * v1[1]) + (v1[2] * v1[2] + v1[3] * v1[3]);
                        *(u32x4*)(base + (size_t)row * 2048 + bj * HALF) = pack8(v0, v1); }
                    s += __shfl_xor(s, 16); s += __shfl_xor(s, 32); q += __shfl_xor(q, 16); q += __shfl_xor(q, 32);
                    if (fq == 0) *(f32x2*)(VST + ((size_t)row * 32 + (pn - 8) * 4 + wc) * 2) = (f32x2){s, q};
                    asm volatile("" ::: "memory"); }
        }
        else if (pn < 24) store_tile_bf16<0>(acc, (bf16_t*)(ws + WS_Q) + (pn - 16) * 256 + c8, 2048, row0);
        else if (pn < 26) {
            float* base = (float*)(ws + WS_CKR) + (pn - 24) * 256 + c8;
#pragma unroll
            for (int ai = 0; ai < 2; ++ai)
#pragma unroll
                for (int m = 0; m < 4; ++m) { float* rowp = base + (size_t)(row0 + ai * HALF + m * 16) * 512;
#pragma unroll
                    for (int bj = 0; bj < 2; ++bj) { *(f32x4*)(rowp + bj * HALF) = acc[ai][bj][m][0]; *(f32x4*)(rowp + bj * HALF + 4) = acc[ai][bj][m][1]; } }
        }
        else if (pn < 30) store_tile_bf16<0>(acc, (bf16_t*)(ws + WS_QI) + (pn - 26) * 256 + c8, 1024, row0);
        else if (pn == 30) {
            bf16_t* KI = (bf16_t*)(ws + WS_KI); float* WI = (float*)(ws + WS_WI);
#pragma unroll
            for (int ai = 0; ai < 2; ++ai)
#pragma unroll
                for (int m = 0; m < 4; ++m) { const size_t row = row0 + ai * HALF + m * 16;
                    if (c8 < 64) *(u32x4*)(KI + row * 64 + c8) = pack8(acc[ai][0][m][0], acc[ai][0][m][1]);
                    else if (c8 < 80) { *(f32x4*)(WI + row * 16 + (c8 - 64)) = acc[ai][0][m][0]; *(f32x4*)(WI + row * 16 + (c8 - 64) + 4) = acc[ai][0][m][1]; } }
        }
        else store_tile_bf16<2>(acc, (bf16_t*)(ws + WS_GA) + (size_t)(pn >= 39 ? (WS_GB - WS_GA) / 2 : 0) + ((pn - 31) & 7) * 256 + c8, 2048, row0);
    }
};
struct EpiQlatF {
    static constexpr bool PERM = true, AFTER_DRAIN = false;
    bf16_t* QL;
    __device__ __forceinline__ void operator()(const f32x4 (&acc)[2][2][4][2], const Unit& u, int wr, int wc, int fr, int fq) const {
        store_tile_bf16<0>(acc, QL + u.h * 512 + u.pn * 256 + wc * 32 + 8 * fq, 8192, u.pm * BM + wr * 64 + fr); }
};
struct EpiPlainF {
    static constexpr bool PERM = true, AFTER_DRAIN = false;
    bf16_t* O; int ld;
    __device__ __forceinline__ void operator()(const f32x4 (&acc)[2][2][4][2], const Unit& u, int wr, int wc, int fr, int fq) const {
        store_tile_bf16<0>(acc, O + u.pn * 256 + wc * 32 + 8 * fq, ld, u.pm * BM + wr * 64 + fr); }
};
__device__ __forceinline__ float blo(unsigned w) { return __uint_as_float(w << 16); }
__device__ __forceinline__ float bhi(unsigned w) { return __uint_as_float(w & 0xffff0000u); }
struct EpiGateAF {
    static constexpr bool PERM = true, AFTER_DRAIN = false;
    bf16_t* GA;
    __device__ __forceinline__ void operator()(const f32x4 (&acc)[2][2][4][2], const Unit& u, int wr, int wc, int fr, int fq) const {
        bf16_t* base = GA + u.pn * 256 + wc * 32 + 8 * fq; const int row0 = u.pm * BM + wr * 64 + fr;
#pragma unroll
        for (int ai = 0; ai < 2; ++ai)
#pragma unroll
            for (int m = 0; m < 4; ++m) { bf16_t* rowp = base + (size_t)(row0 + ai * HALF + m * 16) * 2048;
#pragma unroll
                for (int bj = 0; bj < 2; ++bj) { const u32x4 g = *(const u32x4*)(rowp + bj * HALF); const f32x4 v0 = acc[ai][bj][m][0], v1 = acc[ai][bj][m][1];
                    const f32x4 o0 = {blo(g.x) * v0[0], bhi(g.x) * v0[1], blo(g.y) * v0[2], bhi(g.y) * v0[3]}, o1 = {blo(g.z) * v1[0], bhi(g.z) * v1[1], blo(g.w) * v1[2], bhi(g.w) * v1[3]};
                    *(u32x4*)(rowp + bj * HALF) = pack8(o0, o1); } }
    }
};
struct EpiGateBF {
    static constexpr bool PERM = true, AFTER_DRAIN = false;
    bf16_t* TMP; const bf16_t* GB;
    __device__ __forceinline__ void operator()(const f32x4 (&acc)[2][2][4][2], const Unit& u, int wr, int wc, int fr, int fq) const {
        const int coff = u.pn * 256 + wc * 32 + 8 * fq, row0 = u.pm * BM + wr * 64 + fr;
#pragma unroll
        for (int ai = 0; ai < 2; ++ai)
#pragma unroll
            for (int m = 0; m < 4; ++m) { const size_t ro = (size_t)(row0 + ai * HALF + m * 16) * 2048 + coff;
#pragma unroll
                for (int bj = 0; bj < 2; ++bj) { const u32x4 g = *(const u32x4*)(GB + ro + bj * HALF), t = *(const u32x4*)(TMP + ro + bj * HALF); const f32x4 v0 = acc[ai][bj][m][0], v1 = acc[ai][bj][m][1];
                    const f32x4 o0 = {blo(t.x) + blo(g.x) * v0[0], bhi(t.x) + bhi(g.x) * v0[1], blo(t.y) + blo(g.y) * v0[2], bhi(t.y) + bhi(g.y) * v0[3]};
                    const f32x4 o1 = {blo(t.z) + blo(g.z) * v1[0], bhi(t.z) + bhi(g.z) * v1[1], blo(t.w) + blo(g.w) * v1[2], bhi(t.w) + bhi(g.w) * v1[3]};
                    *(u32x4*)(TMP + ro + bj * HALF) = pack8(o0, o1); } }
    }
};
struct EpiResF {
    static constexpr bool PERM = true, AFTER_DRAIN = false;
    const float* X; float* H; bf16_t* HB; float* HST;
    __device__ __forceinline__ void operator()(const f32x4 (&acc)[2][2][4][2], const Unit& u, int wr, int wc, int fr, int fq) const {
        const int coff = u.pn * 256 + wc * 32 + 8 * fq, row0 = u.pm * BM + wr * 64 + fr;
#pragma unroll
        for (int ai = 0; ai < 2; ++ai)
#pragma unroll
            for (int m = 0; m < 4; ++m) { const int row = row0 + ai * HALF + m * 16; const size_t ro = (size_t)row * 2048 + coff; float q = 0.f;
#pragma unroll
                for (int bj = 0; bj < 2; ++bj) { const f32x4 x0 = *(const f32x4*)(X + ro + bj * HALF), x1 = *(const f32x4*)(X + ro + bj * HALF + 4);
                    const f32x4 h0 = x0 + acc[ai][bj][m][0], h1 = x1 + acc[ai][bj][m][1];
                    *(f32x4*)(H + ro + bj * HALF) = h0; *(f32x4*)(H + ro + bj * HALF + 4) = h1; *(u32x4*)(HB + ro + bj * HALF) = pack8(h0, h1);
                    q += (h0[0] * h0[0] + h0[1] * h0[1]) + (h0[2] * h0[2] + h0[3] * h0[3]) + (h1[0] * h1[0] + h1[1] * h1[1]) + (h1[2] * h1[2] + h1[3] * h1[3]); }
                q += __shfl_xor(q, 16); q += __shfl_xor(q, 32);
                if (fq == 0) HST[(size_t)row * 32 + u.pn * 4 + wc] = q; }
    }
};
struct EpiSwigluF {
    static constexpr bool PERM = true, AFTER_DRAIN = false;
    const float* HST; bf16_t* FFo;
    __device__ __forceinline__ void operator()(const f32x4 (&acc)[2][2][4][2], const Unit& u, int wr, int wc, int fr, int fq) const {
        const int coff = u.pn * 128 + wc * 32 + 8 * fq, row0 = u.pm * BM + wr * 64 + fr;
#pragma unroll
        for (int ai = 0; ai < 2; ++ai)
#pragma unroll
            for (int m = 0; m < 4; ++m) { const int row = row0 + ai * HALF + m * 16; const f32x4* hp = (const f32x4*)(HST + (size_t)row * 32);
                f32x4 sv = hp[0];
#pragma unroll
                for (int j = 1; j < 8; ++j) sv = sv + hp[j];
                const float rs = rsqrtf(((sv[0] + sv[1]) + (sv[2] + sv[3])) * (1.f / 2048.f) + 1e-6f);
                f32x4 o0, o1;
#pragma unroll
                for (int e = 0; e < 4; ++e) { const float g0 = acc[ai][0][m][0][e] * rs, u0 = acc[ai][1][m][0][e] * rs, g1 = acc[ai][0][m][1][e] * rs, u1 = acc[ai][1][m][1][e] * rs;
                    o0[e] = g0 * sigm1(g0) * u0; o1[e] = g1 * sigm1(g1) * u1; }
                *(u32x4*)(FFo + (size_t)row * 5632 + coff) = pack8(o0, o1); }
    }
};
struct EpiRes2F {
    static constexpr bool PERM = true, AFTER_DRAIN = false;
    float* H;
    __device__ __forceinline__ void operator()(const f32x4 (&acc)[2][2][4][2], const Unit& u, int wr, int wc, int fr, int fq) const {
        const int coff = u.pn * 256 + wc * 32 + 8 * fq, row0 = u.pm * BM + wr * 64 + fr;
#pragma unroll
        for (int ai = 0; ai < 2; ++ai)
#pragma unroll
            for (int m = 0; m < 4; ++m) { float* rp = H + (size_t)(row0 + ai * HALF + m * 16) * 2048 + coff;
#pragma unroll
                for (int bj = 0; bj < 2; ++bj) { const f32x4 h0 = *(const f32x4*)(rp + bj * HALF) + acc[ai][bj][m][0], h1 = *(const f32x4*)(rp + bj * HALF + 4) + acc[ai][bj][m][1];
                    *(f32x4*)(rp + bj * HALF) = h0; *(f32x4*)(rp + bj * HALF + 4) = h1; } }
    }
};

template <class Epi, class Sched, bool ALIGN_EPI = true, bool SP2 = true>
__device__ __forceinline__ void gemm_phase(PG8_LAS unsigned char* lds, const Gemm g, const Sched& S, const Epi& E) {
    const int tid = threadIdx.x, wid = __builtin_amdgcn_readfirstlane(tid >> 6), lane = tid & 63, wr = wid >> 2, wc = wid & 3, fr = lane & 15, fq = lane >> 4;
    const int K = g.K, nt = K / BK;
    unsigned voffA[2], voffB[2];
#pragma unroll
    for (int i = 0; i < 2; ++i) { int R, C; stage_rc(tid * 16 + i * 8192, R, C); const int Rb = Epi::PERM ? ((R & ~31) + perm32(R & 31)) : R;
        voffA[i] = (unsigned)(R * g.lda + C) * 2u; voffB[i] = (unsigned)(Rb * g.ldb + C) * 2u; }
    const size_t kstep = (size_t)(BK * 2);
    const size_t hsA = (size_t)HALF * g.lda * 2, hsB = (size_t)HALF * g.ldb * 2;
    const unsigned ldsw = (unsigned)wid * 1024u;
    const int aoff = lds_byte(wr * 64 + fr, fq * 8), boff = lds_byte(wc * 32 + fr, fq * 8);
#define PG8_SA(b, h) (((b) * 2 + (h)) * HTB)
#define PG8_SB(b, h) ((4 + (b) * 2 + (h)) * HTB)
#define PG8_STAGE(bufoff, gbase, voff) do { _Pragma("unroll") for (int _i = 0; _i < 2; ++_i) \
        __builtin_amdgcn_global_load_lds((const unsigned*)((const char*)(gbase) + (voff)[_i]), (PG8_LAS unsigned*)(lds + (bufoff) + ldsw + _i * 8192), 16, 0, 0); } while (0)
#define PG8_LDA(dst, b, h) do { _Pragma("unroll") for (int m = 0; m < 4; ++m) _Pragma("unroll") for (int k = 0; k < 2; ++k) dst[m][k] = *(const PG8_LAS bf16x8*)(lds + PG8_SA(b, h) + aoff + m * 2048 + k * 1024); } while (0)
#define PG8_LDB(dst, b, h) do { _Pragma("unroll") for (int n = 0; n < 2; ++n) _Pragma("unroll") for (int k = 0; k < 2; ++k) dst[n][k] = *(const PG8_LAS bf16x8*)(lds + PG8_SB(b, h) + boff + n * 2048 + k * 1024); } while (0)
#define PG8_MMA(ai, bj, At, Bt) do { __builtin_amdgcn_s_setprio(1); _Pragma("unroll") for (int m = 0; m < 4; ++m) _Pragma("unroll") for (int n = 0; n < 2; ++n) _Pragma("unroll") for (int k = 0; k < 2; ++k) \
        acc[ai][bj][m][n] = __builtin_amdgcn_mfma_f32_16x16x32_bf16(Bt[n][k], At[m][k], acc[ai][bj][m][n], 0, 0, 0); __builtin_amdgcn_s_setprio(0); } while (0)
#define PG8_WAIT_V(n) asm volatile("s_waitcnt vmcnt(" #n ")" ::: "memory")
#define PG8_WAIT_L(n) asm volatile("s_waitcnt lgkmcnt(" #n ")" ::: "memory")
#define PG8_BAR __builtin_amdgcn_s_barrier()
#define PG8_SCHED __builtin_amdgcn_sched_barrier(0)
    Unit cur, nxt; int ui = 0;
    if (!S.next(0, cur)) return;
    f32x4 acc[2][2][4][2];
#pragma unroll
    for (int a = 0; a < 2; ++a)
#pragma unroll
        for (int b = 0; b < 2; ++b)
#pragma unroll
            for (int m = 0; m < 4; ++m)
#pragma unroll
                for (int n = 0; n < 2; ++n) acc[a][b][m][n] = (f32x4){0.f, 0.f, 0.f, 0.f};
    bf16x8 At[4][2], B0[2][2], B1[2][2];
    const char* cA; const char* cB; S.ptrs(cur, g, cA, cB);
    S.a_ready(cur);
    if constexpr (SP2) {
        PG8_STAGE(PG8_SB(0, 0), cB, voffB); PG8_STAGE(PG8_SB(0, 1), cB + hsB, voffB); PG8_STAGE(PG8_SA(0, 0), cA, voffA); PG8_STAGE(PG8_SA(0, 1), cA + hsA, voffA);
        if (wr == 1) PG8_BAR;
        PG8_WAIT_V(2); PG8_BAR;
        PG8_STAGE(PG8_SB(1, 0), cB + kstep, voffB); PG8_STAGE(PG8_SA(1, 0), cA + kstep, voffA); PG8_STAGE(PG8_SB(1, 1), cB + hsB + kstep, voffB);
        PG8_WAIT_V(6); PG8_BAR;
    } else {
        PG8_STAGE(PG8_SB(0, 0), cB, voffB); PG8_STAGE(PG8_SA(0, 0), cA, voffA); PG8_STAGE(PG8_SB(0, 1), cB + hsB, voffB); PG8_STAGE(PG8_SA(0, 1), cA + hsA, voffA);
        if (wr == 1) PG8_BAR;
        PG8_WAIT_V(4); PG8_BAR;
        PG8_STAGE(PG8_SB(1, 0), cB + kstep, voffB); PG8_STAGE(PG8_SA(1, 0), cA + kstep, voffA); PG8_STAGE(PG8_SB(1, 1), cB + hsB + kstep, voffB);
        PG8_WAIT_V(6); PG8_BAR;
    }
    for (;;) {
        const bool has_next = S.next(ui + 1, nxt);
        const char* nA = cA; const char* nB = cB; if (has_next) S.ptrs(nxt, g, nA, nB);
        for (int t = 0; t < nt; t += 2) {
            const bool last = (t == nt - 2);
            const char* a1 = cA + (size_t)(t + 1) * kstep;
            const char* a2 = last ? nA : cA + (size_t)(t + 2) * kstep; const char* b2 = last ? nB : cB + (size_t)(t + 2) * kstep;
            const char* a3 = a2 + kstep; const char* b3 = b2 + kstep;
            if (last && has_next) S.a_ready(nxt);
            if constexpr (SP2) {
            PG8_LDB(B0, 0, 0); PG8_LDB(B1, 0, 1); PG8_SCHED; PG8_LDA(At, 0, 0); PG8_STAGE(PG8_SA(1, 1), a1 + hsA, voffA);
            PG8_WAIT_V(8); PG8_WAIT_L(0); PG8_BAR; PG8_MMA(0, 0, At, B0); PG8_MMA(0, 1, At, B1); PG8_BAR; PG8_SCHED;
            PG8_LDA(At, 0, 1); PG8_STAGE(PG8_SB(0, 0), b2, voffB); PG8_STAGE(PG8_SB(0, 1), b2 + hsB, voffB); PG8_STAGE(PG8_SA(0, 0), a2, voffA);
            PG8_WAIT_V(8); PG8_WAIT_L(0); PG8_BAR; PG8_MMA(1, 0, At, B0); PG8_MMA(1, 1, At, B1); PG8_BAR; PG8_SCHED;
            PG8_LDB(B0, 1, 0); PG8_LDB(B1, 1, 1); PG8_SCHED; PG8_LDA(At, 1, 0); PG8_STAGE(PG8_SA(0, 1), a2 + hsA, voffA);
            PG8_WAIT_V(8); PG8_WAIT_L(0); PG8_BAR; PG8_MMA(0, 0, At, B0); PG8_MMA(0, 1, At, B1); PG8_BAR; PG8_SCHED;
            PG8_LDA(At, 1, 1); PG8_STAGE(PG8_SB(1, 0), b3, voffB); PG8_STAGE(PG8_SB(1, 1), b3 + hsB, voffB); PG8_STAGE(PG8_SA(1, 0), a3, voffA);
            PG8_WAIT_V(8); PG8_WAIT_L(0); PG8_BAR; PG8_MMA(1, 0, At, B0); PG8_MMA(1, 1, At, B1); PG8_BAR; PG8_SCHED;
            } else {
            PG8_LDB(B0, 0, 0); PG8_SCHED; PG8_LDA(At, 0, 0); PG8_STAGE(PG8_SA(1, 1), a1 + hsA, voffA);
            PG8_WAIT_L(8); PG8_BAR; PG8_WAIT_L(0); PG8_MMA(0, 0, At, B0); PG8_BAR; PG8_SCHED;
            PG8_LDB(B1, 0, 1); PG8_STAGE(PG8_SB(0, 0), b2, voffB);
            PG8_BAR; PG8_WAIT_L(0); PG8_MMA(0, 1, At, B1); PG8_BAR;
            PG8_LDA(At, 0, 1); PG8_STAGE(PG8_SA(0, 0), a2, voffA);
            PG8_BAR; PG8_WAIT_L(0); PG8_MMA(1, 0, At, B0); PG8_BAR; PG8_SCHED;
            PG8_STAGE(PG8_SB(0, 1), b2 + hsB, voffB);
            PG8_WAIT_V(6); PG8_BAR; PG8_MMA(1, 1, At, B1); PG8_BAR;
            PG8_LDB(B0, 1, 0); PG8_SCHED; PG8_LDA(At, 1, 0); PG8_STAGE(PG8_SA(0, 1), a2 + hsA, voffA);
            PG8_WAIT_L(8); PG8_BAR; PG8_WAIT_L(0); PG8_MMA(0, 0, At, B0); PG8_BAR; PG8_SCHED;
            PG8_LDB(B1, 1, 1); PG8_STAGE(PG8_SB(1, 0), b3, voffB);
            PG8_BAR; PG8_WAIT_L(0); PG8_MMA(0, 1, At, B1); PG8_BAR;
            PG8_LDA(At, 1, 1); PG8_STAGE(PG8_SA(1, 0), a3, voffA);
            PG8_BAR; PG8_WAIT_L(0); PG8_MMA(1, 0, At, B0); PG8_BAR; PG8_SCHED;
            PG8_STAGE(PG8_SB(1, 1), b3 + hsB, voffB);
            PG8_WAIT_V(6); PG8_BAR; PG8_MMA(1, 1, At, B1); PG8_BAR;
            }
        }
        if constexpr (ALIGN_EPI) { if (wr == 0) PG8_BAR; }
        if constexpr (!Epi::AFTER_DRAIN) { E(acc, cur, wr, wc, fr, fq); S.done(cur); }
        if (!has_next) break;
#pragma unroll
        for (int a = 0; a < 2; ++a)
#pragma unroll
            for (int b = 0; b < 2; ++b)
#pragma unroll
                for (int m = 0; m < 4; ++m)
#pragma unroll
                    for (int n = 0; n < 2; ++n) acc[a][b][m][n] = (f32x4){0.f, 0.f, 0.f, 0.f};
        cur = nxt; cA = nA; cB = nB; ++ui;
        if constexpr (ALIGN_EPI) { if (wr == 1) PG8_BAR; }
    }
    PG8_WAIT_V(0);
    if constexpr (!ALIGN_EPI) { if (wr == 0) PG8_BAR; }
    PG8_BAR;
    if constexpr (Epi::AFTER_DRAIN) { E.fused(acc, cur, wr, wc, fr, fq, lds, wid, lane); S.done(cur); }
#undef PG8_SA
#undef PG8_SB
#undef PG8_STAGE
#undef PG8_LDA
#undef PG8_LDB
#undef PG8_MMA
#undef PG8_WAIT_V
#undef PG8_WAIT_L
#undef PG8_BAR
#undef PG8_SCHED
}
}

__device__ __forceinline__ void rows_xn(const float* x, const float* g, bf16* XN, int gw, int ngw, int lane) {
    for (int m = gw; m < M; m += ngw) {
        const f32x4* xr = (const f32x4*)(x + (size_t)m * D) + lane;
        f32x4 v[8]; float s = 0.f;
#pragma unroll
        for (int j = 0; j < 8; ++j) { v[j] = xr[64 * j]; s += v[j].x * v[j].x + v[j].y * v[j].y + v[j].z * v[j].z + v[j].w * v[j].w; }
        const float rs = rsqrtf(wave_sum(s) * (1.f / D) + EPS);
        u32x2* o = (u32x2*)(XN + (size_t)m * D) + lane;
#pragma unroll
        for (int j = 0; j < 8; ++j) {
            const f32x4 gg = ((const f32x4*)g)[lane + 64 * j];
            u32x2 w; w.x = (unsigned)f2bf(v[j].x * rs * gg.x) | ((unsigned)f2bf(v[j].y * rs * gg.y) << 16);
            w.y = (unsigned)f2bf(v[j].z * rs * gg.z) | ((unsigned)f2bf(v[j].w * rs * gg.w) << 16);
            o[64 * j] = w;
        }
    }
}
__device__ __forceinline__ void rows_cn(const float* CKR, const float* g, bf16* CN, int gw, int ngw, int lane) {
    for (int m = gw; m < M; m += ngw) {
        const f32x4* xr = (const f32x4*)(CKR + (size_t)m * CL) + lane;
        f32x4 v[2]; float s = 0.f;
#pragma unroll
        for (int j = 0; j < 2; ++j) { v[j] = xr[64 * j]; s += v[j].x * v[j].x + v[j].y * v[j].y + v[j].z * v[j].z + v[j].w * v[j].w; }
        const float rs = rsqrtf(wave_sum(s) * (1.f / CL) + EPS);
        u32x2* o = (u32x2*)(CN + (size_t)m * CL) + lane;
#pragma unroll
        for (int j = 0; j < 2; ++j) {
            const f32x4 gg = ((const f32x4*)g)[lane + 64 * j];
            u32x2 w; w.x = (unsigned)f2bf(v[j].x * rs * gg.x) | ((unsigned)f2bf(v[j].y * rs * gg.y) << 16);
            w.y = (unsigned)f2bf(v[j].z * rs * gg.z) | ((unsigned)f2bf(v[j].w * rs * gg.w) << 16);
            o[64 * j] = w;
        }
    }
}
__device__ __forceinline__ void rows_final(float* H, const float* g, int gw, int ngw, int lane) {
    for (int m = gw; m < M; m += ngw) {
        f32x4* xr = (f32x4*)(H + (size_t)m * D) + lane;
        f32x4 v[8]; float s = 0.f;
#pragma unroll
        for (int j = 0; j < 8; ++j) { v[j] = xr[64 * j]; s += v[j].x * v[j].x + v[j].y * v[j].y + v[j].z * v[j].z + v[j].w * v[j].w; }
        const float rs = rsqrtf(wave_sum(s) * (1.f / D) + EPS);
#pragma unroll
        for (int j = 0; j < 8; ++j) { const f32x4 gg = ((const f32x4*)g)[lane + 64 * j]; xr[64 * j] = v[j] * rs * gg; }
    }
}

__device__ __forceinline__ void naive_gating(float* lds, bf16* U, const bf16* V, const float* VST, const float* ln_g, const float* ln_b,
                                             const float* w_s, const float* b_s, int vb, int nb) {
    float* Wt = lds; float* vn = lds + 128 * 128; float* mr = vn + 128 * 64;
    const int tid = threadIdx.x;
    for (int unit = vb; unit < 2 * 32 * 8 * 4; unit += nb) {
        const int cq = unit & 3, g = (unit >> 2) & 7, n = (unit >> 5) & 31, b = unit >> 10;
        const int row0 = b * SEQ + n * 128, ch0 = g * 256 + cq * 64;
        __syncthreads();
        if (tid < 128) {
            float s = 0.f, q = 0.f;
            for (int j = 0; j < 32; ++j) { s += VST[((size_t)(row0 + tid) * 32 + j) * 2]; q += VST[((size_t)(row0 + tid) * 32 + j) * 2 + 1]; }
            const float mean = s * (1.f / D); const float var = q * (1.f / D) - mean * mean;
            mr[tid * 2] = mean; mr[tid * 2 + 1] = rsqrtf(fmaxf(var, 0.f) + EPS);
        }
        for (int i = tid; i < 128 * 128; i += NTHREADS) { const int p = i >> 7, q = i & 127; Wt[q * 128 + p] = ((q >> 6) <= (p >> 6)) ? w_s[(size_t)g * 16384 + p * 128 + q] : 0.f; }
        __syncthreads();
        for (int i = tid; i < 128 * 64; i += NTHREADS) { const int q = i >> 6, c = i & 63;
            vn[i] = (bf2f(V[(size_t)(row0 + q) * D + ch0 + c]) - mr[q * 2]) * mr[q * 2 + 1] * ln_g[ch0 + c] + ln_b[ch0 + c]; }
        __syncthreads();
        const int c = tid & 63, pg = tid >> 6;
        float acc[16];
#pragma unroll
        for (int i = 0; i < 16; ++i) acc[i] = 0.f;
        for (int q = 0; q < 128; ++q) {
            const float x = vn[q * 64 + c];
#pragma unroll
            for (int i4 = 0; i4 < 4; ++i4) { const f32x4 w = *(const f32x4*)(Wt + q * 128 + pg * 16 + i4 * 4);
                acc[i4 * 4 + 0] += w.x * x; acc[i4 * 4 + 1] += w.y * x; acc[i4 * 4 + 2] += w.z * x; acc[i4 * 4 + 3] += w.w * x; }
        }
#pragma unroll
        for (int i = 0; i < 16; ++i) { const int p = pg * 16 + i; const size_t idx = (size_t)(row0 + p) * D + ch0 + c;
            U[idx] = f2bf(bf2f(U[idx]) * (acc[i] + b_s[g * 128 + p])); }
    }
}

__device__ __forceinline__ void naive_scores(float* lds, const bf16* QI, const bf16* KI, const float* WI, float* SC, int vb, int nb) {
    float* qs = lds;
    float* ws = lds + 1024;
    const int tid = threadIdx.x;
    for (int t = vb; t < M; t += nb) {
        const int b = t / SEQ, pos = t % SEQ, nadm = ((pos >> 6) + 1) * 64;
        __syncthreads();
        for (int i = tid; i < 1024; i += NTHREADS) qs[i] = bf2f(QI[(size_t)t * 1024 + i]);
        if (tid < 16) ws[tid] = WI[(size_t)t * 16 + tid] * 0.25f;
        __syncthreads();
        float* out = SC + sc_off(b, pos);
        for (int s = tid; s < nadm; s += NTHREADS) {
            float k[64];
            const u32x4* kp = (const u32x4*)(KI + (size_t)(b * SEQ + s) * 64);
#pragma unroll
            for (int i = 0; i < 8; ++i) { const u32x4 w = kp[i]; const unsigned ww[4] = {w.x, w.y, w.z, w.w};
#pragma unroll
                for (int e = 0; e < 4; ++e) { k[i * 8 + e * 2] = __uint_as_float(ww[e] << 16); k[i * 8 + e * 2 + 1] = __uint_as_float(ww[e] & 0xffff0000u); } }
            float sc = 0.f;
            for (int h = 0; h < 16; ++h) {
                float l = 0.f;
#pragma unroll
                for (int d = 0; d < 64; ++d) l += qs[h * 64 + d] * k[d];
                sc += ws[h] * fmaxf(l * 0.125f, 0.f);
            }
            out[s] = sc;
        }
    }
}

__device__ __forceinline__ unsigned fkey(float f) { const unsigned u = __float_as_uint(f + 0.0f); return (u & 0x80000000u) ? ~u : (u | 0x80000000u); }
__device__ __forceinline__ void topk_rows(const float* SC, int* SEL, int gw, int ngw, int lane) {
    for (int t = gw; t < M; t += ngw) {
        const int b = t / SEQ, pos = t % SEQ, nadm = ((pos >> 6) + 1) * 64;
        int* sel = SEL + (size_t)t * TOPK;
        if (nadm <= TOPK) { for (int i = lane; i < nadm; i += 64) sel[i] = i; continue; }
        const float* sc = SC + sc_off(b, pos);
        const int nj = nadm >> 6;
        unsigned key[64];
#pragma unroll
        for (int j = 0; j < 64; ++j) key[j] = (j < nj) ? fkey(sc[j * 64 + lane]) : 0u;
        unsigned prefix = 0u;
        for (int bit = 31; bit >= 0; --bit) {
            const unsigned cand = prefix | (1u << bit);
            int cnt = 0;
#pragma unroll
            for (int j4 = 0; j4 < 16; ++j4) {
                if (j4 * 4 < nj) {
#pragma unroll
                    for (int jj = 0; jj < 4; ++jj) cnt += __builtin_popcountll(__ballot(key[j4 * 4 + jj] >= cand));
                }
            }
            if (cnt >= TOPK) prefix = cand;
        }
        int cgt = 0;
#pragma unroll
        for (int j4 = 0; j4 < 16; ++j4) {
            if (j4 * 4 < nj) {
#pragma unroll
                for (int jj = 0; jj < 4; ++jj) cgt += __builtin_popcountll(__ballot(key[j4 * 4 + jj] > prefix));
            }
        }
        int need = TOPK - cgt, obase = 0;
        const unsigned long long lt = (1ull << lane) - 1ull;
#pragma unroll
        for (int j = 0; j < 64; ++j) {
            if (j < nj) {
                const bool gt = key[j] > prefix, eq = key[j] == prefix;
                const unsigned long long me = __ballot(eq);
                const int erank = __builtin_popcountll(me & lt);
                const bool take = gt || (eq && erank < need);
                const unsigned long long ms = __ballot(take);
                if (take) sel[obase + __builtin_popcountll(ms & lt)] = j * 64 + lane;
                obase += __builtin_popcountll(ms);
                const int ne = __builtin_popcountll(me); need -= (ne < need ? ne : need);
            }
        }
    }
}

__device__ __forceinline__ void naive_attn(float* lds, bf16* QL, const bf16* CN, const int* SEL, int vb, int nb) {
    float* qs = lds;
    float* att = lds + 16 * 512;
    int* sl = (int*)(att + 16 * 256);
    const int tid = threadIdx.x, lane = tid & 63, wid = tid >> 6;
    for (int t = vb; t < M; t += nb) {
        const int b = t / SEQ, pos = t % SEQ, nadm = ((pos >> 6) + 1) * 64, nsel = nadm < TOPK ? nadm : TOPK;
        __syncthreads();
        for (int i = tid; i < 16 * 512; i += NTHREADS) qs[i] = bf2f(QL[(size_t)t * 8192 + i]);
        if (tid < 256) sl[tid] = (tid < nsel) ? SEL[(size_t)t * TOPK + tid] : 0;
        __syncthreads();
        {
            const int k = tid & 255, hh = tid >> 8;
            float a[8];
#pragma unroll
            for (int i = 0; i < 8; ++i) a[i] = 0.f;
            if (k < nsel) {
                const u32x4* cp = (const u32x4*)(CN + (size_t)(b * SEQ + sl[k]) * CL);
                for (int c8 = 0; c8 < 64; ++c8) {
                    const u32x4 w = cp[c8]; float cv[8];
                    cv[0] = __uint_as_float(w.x << 16); cv[1] = __uint_as_float(w.x & 0xffff0000u); cv[2] = __uint_as_float(w.y << 16); cv[3] = __uint_as_float(w.y & 0xffff0000u);
                    cv[4] = __uint_as_float(w.z << 16); cv[5] = __uint_as_float(w.z & 0xffff0000u); cv[6] = __uint_as_float(w.w << 16); cv[7] = __uint_as_float(w.w & 0xffff0000u);
#pragma unroll
                    for (int i = 0; i < 8; ++i) { const float* qh = qs + (hh * 8 + i) * 512 + c8 * 8;
                        const f32x4 q0 = *(const f32x4*)qh, q1 = *(const f32x4*)(qh + 4);
                        a[i] += q0.x * cv[0] + q0.y * cv[1] + q0.z * cv[2] + q0.w * cv[3] + q1.x * cv[4] + q1.y * cv[5] + q1.z * cv[6] + q1.w * cv[7]; }
                }
            }
#pragma unroll
            for (int i = 0; i < 8; ++i) att[(hh * 8 + i) * 256 + k] = (k < nsel) ? a[i] * 0.08838834764831845f : -INFINITY;
        }
        __syncthreads();
        {
#pragma unroll
            for (int hi = 0; hi < 2; ++hi) { float* row = att + (wid * 2 + hi) * 256;
                float v[4]; float mx = -INFINITY;
#pragma unroll
                for (int i = 0; i < 4; ++i) { v[i] = row[lane + 64 * i]; mx = fmaxf(mx, v[i]); }
                mx = wave_max(mx); float s = 0.f;
#pragma unroll
                for (int i = 0; i < 4; ++i) { v[i] = __expf(v[i] - mx); s += v[i]; }
                s = wave_sum(s); const float inv = 1.f / s;
#pragma unroll
                for (int i = 0; i < 4; ++i) row[lane + 64 * i] = v[i] * inv; }
        }
        __syncthreads();
        {
            float o[16];
#pragma unroll
            for (int i = 0; i < 16; ++i) o[i] = 0.f;
            for (int k = 0; k < nsel; ++k) {
                const float cv = bf2f(CN[(size_t)(b * SEQ + sl[k]) * CL + tid]);
#pragma unroll
                for (int h = 0; h < 16; ++h) o[h] += att[h * 256 + k] * cv;
            }
#pragma unroll
            for (int h = 0; h < 16; ++h) QL[(size_t)t * 8192 + h * 512 + tid] = f2bf(o[h]);
        }
    }
}


typedef short bf16x8v __attribute__((ext_vector_type(8)));
typedef float f32x16 __attribute__((ext_vector_type(16)));
typedef short v4i16_t __attribute__((ext_vector_type(4)));
__device__ __forceinline__ void fast_scores(const bf16* QI, const bf16* KI, const float* WI, float* SC, int vb, int nb, int wave, int lane) {
    const int r = lane & 31, hi = lane >> 5;
    const int arow_tok = (r >> 2) & 1, arow_head = (r & 3) + 4 * (r >> 3);
    constexpr int NUNITS = 1152;
    for (int u = vb; u < NUNITS; u += nb) {
        int c = 63, rem = u >> 1; const int b = u & 1;
        for (;;) { const int n = 2 * ((c + 8) >> 3); if (rem < n) break; rem -= n; --c; }
        const int hf = rem & 1, sg = rem >> 1;
        const int pos0 = c * 64 + hf * 32 + wave * 4, t0 = b * SEQ + pos0;
        const int k_lo = sg * 512, k_hi = (k_lo + 512 < (c + 1) * 64) ? k_lo + 512 : (c + 1) * 64;
        bf16x8v af[2][4]; float wsc[2][16]; float* outp[2];
#pragma unroll
        for (int p = 0; p < 2; ++p) {
#pragma unroll
            for (int ks = 0; ks < 4; ++ks) af[p][ks] = *(const bf16x8v*)(QI + (size_t)(t0 + 2 * p + arow_tok) * 1024 + arow_head * 64 + ks * 16 + 8 * hi);
            const f32x4* wp = (const f32x4*)(WI + (size_t)(t0 + 2 * p + hi) * 16);
#pragma unroll
            for (int j = 0; j < 4; ++j) { const f32x4 w = wp[j]; wsc[p][4 * j] = w[0] * 0.03125f; wsc[p][4 * j + 1] = w[1] * 0.03125f; wsc[p][4 * j + 2] = w[2] * 0.03125f; wsc[p][4 * j + 3] = w[3] * 0.03125f; }
            outp[p] = SC + sc_off(b, pos0 + 2 * p + hi) + r;
        }
        const bf16* kbase = KI + (size_t)(b * SEQ + r) * 64 + 8 * hi;
        bf16x8v bfr[4], bnx[4];
#pragma unroll
        for (int ks = 0; ks < 4; ++ks) bfr[ks] = *(const bf16x8v*)(kbase + (size_t)k_lo * 64 + ks * 16);
        for (int k0 = k_lo; k0 < k_hi; k0 += 32) {
            const int kn = (k0 + 32 < k_hi) ? k0 + 32 : k0;
#pragma unroll
            for (int ks = 0; ks < 4; ++ks) bnx[ks] = *(const bf16x8v*)(kbase + (size_t)kn * 64 + ks * 16);
#pragma unroll
            for (int p = 0; p < 2; ++p) {
                f32x16 acc = {0.f, 0.f, 0.f, 0.f, 0.f, 0.f, 0.f, 0.f, 0.f, 0.f, 0.f, 0.f, 0.f, 0.f, 0.f, 0.f};
#pragma unroll
                for (int ks = 0; ks < 4; ++ks) acc = __builtin_amdgcn_mfma_f32_32x32x16_bf16(af[p][ks], bfr[ks], acc, 0, 0, 0);
                float s = 0.f;
#pragma unroll
                for (int h = 0; h < 16; ++h) s += fmaxf(acc[h], 0.f) * wsc[p][h];
                outp[p][k0] = s;
            }
#pragma unroll
            for (int ks = 0; ks < 4; ++ks) bfr[ks] = bnx[ks];
        }
    }
}

constexpr int AT_ROWB = 1040;
constexpr int AT_CB = 64 * AT_ROWB;
constexpr int AT_SP = 2 * AT_CB;
constexpr int AT_PB = AT_SP + 2 * 16 * 68 * 4;
constexpr int AT_AL = AT_PB + 16 * 72 * 2;
constexpr int AT_END = AT_AL + 128;
__device__ __forceinline__ int at_nsel(int t) { const int nadm = (((t & (SEQ - 1)) >> 6) + 1) * 64; return nadm < TOPK ? nadm : TOPK; }
__device__ __forceinline__ void at_gather(LAS unsigned char* buf, const bf16* CN, const int* SEL, int t, int ch, int wave, int lane) {
    const int nsel = at_nsel(t), bbase = (t >> 12) * SEQ;
    int idx = 0; { const int i = ch * 64 + wave * 8 + (lane & 7); if (i < nsel) idx = SEL[(size_t)t * TOPK + i]; }
#pragma unroll
    for (int i = 0; i < 8; ++i) { const int row = __builtin_amdgcn_readlane(idx, i);
        __builtin_amdgcn_global_load_lds((const unsigned*)(CN + (size_t)(bbase + row) * CL + lane * 8), (LAS unsigned*)(buf + (wave * 8 + i) * AT_ROWB), 16, 0, 0); }
}
__device__ __forceinline__ void fast_attn(LAS unsigned char* lds, bf16* QL, const bf16* CN, const int* SEL, int vb, int nb, int wave, int lane) {
    const int g = lane >> 4, l15 = lane & 15, kt = wave & 3, kh = wave >> 2;
    LAS float* Sp = (LAS float*)(lds + AT_SP); LAS bf16* Pb = (LAS bf16*)(lds + AT_PB); LAS float* AL = (LAS float*)(lds + AT_AL);
    int tok = vb, ch = 0, cur = 0;
    if (tok >= M) return;
    at_gather(lds, CN, SEL, tok, 0, wave, lane);
    bf16x8v qf[8];
    float m_run[2] = {-INFINITY, -INFINITY}, l_run[2] = {0.f, 0.f};
    f32x4 oacc[4];
    while (tok < M) {
        const int nsel = at_nsel(tok), nch = (nsel + 63) >> 6;
        int ntok = tok, nc = ch + 1; if (nc >= nch) { ntok = tok + nb; nc = 0; }
        LAS unsigned char* buf = lds + cur * AT_CB;
        if (ch == 0) {
#pragma unroll
            for (int ks = 0; ks < 8; ++ks) qf[ks] = *(const bf16x8v*)(QL + (size_t)tok * 8192 + l15 * 512 + kh * 256 + ks * 32 + 8 * g);
            m_run[0] = -INFINITY; m_run[1] = -INFINITY; l_run[0] = 0.f; l_run[1] = 0.f;
#pragma unroll
            for (int n = 0; n < 4; ++n) oacc[n] = (f32x4){0.f, 0.f, 0.f, 0.f};
        }
        asm volatile("s_waitcnt vmcnt(0) lgkmcnt(0)" ::: "memory"); __builtin_amdgcn_s_barrier(); asm volatile("" ::: "memory");
        if (ntok < M) at_gather(lds + (cur ^ 1) * AT_CB, CN, SEL, ntok, nc, wave, lane);
        {   f32x4 sacc = {0.f, 0.f, 0.f, 0.f};
            const LAS unsigned char* cb = buf + (kt * 16 + l15) * AT_ROWB + (kh * 256 + 8 * g) * 2;
#pragma unroll
            for (int ks = 0; ks < 8; ++ks) { const bf16x8v cf = *(const LAS bf16x8v*)(cb + ks * 64); sacc = __builtin_amdgcn_mfma_f32_16x16x32_bf16(cf, qf[ks], sacc, 0, 0, 0); }
            *(LAS f32x4*)(Sp + (kh * 16 + l15) * 68 + kt * 16 + 4 * g) = sacc;
        }
        asm volatile("s_waitcnt lgkmcnt(0)" ::: "memory"); __builtin_amdgcn_s_barrier(); asm volatile("" ::: "memory");
#pragma unroll
        for (int hh = 0; hh < 2; ++hh) { const int h = 2 * wave + hh;
            float s = (Sp[h * 68 + lane] + Sp[(16 + h) * 68 + lane]) * 0.12751743074602468f;
            if (ch * 64 + lane >= nsel) s = -INFINITY;
            const float mn = fmaxf(m_run[hh], wave_max(s));
            const float alpha = __builtin_amdgcn_exp2f(m_run[hh] - mn), p = __builtin_amdgcn_exp2f(s - mn);
            l_run[hh] = l_run[hh] * alpha + wave_sum(p); m_run[hh] = mn;
            Pb[h * 72 + lane] = f2bf(p);
            if (lane == 0) AL[h] = alpha; }
        asm volatile("s_waitcnt lgkmcnt(0)" ::: "memory"); __builtin_amdgcn_s_barrier(); asm volatile("" ::: "memory");
        {   const float al = AL[l15];
#pragma unroll
            for (int n = 0; n < 4; ++n) oacc[n] = oacc[n] * al;
            bf16x8v pf[2];
#pragma unroll
            for (int ks = 0; ks < 2; ++ks) pf[ks] = *(const LAS bf16x8v*)((const LAS unsigned char*)Pb + l15 * 144 + (32 * ks + 8 * g) * 2);
            const LAS unsigned char* tb = buf + (8 * g + (l15 >> 2)) * AT_ROWB + (64 * wave + 4 * (l15 & 3)) * 2;
#pragma unroll
            for (int n = 0; n < 4; ++n)
#pragma unroll
                for (int ks = 0; ks < 2; ++ks) {
                    const v4i16_t t0 = __builtin_amdgcn_ds_read_tr16_b64_v4i16((LAS v4i16_t*)(tb + (32 * ks) * AT_ROWB + n * 32));
                    const v4i16_t t1 = __builtin_amdgcn_ds_read_tr16_b64_v4i16((LAS v4i16_t*)(tb + (32 * ks + 4) * AT_ROWB + n * 32));
                    const bf16x8v cf = {t0[0], t0[1], t0[2], t0[3], t1[0], t1[1], t1[2], t1[3]};
                    oacc[n] = __builtin_amdgcn_mfma_f32_16x16x32_bf16(cf, pf[ks], oacc[n], 0, 0, 0);
                }
        }
        if (nc == 0) {
            if (lane == 0) { AL[16 + 2 * wave] = 1.f / l_run[0]; AL[16 + 2 * wave + 1] = 1.f / l_run[1]; }
            asm volatile("s_waitcnt lgkmcnt(0)" ::: "memory"); __builtin_amdgcn_s_barrier(); asm volatile("" ::: "memory");
            const float li = AL[16 + l15];
            bf16* op = QL + (size_t)tok * 8192 + l15 * 512 + 64 * wave + 4 * g;
#pragma unroll
            for (int n = 0; n < 4; ++n) { const f32x4 o = oacc[n] * li; u32x2 w; w.x = pk2(o[0], o[1]); w.y = pk2(o[2], o[3]); *(u32x2*)(op + 16 * n) = w; }
        }
        tok = ntok; ch = nc; cur ^= 1;
    }
    asm volatile("s_waitcnt vmcnt(0) lgkmcnt(0)" ::: "memory"); __builtin_amdgcn_s_barrier();
}

#ifdef NAIVEMASK
template <bool DUAL, class Epi>
__device__ __forceinline__ void naive_gemm(float* lds, const bf16* A, int lda, const float* W, const float* W2, int ldw, const float* kscale,
                                           int Mrows, int N, int K, const Epi& epi, int vb, int nb) {
    float* As = lds;
    float* Ws = lds + 16 * 132;
    float* Ws2 = lds + 32 * 132;
    const int tid = threadIdx.x, tx = tid & 31, ty = tid >> 5;
    const int ntn = (N + 127) / 128, ntm = Mrows / 128;
    for (int tile = vb; tile < ntm * ntn; tile += nb) {
        const int tm = tile / ntn, tn = tile % ntn;
        const int row0 = tm * 128, col0 = tn * 128;
        float acc[8][4], acc2[8][4];
#pragma unroll
        for (int i = 0; i < 8; ++i)
#pragma unroll
            for (int j = 0; j < 4; ++j) { acc[i][j] = 0.f; acc2[i][j] = 0.f; }
        for (int k0 = 0; k0 < K; k0 += 16) {
            {
                const int r = tid >> 2, k4 = (tid & 3) * 4;
                const u32x2 raw = *(const u32x2*)(A + (size_t)(row0 + r) * lda + k0 + k4);
                As[(k4 + 0) * 132 + r] = __uint_as_float(raw.x << 16);
                As[(k4 + 1) * 132 + r] = __uint_as_float(raw.x & 0xffff0000u);
                As[(k4 + 2) * 132 + r] = __uint_as_float(raw.y << 16);
                As[(k4 + 3) * 132 + r] = __uint_as_float(raw.y & 0xffff0000u);
            }
            {
                const int k = tid >> 5, c4 = (tid & 31) * 4;
                f32x4 w = {0.f, 0.f, 0.f, 0.f}, w2 = {0.f, 0.f, 0.f, 0.f};
                if (col0 + c4 < N) {
                    w = *(const f32x4*)(W + (size_t)(k0 + k) * ldw + col0 + c4);
                    if (DUAL) w2 = *(const f32x4*)(W2 + (size_t)(k0 + k) * ldw + col0 + c4);
                    if (kscale) { const float s = kscale[k0 + k]; w = w * s; w2 = w2 * s; }
                }
                *(f32x4*)(Ws + k * 132 + c4) = w;
                if (DUAL) *(f32x4*)(Ws2 + k * 132 + c4) = w2;
            }
            __syncthreads();
#pragma unroll
            for (int k = 0; k < 16; ++k) {
                const f32x4 a0 = *(const f32x4*)(As + k * 132 + ty * 8), a1 = *(const f32x4*)(As + k * 132 + ty * 8 + 4);
                const f32x4 w = *(const f32x4*)(Ws + k * 132 + tx * 4);
                const float a[8] = {a0.x, a0.y, a0.z, a0.w, a1.x, a1.y, a1.z, a1.w};
#pragma unroll
                for (int i = 0; i < 8; ++i) { acc[i][0] += a[i] * w.x; acc[i][1] += a[i] * w.y; acc[i][2] += a[i] * w.z; acc[i][3] += a[i] * w.w; }
                if (DUAL) {
                    const f32x4 w2 = *(const f32x4*)(Ws2 + k * 132 + tx * 4);
#pragma unroll
                    for (int i = 0; i < 8; ++i) { acc2[i][0] += a[i] * w2.x; acc2[i][1] += a[i] * w2.y; acc2[i][2] += a[i] * w2.z; acc2[i][3] += a[i] * w2.w; }
                }
            }
            __syncthreads();
        }
#pragma unroll
        for (int i = 0; i < 8; ++i)
#pragma unroll
            for (int j = 0; j < 4; ++j) { const int r = row0 + ty * 8 + i, c = col0 + tx * 4 + j; if (c < N) epi(r, c, acc[i][j], acc2[i][j]); }
    }
}

struct EpiProj {
    bf16 *U, *V, *Q, *QI, *KI, *GA, *GB; float *CKR, *WI; int coff;
    __device__ __forceinline__ void operator()(int r, int c, float v, float) const {
        c += coff;
        if (c < 2048) U[(size_t)r * 2048 + c] = f2bf(gelu_tanh(v));
        else if (c < 4096) V[(size_t)r * 2048 + c - 2048] = f2bf(gelu_tanh(v));
        else if (c < 6144) Q[(size_t)r * 2048 + c - 4096] = f2bf(v);
        else if (c < 6656) CKR[(size_t)r * 512 + c - 6144] = v;
        else if (c < 7680) QI[(size_t)r * 1024 + c - 6656] = f2bf(v);
        else if (c < 7744) KI[(size_t)r * 64 + c - 7680] = f2bf(v);
        else if (c < 7760) WI[(size_t)r * 16 + c - 7744] = v;
        else if (c < 9808) GA[(size_t)r * 2048 + c - 7760] = f2bf(sigmoidf(v));
        else GB[(size_t)r * 2048 + c - 9808] = f2bf(sigmoidf(v));
    }
};
struct EpiGateA {
    bf16* GA;
    __device__ __forceinline__ void operator()(int r, int c, float v, float) const { const size_t i = (size_t)r * 2048 + c; GA[i] = f2bf(bf2f(GA[i]) * v); }
};
struct EpiGateB {
    bf16* TMP; const bf16* GB;
    __device__ __forceinline__ void operator()(int r, int c, float v, float) const { const size_t i = (size_t)r * 2048 + c; TMP[i] = f2bf(bf2f(TMP[i]) + bf2f(GB[i]) * v); }
};
struct EpiRes {
    const float* X; float* H; bf16* HB;
    __device__ __forceinline__ void operator()(int r, int c, float v, float) const { const size_t i = (size_t)r * 2048 + c; const float h = X[i] + v; H[i] = h; HB[i] = f2bf(h); }
};
struct EpiSwiglu {
    const float* HST; bf16* FFo;
    __device__ __forceinline__ void operator()(int r, int c, float g, float u) const {
        float ss = 0.f;
        for (int j = 0; j < 32; ++j) ss += HST[(size_t)r * 32 + j];
        const float rs = rsqrtf(ss * (1.f / D) + EPS);
        const float gg = g * rs, uu = u * rs;
        FFo[(size_t)r * FF + c] = f2bf(gg * sigmoidf(gg) * uu);
    }
};
struct EpiRes2 {
    float* H;
    __device__ __forceinline__ void operator()(int r, int c, float v, float) const { const size_t i = (size_t)r * 2048 + c; H[i] = H[i] + v; }
};

__device__ __forceinline__ void rows_vst(const bf16* V, float* VST, int gw, int ngw, int lane) {
    for (int m = gw; m < M; m += ngw) {
        const int j = lane >> 1, hf = lane & 1;
        const u32x4* p = (const u32x4*)(V + (size_t)m * D + j * 64 + hf * 32);
        float s = 0.f, q = 0.f;
#pragma unroll
        for (int i = 0; i < 4; ++i) { const u32x4 w = p[i]; const unsigned ww[4] = {w.x, w.y, w.z, w.w};
#pragma unroll
            for (int e = 0; e < 4; ++e) { const float a = __uint_as_float(ww[e] << 16), b = __uint_as_float(ww[e] & 0xffff0000u); s += a + b; q += a * a + b * b; } }
        s += __shfl_xor(s, 1); q += __shfl_xor(q, 1);
        if (hf == 0) { VST[((size_t)m * 32 + j) * 2] = s; VST[((size_t)m * 32 + j) * 2 + 1] = q; }
    }
}
__device__ __forceinline__ void rows_hst(const float* H, float* HST, int gw, int ngw, int lane) {
    for (int m = gw; m < M; m += ngw) {
        const int j = lane >> 1, hf = lane & 1;
        const f32x4* p = (const f32x4*)(H + (size_t)m * D + j * 64 + hf * 32);
        float q = 0.f;
#pragma unroll
        for (int i = 0; i < 8; ++i) { const f32x4 w = p[i]; q += w.x * w.x + w.y * w.y + w.z * w.z + w.w * w.w; }
        q += __shfl_xor(q, 1);
        if (hf == 0) HST[(size_t)m * 32 + j] = q;
    }
}
__device__ __forceinline__ void naive_qlat(float* lds, const bf16* Q, const float* w_uk, bf16* QL, int vb, int nb) {
    float* qs = lds;
    const int tid = threadIdx.x;
    for (int unit = vb; unit < (M / 32) * NH; unit += nb) {
        const int h = unit % NH, t0 = (unit / NH) * 32;
        __syncthreads();
        for (int i = tid; i < 32 * 128; i += NTHREADS) qs[i] = bf2f(Q[(size_t)(t0 + (i >> 7)) * D + h * 128 + (i & 127)]);
        __syncthreads();
        float acc[32];
#pragma unroll
        for (int i = 0; i < 32; ++i) acc[i] = 0.f;
        const f32x4* wr = (const f32x4*)(w_uk + (size_t)tid * 2048 + h * 128);
        for (int d4 = 0; d4 < 32; ++d4) {
            const f32x4 w = wr[d4];
#pragma unroll
            for (int i = 0; i < 32; ++i) { const f32x4 q = *(const f32x4*)(qs + i * 128 + d4 * 4); acc[i] += w.x * q.x + w.y * q.y + w.z * q.z + w.w * q.w; }
        }
#pragma unroll
        for (int i = 0; i < 32; ++i) QL[((size_t)(t0 + i) * NH + h) * CL + tid] = f2bf(acc[i]);
    }
}
__device__ __forceinline__ void naive_yb(float* lds, const bf16* OL, const float* w_uv, bf16* YB, int vb, int nb) {
    float* os = lds;
    const int tid = threadIdx.x, d = tid & 127, tq = tid >> 7;
    for (int unit = vb; unit < (M / 32) * NH; unit += nb) {
        const int h = unit % NH, t0 = (unit / NH) * 32;
        __syncthreads();
        for (int i = tid; i < 32 * 512; i += NTHREADS) os[i] = bf2f(OL[((size_t)(t0 + (i >> 9)) * NH + h) * CL + (i & 511)]);
        __syncthreads();
        float acc[8];
#pragma unroll
        for (int i = 0; i < 8; ++i) acc[i] = 0.f;
        for (int c = 0; c < CL; ++c) {
            const float w = w_uv[(size_t)c * 2048 + h * 128 + d];
#pragma unroll
            for (int i = 0; i < 8; ++i) acc[i] += w * os[(tq * 8 + i) * 512 + c];
        }
#pragma unroll
        for (int i = 0; i < 8; ++i) YB[(size_t)(t0 + tq * 8 + i) * D + h * 128 + d] = f2bf(acc[i]);
    }
}

#endif
#define XB_TMO      128
#define XB_XCNT(j)  (256  + 64 * (j))
#define XB_XSUB(j)  (1280 + 64 * (j))
#define XB_XGEN(j)  (2304 + 64 * (j))
#define XB_TOP      3328
#define XB_TOPGEN   3392
#define XCD_BAR_WORDS 3456
#define XB_SPIN_CAP (1u << 18)

__device__ __forceinline__ unsigned xb_ld(unsigned* p)              { return __hip_atomic_load(p, __ATOMIC_RELAXED, __HIP_MEMORY_SCOPE_AGENT); }
__device__ __forceinline__ unsigned xb_add(unsigned* p, unsigned v) { return __hip_atomic_fetch_add(p, v, __ATOMIC_RELAXED, __HIP_MEMORY_SCOPE_AGENT); }
__device__ __forceinline__ unsigned xb_xcc_id() { return (unsigned)__builtin_amdgcn_s_getreg((3 << 11) | 20) & 0xFu; }
#define XB_SPIN(cond, bar) do { unsigned _sp = 0; while (cond) { __builtin_amdgcn_s_sleep(1); \
    if ((++_sp & 255u) == 0u) { if (xb_ld(&(bar)[XB_TMO])) break; if (_sp > XB_SPIN_CAP) { atomicAdd(&(bar)[XB_TMO], 1u); break; } } } } while (0)

struct XcdBarrier {
    unsigned* bar; unsigned x;
    volatile LAS unsigned* st;
};

__device__ __forceinline__ XcdBarrier xcd_barrier_post(unsigned* bar, volatile LAS unsigned* st) {
    XcdBarrier b; b.bar = bar; b.x = xb_xcc_id(); b.st = st;
    if (threadIdx.x == 0) (void)xb_add(&bar[XB_XCNT(b.x)], 1u);
    return b;
}
__device__ __forceinline__ void xcd_barrier_complete(unsigned* bar, unsigned x, unsigned& nloc, unsigned& nx) {
    const unsigned G = gridDim.x * gridDim.y * gridDim.z;
    unsigned sum, cnt, mine, sp = 0u;
    for (;;) {
        sum = 0u; cnt = 0u; mine = 0u;
#pragma unroll
        for (unsigned j = 0; j < 16; ++j) { const unsigned c = xb_ld(&bar[XB_XCNT(j)]); sum += c; cnt += (c > 0u) ? 1u : 0u; mine = (j == x) ? c : mine; }
        if (sum == G) break;
        __builtin_amdgcn_s_sleep(1);
        if ((++sp & 255u) == 0u) { if (xb_ld(&bar[XB_TMO])) break; if (sp > XB_SPIN_CAP) { atomicAdd(&bar[XB_TMO], 1u); break; } }
    }
    nloc = mine > 0u ? mine : 1u; nx = cnt > 0u ? cnt : 1u;
}

__device__ __forceinline__ void xcd_barrier(const XcdBarrier& b) {
    asm volatile("s_waitcnt vmcnt(0)" ::: "memory");
    __syncthreads();
    if (threadIdx.x == 0) {
        unsigned* bar = b.bar;
        __builtin_amdgcn_s_waitcnt(0);
        unsigned nloc = b.st[0], nx = b.st[1];
        if (nloc == 0u) { xcd_barrier_complete(bar, b.x, nloc, nx); b.st[0] = nloc; b.st[1] = nx; }
        const unsigned old = xb_add(&bar[XB_XSUB(b.x)], 1u);
        const unsigned gen = old / nloc;
        if (old + 1u == (gen + 1u) * nloc) {
            __builtin_amdgcn_fence(__ATOMIC_RELEASE, "agent");
            asm volatile("s_waitcnt vmcnt(0)" ::: "memory");
            const unsigned og = xb_add(&bar[XB_TOP], 1u);
            const unsigned tg = og / nx;
            if (og + 1u == (tg + 1u) * nx) xb_add(&bar[XB_TOPGEN], 1u);
            else XB_SPIN(xb_ld(&bar[XB_TOPGEN]) == tg, bar);
            __builtin_amdgcn_fence(__ATOMIC_ACQUIRE, "agent");
            xb_add(&bar[XB_XGEN(b.x)], 1u);
            asm volatile("s_waitcnt vmcnt(0)" ::: "memory");
        } else {
            XB_SPIN(xb_ld(&bar[XB_XGEN(b.x)]) == gen, bar);
            __builtin_amdgcn_fence(__ATOMIC_ACQUIRE, "agent");
            asm volatile("s_waitcnt vmcnt(0)" ::: "memory");
        }
    }
    __syncthreads();
}

#define LDS_WAIT() asm volatile("s_waitcnt lgkmcnt(0)" ::: "memory")
#define VM_WAIT() asm volatile("s_waitcnt vmcnt(0)" ::: "memory")
template <class ColMap>
__device__ __forceinline__ void transpose_item(const float* W, int ldw, int ks0, bf16* WT, int ldd, int kd0, int n0, const ColMap& cm, const float* kscale, LAS float* scr, int lane) {
    const int sc = cm(n0 + (lane & 31));
#pragma unroll 8
    for (int i = 0; i < 32; ++i) { const int kk = 2 * i + (lane >> 5); float v = 0.f;
        if (sc >= 0) { v = W[(size_t)(ks0 + kk) * ldw + sc]; if (kscale) v *= kscale[ks0 + kk]; }
        scr[kk * 33 + (lane & 31)] = v; }
    LDS_WAIT(); asm volatile("" ::: "memory");
    const int c = lane & 7;
#pragma unroll
    for (int j = 0; j < 4; ++j) { const int n = (lane >> 3) + 8 * j; const LAS float* s = scr + (8 * c) * 33 + n;
        u32x4 o; o.x = pk2(s[0 * 33], s[1 * 33]); o.y = pk2(s[2 * 33], s[3 * 33]); o.z = pk2(s[4 * 33], s[5 * 33]); o.w = pk2(s[6 * 33], s[7 * 33]);
        *(u32x4*)(WT + (size_t)(n0 + n) * ldd + kd0 + 8 * c) = o; }
    LDS_WAIT(); asm volatile("" ::: "memory");
}
struct CmIdent { __device__ __forceinline__ int operator()(int n) const { return n; } };
struct CmWin { __device__ __forceinline__ int operator()(int n) const { return n < 7760 ? n : (n < 7936 ? -1 : n - 176); } };
struct CmGU { __device__ __forceinline__ int operator()(int n) const { return (n >> 8) * 128 + (n & 127); } };

__device__ __forceinline__ void p0_prologue(LAS unsigned char* lds, const float* x, const float* norm1_g, const float* w_in, const float* w_uk, const float* w_uv,
                                            const float* w_oa, const float* w_ob, const float* w_out, bf16* XN, bf16* WIN, bf16* WUK, bf16* WUV, bf16* WOA, bf16* WOB, bf16* WOUT,
                                            int gw, int ngw, int wave, int lane) {
    LAS float* scr = (LAS float*)(lds + wave * 16384);
    constexpr int I_IN = 32 * (NINP / 32), I_SQ = 32 * 64, I_UV = 16 * 64;
    constexpr int NITEMS = I_IN + 3 * I_SQ + I_UV;
    for (int it = gw; it < NITEMS; it += ngw) {
        int r = it;
        if (r < I_IN) { const int nb = r % (NINP / 32), kb = r / (NINP / 32); transpose_item(w_in, NIN, kb * 64, WIN, D, kb * 64, nb * 32, CmWin(), nullptr, scr, lane); continue; } r -= I_IN;
        if (r < I_SQ) { transpose_item(w_oa, D, (r / 64) * 64, WOA, D, (r / 64) * 64, (r % 64) * 32, CmIdent(), nullptr, scr, lane); continue; } r -= I_SQ;
        if (r < I_SQ) { transpose_item(w_ob, D, (r / 64) * 64, WOB, D, (r / 64) * 64, (r % 64) * 32, CmIdent(), nullptr, scr, lane); continue; } r -= I_SQ;
        if (r < I_SQ) { transpose_item(w_out, D, (r / 64) * 64, WOUT, D, (r / 64) * 64, (r % 64) * 32, CmIdent(), nullptr, scr, lane); continue; } r -= I_SQ;
        {
            const int nb = r % 64, kb = r / 64, h = nb >> 2; const bool data = (kb >> 3) == (h & 1);
            if (data) transpose_item(w_uv, D, (kb & 7) * 64, WUV, 1024, kb * 64, nb * 32, CmIdent(), nullptr, scr, lane);
            else { const int c = lane & 7;
#pragma unroll
                for (int j = 0; j < 4; ++j) { const int n = (lane >> 3) + 8 * j; *(u32x4*)(WUV + (size_t)(nb * 32 + n) * 1024 + kb * 64 + 8 * c) = (u32x4){0u, 0u, 0u, 0u}; } }
        }
    }
    for (int i = gw * 64 + lane; i < 16 * 512 * 16; i += ngw * 64) { const int d8 = i & 15, c = (i >> 4) & 511, h = i >> 13;
        const f32x4* s = (const f32x4*)(w_uk + (size_t)c * 2048 + h * 128 + d8 * 8); const f32x4 a = s[0], b = s[1];
        u32x4 o; o.x = pk2(a[0], a[1]); o.y = pk2(a[2], a[3]); o.z = pk2(b[0], b[1]); o.w = pk2(b[2], b[3]);
        *(u32x4*)(WUK + ((size_t)h * 512 + c) * 128 + d8 * 8) = o; }
    rows_xn(x, norm1_g, XN, gw, ngw, lane);
}
__device__ __forceinline__ void p_convert_ffn(LAS unsigned char* lds, const float* w_fg, const float* w_fu, const float* w_fd, const float* norm2_g, bf16* WGU, bf16* WD, int gw, int ngw, int wave, int lane) {
    LAS float* scr = (LAS float*)(lds + wave * 16384);
    constexpr int I_GU = 32 * (11264 / 32), I_D = 88 * 64;
    for (int it = gw; it < I_GU + I_D; it += ngw) {
        int r = it;
        if (r < I_GU) { const int nb = r % 352, kb = r / 352; const bool up = ((nb * 32) & 128) != 0;
            transpose_item(up ? w_fu : w_fg, FF, kb * 64, WGU, D, kb * 64, nb * 32, CmGU(), norm2_g, scr, lane); continue; } r -= I_GU;
        transpose_item(w_fd, D, (r / 64) * 64, WD, FF, (r / 64) * 64, (r % 64) * 32, CmIdent(), nullptr, scr, lane);
    }
}


#define P_X ((const float*)ka->in[0])
#define P_NORM1 ((const float*)ka->in[1])
#define P_WIN_F ((const float*)ka->in[2])
#define P_LNG ((const float*)ka->in[3])
#define P_LNB ((const float*)ka->in[4])
#define P_WS_F ((const float*)ka->in[5])
#define P_BS_F ((const float*)ka->in[6])
#define P_KVG ((const float*)ka->in[7])
#define P_WUK_F ((const float*)ka->in[8])
#define P_WUV_F ((const float*)ka->in[9])
#define P_WOA_F ((const float*)ka->in[10])
#define P_WOB_F ((const float*)ka->in[11])
#define P_WOUT_F ((const float*)ka->in[12])
#define P_NORM2 ((const float*)ka->in[13])
#define P_WFG ((const float*)ka->in[14])
#define P_WFU ((const float*)ka->in[15])
#define P_WFD ((const float*)ka->in[16])
#define P_FING ((const float*)ka->in[17])
#define B16(off) ((bf16*)(ws + (off)))
#define F32(off) ((float*)(ws + (off)))
constexpr int CW_BAR = 4096;
struct Args { const float* in[18]; float* out; unsigned char* ws; int ph_lo, ph_hi, use_bar, pad; };
constexpr int N_PHASES = 12;

template <int ONLY> __global__ void __launch_bounds__(NTHREADS, 2) mk_fwd(Args a) {
    extern __shared__ __attribute__((aligned(16))) unsigned char lds_g[];
    LAS unsigned char* lds = (LAS unsigned char*)lds_g;
    float* ldsf = (float*)lds_g;
    const int tid = threadIdx.x, lane = tid & 63, wave = __builtin_amdgcn_readfirstlane(tid >> 6);
    const int G = gridDim.x, vb = blockIdx.x;
    const int gw = vb * NWAVES + wave, ngw = G * NWAVES;
    const __attribute__((address_space(4))) Args* ka = (const __attribute__((address_space(4))) Args*)__builtin_amdgcn_kernarg_segment_ptr();
    unsigned char* const ws = a.ws;
    for (int u = tid; u < (LDS_BYTES - LDSCTL_OFF) / 4; u += NTHREADS) ((LAS unsigned*)(lds + LDSCTL_OFF))[u] = 0u;
    __syncthreads();
    XcdBarrier bar; bar.bar = (unsigned*)(ws + WS_CTL) + CW_BAR; bar.x = 0; bar.st = nullptr;
    if (a.use_bar) bar = xcd_barrier_post((unsigned*)(ws + WS_CTL) + CW_BAR, (volatile LAS unsigned*)(lds + MISC_OFF) + 8);
    const int lo = a.ph_lo, hi = a.ph_hi;
#ifndef SKIPMASK
#define SKIPMASK 0
#endif
#define IN(k) (!((SKIPMASK >> (k)) & 1) && (ONLY < 0 || ONLY == (k)) && lo <= (k) && (k) < hi)
#define SEAM(k) do { if (IN(k) && IN((k) + 1)) xcd_barrier(bar); } while (0)

    if (IN(0)) { p0_prologue(lds, P_X, P_NORM1, P_WIN_F, P_WUK_F, P_WUV_F, P_WOA_F, P_WOB_F, P_WOUT_F, B16(WS_XN), B16(WS_WIN), B16(WS_WUK), B16(WS_WUV), B16(WS_WOA), B16(WS_WOB), B16(WS_WOUT), gw, ngw, wave, lane); }
    SEAM(0);
#if defined(NAIVEMASK) && (NAIVEMASK & (1 << 1))
    if (IN(1)) { EpiProj e{B16(WS_U), B16(WS_V), B16(WS_Q), B16(WS_QI), B16(WS_KI), B16(WS_GA), B16(WS_GB), F32(WS_CKR), F32(WS_WI), 0}; naive_gemm<false>(ldsf, B16(WS_XN), D, P_WIN_F, nullptr, NIN, nullptr, M, NIN, D, e, vb, G); }
#else
    if (IN(1)) { pg8::Gemm g{B16(WS_XN), B16(WS_WIN), D, D, D}; pg8::StaticOrder S; S.init(M, NINP, G, vb);
        pg8::EpiProjF E{ws};
        pg8::gemm_phase<pg8::EpiProjF, pg8::StaticOrder, true, true>(lds, g, S, E); }
#endif
    SEAM(1);
#if defined(NAIVEMASK)
    if (ONLY == 101) { rows_vst(B16(WS_V), F32(WS_VST), gw, ngw, lane); }
    if (ONLY == 102) { rows_hst(ka->out, F32(WS_HST), gw, ngw, lane); }
#endif
    if (IN(2)) { rows_cn(F32(WS_CKR), P_KVG, B16(WS_CN), gw, ngw, lane); naive_gating(ldsf, B16(WS_U), B16(WS_V), F32(WS_VST), P_LNG, P_LNB, P_WS_F, P_BS_F, vb, G); fast_scores(B16(WS_QI), B16(WS_KI), F32(WS_WI), F32(WS_SC), vb, G, wave, lane); __syncthreads(); }
    SEAM(2);
#if defined(NAIVEMASK) && (NAIVEMASK & (1 << 3))
    if (IN(3)) { EpiGateA e{B16(WS_GA)}; naive_gemm<false>(ldsf, B16(WS_U), D, P_WOA_F, nullptr, D, nullptr, M, D, D, e, vb, G); topk_rows(F32(WS_SC), (int*)(ws + WS_SEL), gw, ngw, lane); }
#else
    if (IN(3)) { pg8::Gemm g{B16(WS_U), B16(WS_WOA), D, D, D}; pg8::StaticOrder S; S.init(M, D, G, vb); pg8::EpiGateAF E{B16(WS_GA)};
        pg8::gemm_phase<pg8::EpiGateAF, pg8::StaticOrder, true, true>(lds, g, S, E);
        topk_rows(F32(WS_SC), (int*)(ws + WS_SEL), gw, ngw, lane); }
#endif
    SEAM(3);
#if defined(NAIVEMASK) && (NAIVEMASK & (1 << 4))
    if (IN(4)) { naive_qlat(ldsf, B16(WS_Q), P_WUK_F, B16(WS_QL), vb, G); }
#else
    if (IN(4)) { int kq = 128; asm volatile("" : "+s"(kq)); pg8::Gemm g{B16(WS_Q), B16(WS_WUK), D, 128, kq}; pg8::HeadOrderQ S{G, vb}; pg8::EpiQlatF E{B16(WS_QL)};
        pg8::gemm_phase<pg8::EpiQlatF, pg8::HeadOrderQ, true, true>(lds, g, S, E); }
#endif
    SEAM(4);
    if (IN(5)) { fast_attn(lds, B16(WS_QL), B16(WS_CN), (const int*)(ws + WS_SEL), vb, G, wave, lane); __syncthreads(); }
    SEAM(5);
#if defined(NAIVEMASK) && (NAIVEMASK & (1 << 6))
    if (IN(6)) { naive_yb(ldsf, B16(WS_QL), P_WUV_F, B16(WS_Q), vb, G); }
#else
    if (IN(6)) { pg8::Gemm g{B16(WS_QL), B16(WS_WUV), 8192, 1024, 1024}; pg8::PairOrderYB S{G, vb}; pg8::EpiPlainF E{B16(WS_Q), D};
        pg8::gemm_phase<pg8::EpiPlainF, pg8::PairOrderYB, true, true>(lds, g, S, E); }
#endif
    SEAM(6);
#if defined(NAIVEMASK) && (NAIVEMASK & (1 << 7))
    if (IN(7)) { EpiGateB e{B16(WS_GA), B16(WS_GB)}; naive_gemm<false>(ldsf, B16(WS_Q), D, P_WOB_F, nullptr, D, nullptr, M, D, D, e, vb, G); p_convert_ffn(lds, P_WFG, P_WFU, P_WFD, P_NORM2, B16(WS_WGU), B16(WS_WD), gw, ngw, wave, lane); }
#else
    if (IN(7)) { pg8::Gemm g{B16(WS_Q), B16(WS_WOB), D, D, D}; pg8::StaticOrder S; S.init(M, D, G, vb); pg8::EpiGateBF E{B16(WS_GA), B16(WS_GB)};
        pg8::gemm_phase<pg8::EpiGateBF, pg8::StaticOrder, true, true>(lds, g, S, E);
        p_convert_ffn(lds, P_WFG, P_WFU, P_WFD, P_NORM2, B16(WS_WGU), B16(WS_WD), gw, ngw, wave, lane); }
#endif
    SEAM(7);
#if defined(NAIVEMASK) && (NAIVEMASK & (1 << 8))
    if (IN(8)) { EpiRes e{P_X, ka->out, B16(WS_HB)}; naive_gemm<false>(ldsf, B16(WS_GA), D, P_WOUT_F, nullptr, D, nullptr, M, D, D, e, vb, G); }
#else
    if (IN(8)) { pg8::Gemm g{B16(WS_GA), B16(WS_WOUT), D, D, D}; pg8::StaticOrder S; S.init(M, D, G, vb); pg8::EpiResF E{P_X, ka->out, B16(WS_HB), F32(WS_HST)};
        pg8::gemm_phase<pg8::EpiResF, pg8::StaticOrder, true, true>(lds, g, S, E); }
#endif
    SEAM(8);
#if defined(NAIVEMASK) && (NAIVEMASK & (1 << 9))
    if (IN(9)) { EpiSwiglu e{F32(WS_HST), B16(WS_FF)}; naive_gemm<true>(ldsf, B16(WS_HB), D, P_WFG, P_WFU, FF, P_NORM2, M, FF, D, e, vb, G); }
#else
    if (IN(9)) { pg8::Gemm g{B16(WS_HB), B16(WS_WGU), D, D, D}; pg8::StaticOrder S; S.init(M, 11264, G, vb); pg8::EpiSwigluF E{F32(WS_HST), B16(WS_FF)};
        pg8::gemm_phase<pg8::EpiSwigluF, pg8::StaticOrder, true, true>(lds, g, S, E); }
#endif
    SEAM(9);
#if defined(NAIVEMASK) && (NAIVEMASK & (1 << 10))
    if (IN(10)) { EpiRes2 e{ka->out}; naive_gemm<false>(ldsf, B16(WS_FF), FF, P_WFD, nullptr, D, nullptr, M, D, FF, e, vb, G); }
#else
    if (IN(10)) { pg8::Gemm g{B16(WS_FF), B16(WS_WD), FF, FF, FF}; pg8::StaticOrder S; S.init(M, D, G, vb); pg8::EpiRes2F E{ka->out};
        pg8::gemm_phase<pg8::EpiRes2F, pg8::StaticOrder, true, true>(lds, g, S, E); }
#endif
    SEAM(10);
    if (IN(11)) rows_final(ka->out, P_FING, gw, ngw, lane);
#undef IN
#undef SEAM
}

#ifndef MK_N_LAUNCHES
#define MK_N_LAUNCHES 1
#endif

template <int P> static void launch_one(int grid, Args a, hipStream_t stream) {
    static bool attr = false;
    if (!attr) { (void)hipFuncSetAttribute((const void*)mk_fwd<P>, hipFuncAttributeMaxDynamicSharedMemorySize, LDS_BYTES); attr = true; }
    a.ph_lo = (P < 0 || P > 99) ? 0 : P; a.ph_hi = (P < 0) ? N_PHASES : ((P > 99) ? 0 : P + 1); a.use_bar = (P < 0) ? 1 : 0;
    hipLaunchKernelGGL(mk_fwd<P>, dim3(grid), dim3(NTHREADS), LDS_BYTES, stream, a);
}
extern "C" void kernel_launch(void* const* d_in, const int* in_sizes, int n_in, void* d_out, int out_size, void* d_ws, size_t ws_size, hipStream_t stream) {
    static int grid = 0;
    if (grid == 0) {
        if (n_in != 18 || out_size != M * D || ws_size < WS_END) { fprintf(stderr, "kernel_launch: unexpected shapes n_in %d out %d ws %zu\n", n_in, out_size, ws_size); grid = -1; return; }
        int dev = 0, cus = 0;
        (void)hipGetDevice(&dev); (void)hipDeviceGetAttribute(&cus, hipDeviceAttributeMultiprocessorCount, dev);
        grid = cus > 0 ? cus : 256;
    }
    if (grid < 0) return;
    (void)hipMemsetAsync((char*)d_ws + WS_CTL, 0, CTL_ZERO_BYTES, stream);
    Args a{};
    for (int i = 0; i < 18; ++i) a.in[i] = (const float*)d_in[i];
    a.out = (float*)d_out; a.ws = (unsigned char*)d_ws;
#if MK_N_LAUNCHES == 1
    launch_one<-1>(grid, a, stream);
#else
    launch_one<0>(grid, a, stream); launch_one<1>(grid, a, stream);
#if defined(NAIVEMASK) && (NAIVEMASK & 2)
    launch_one<101>(grid, a, stream);
#endif
    launch_one<2>(grid, a, stream); launch_one<3>(grid, a, stream); launch_one<4>(grid, a, stream); launch_one<5>(grid, a, stream);
    launch_one<6>(grid, a, stream); launch_one<7>(grid, a, stream); launch_one<8>(grid, a, stream);
#if defined(NAIVEMASK) && (NAIVEMASK & (1 << 8))
    launch_one<102>(grid, a, stream);
#endif
    launch_one<9>(grid, a, stream); launch_one<10>(grid, a, stream); launch_one<11>(grid, a, stream);
#endif
}
```

```cpp
#include <hip/hip_runtime.h>
#include <cstdio>
#include <cstdint>

#define DBG_A total
#define DBG_B barsum
constexpr int BATCH = 2, SEQ = 4096, D = 2048, M = BATCH * SEQ, NIN = 11856, FF = 5632;
constexpr int CL = 512, NH = 16, HD = 128, IH = 16, IDM = 64, TOPK = 256, CHUNK = 64;
constexpr int NINP = 12032;
constexpr float EPS = 1e-6f;
constexpr int NTHREADS = 512, NWAVES = 8;

#define LAS __attribute__((address_space(3)))
#define GAS __attribute__((address_space(1)))
typedef unsigned short bf16;
typedef float f32x4 __attribute__((ext_vector_type(4)));
typedef float f32x2 __attribute__((ext_vector_type(2)));
typedef unsigned u32x4 __attribute__((ext_vector_type(4)));
typedef unsigned u32x2 __attribute__((ext_vector_type(2)));

__device__ __forceinline__ float bf2f(bf16 v) { return __uint_as_float(((unsigned)v) << 16); }
__device__ __forceinline__ bf16 f2bf(float f) { unsigned u = __float_as_uint(f); return (bf16)((u + 0x7fffu + ((u >> 16) & 1u)) >> 16); }
__device__ __forceinline__ unsigned pk2(float lo, float hi) { return (unsigned)f2bf(lo) | ((unsigned)f2bf(hi) << 16); }
__device__ __forceinline__ float bflo(unsigned w) { return __uint_as_float(w << 16); }
__device__ __forceinline__ float bfhi(unsigned w) { return __uint_as_float(w & 0xffff0000u); }
__device__ __forceinline__ float wave_sum(float v) {
#pragma unroll
    for (int o = 1; o < 64; o <<= 1) v += __shfl_xor(v, o);
    return v;
}
__device__ __forceinline__ float wave_max(float v) {
#pragma unroll
    for (int o = 1; o < 64; o <<= 1) v = fmaxf(v, __shfl_xor(v, o));
    return v;
}
__device__ __forceinline__ float gelu_tanh(float x) {
    const float u2 = 1.5957691216057308f * (x + 0.044715f * x * x * x);
    return x * __builtin_amdgcn_rcpf(1.f + __expf(-u2));
}
__device__ __forceinline__ float sigmoidf(float x) { return __builtin_amdgcn_rcpf(1.f + __expf(-x)); }

constexpr size_t MiB = 1u << 20;
constexpr size_t WS_CTL = 0, CTL_ZERO_BYTES = 64 * 1024;
constexpr size_t WS_VST = 1 * MiB;
constexpr size_t WS_HST = 3 * MiB;
constexpr size_t WS_WI = 4 * MiB;
constexpr size_t WS_KI = 5 * MiB;
constexpr size_t WS_SEL = 6 * MiB;
constexpr size_t WS_CN = 14 * MiB;
constexpr size_t WS_CKR = 22 * MiB;
constexpr size_t WS_QI = 38 * MiB;
constexpr size_t WS_WUK = 54 * MiB;
constexpr size_t WS_WUV = 56 * MiB;
constexpr size_t WS_WOA = 60 * MiB;
constexpr size_t WS_WOB = 68 * MiB;
constexpr size_t WS_WOUT = 76 * MiB;
constexpr size_t WS_WIN = 86 * MiB;
constexpr size_t WS_XN = 133 * MiB;
constexpr size_t WS_SC = 101 * MiB;
constexpr size_t WS_QL = 102 * MiB;
constexpr size_t WS_U = 166 * MiB;
constexpr size_t WS_V = 198 * MiB;
constexpr size_t WS_Q = 230 * MiB;
constexpr size_t WS_GA = 262 * MiB;
constexpr size_t WS_GB = 294 * MiB;
constexpr size_t WS_WGU = 86 * MiB;
constexpr size_t WS_WD = 130 * MiB;
constexpr size_t WS_HB = 152 * MiB;
constexpr size_t WS_FF = 230 * MiB;
constexpr size_t WS_END = 326 * MiB;

constexpr int RING_BYTES = 131072;
constexpr int LDS_BYTES = 163840;
constexpr int LDSCTL_OFF = LDS_BYTES - 512, MISC_OFF = LDSCTL_OFF + 320;
constexpr size_t SC_PER_BATCH = 8519680;

__device__ __forceinline__ size_t sc_off(int b, int pos) {
    const int c = pos >> 6, r = pos & 63;
    return (size_t)b * SC_PER_BATCH + (size_t)2048 * c * (c + 1) + (size_t)r * 64 * (c + 1);
}
namespace pg8 {
#define PG8_LAS __attribute__((address_space(3)))
typedef unsigned short bf16_t;
typedef short bf16x8 __attribute__((ext_vector_type(8)));
typedef float f32x4 __attribute__((ext_vector_type(4)));
typedef unsigned u32x4 __attribute__((ext_vector_type(4)));
constexpr int BM = 256, BK = 64, HALF = 128, HTB = HALF * BK * 2  , STAGE_BYTES = 8 * HTB, NXCD = 8, WGM = 8;

__host__ __device__ __forceinline__ int lds_byte(int r, int c) { const int st = (r >> 4) * 2 + (c >> 5), rr = r & 15, cc = c & 31, ob = rr * 64 + cc * 2; return st * 1024 + (ob ^ (((ob >> 9) & 1) << 5)); }
__host__ __device__ __forceinline__ void stage_rc(int b, int& R, int& C) { const int st = b / 1024, sb = b % 1024, swz = sb ^ (((sb >> 9) & 1) << 5); R = (st >> 1) * 16 + swz / 64; C = (st & 1) * 32 + (swz % 64) / 2; }
__host__ __device__ __forceinline__ int perm32(int rho) { const int n = rho >> 4, i = rho & 15; return 8 * (i >> 2) + 4 * n + (i & 3); }

struct Unit { int pm, pn, h; };
struct Gemm { const bf16_t* A; const bf16_t* Bt; int lda, ldb, K; };

struct StaticOrder {
    int nM, nN, nwg, G, c;
    __host__ __device__ void init(int M_, int N_, int G_, int c_) { nM = M_ / BM; nN = N_ / BM; nwg = nM * nN; G = G_; c = c_; }
    __host__ __device__ bool next(int i, Unit& u) const {
        const long L = (long)i * G + c; if (L >= nwg) return false;
        int wgid = (int)L; { const int q = nwg / NXCD, r = nwg % NXCD, xcd = wgid % NXCD, off = wgid / NXCD; wgid = (xcd < r ? xcd * (q + 1) : r * (q + 1) + (xcd - r) * q) + off; }
        const int nig = WGM * nN, gid = wgid / nig, fm = gid * WGM, gsz = (nM - fm) < WGM ? (nM - fm) : WGM;
        u.pm = fm + ((wgid % nig) % gsz); u.pn = (wgid % nig) / gsz; u.h = 0; return true;
    }
    __device__ __forceinline__ void ptrs(const Unit& u, const Gemm& g, const char*& a, const char*& b) const {
        a = (const char*)g.A + (size_t)u.pm * BM * g.lda * 2; b = (const char*)g.Bt + (size_t)u.pn * BM * g.ldb * 2; }
    __device__ __forceinline__ void a_ready(const Unit&) const {}
    __device__ __forceinline__ void done(const Unit&) const {}
};
struct HeadOrderQ {
    int G, c;
    __device__ bool next(int i, Unit& u) const { const int L = i * G + c; if (L >= 1024) return false; u.h = L >> 6; u.pn = (L >> 5) & 1; u.pm = L & 31; return true; }
    __device__ __forceinline__ void ptrs(const Unit& u, const Gemm& g, const char*& a, const char*& b) const {
        a = (const char*)g.A + ((size_t)u.pm * BM * g.lda + u.h * 128) * 2; b = (const char*)g.Bt + (size_t)(u.h * 512 + u.pn * BM) * g.ldb * 2; }
    __device__ __forceinline__ void a_ready(const Unit&) const {}
    __device__ __forceinline__ void done(const Unit&) const {}
};
struct PairOrderYB {
    int G, c;
    __device__ bool next(int i, Unit& u) const { const int L = i * G + c; if (L >= 256) return false; u.h = 0; u.pn = L >> 5; u.pm = L & 31; return true; }
    __device__ __forceinline__ void ptrs(const Unit& u, const Gemm& g, const char*& a, const char*& b) const {
        a = (const char*)g.A + ((size_t)u.pm * BM * g.lda + u.pn * 1024) * 2; b = (const char*)g.Bt + (size_t)(u.pn * BM) * g.ldb * 2; }
    __device__ __forceinline__ void a_ready(const Unit&) const {}
    __device__ __forceinline__ void done(const Unit&) const {}
};

typedef __bf16 bf16x2_t __attribute__((ext_vector_type(2)));
typedef float f32x2c __attribute__((ext_vector_type(2)));
__device__ __forceinline__ unsigned cvt_pk_bf16(float lo, float hi) { const f32x2c v = {lo, hi}; const bf16x2_t b = __builtin_convertvector(v, bf16x2_t); return __builtin_bit_cast(unsigned, b); }
__device__ __forceinline__ u32x4 pack8(const f32x4 v0, const f32x4 v1) { u32x4 w; w.x = cvt_pk_bf16(v0[0], v0[1]); w.y = cvt_pk_bf16(v0[2], v0[3]); w.z = cvt_pk_bf16(v1[0], v1[1]); w.w = cvt_pk_bf16(v1[2], v1[3]); return w; }
__device__ __forceinline__ float gelu1(float x) { const float u2 = 1.5957691216057308f * (x + 0.044715f * x * x * x); return x * __builtin_amdgcn_rcpf(1.f + __expf(-u2)); }
__device__ __forceinline__ float sigm1(float x) { return __builtin_amdgcn_rcpf(1.f + __expf(-x)); }
template <int ACT> __device__ __forceinline__ f32x4 act4(f32x4 v) {
    if (ACT == 1) { v[0] = gelu1(v[0]); v[1] = gelu1(v[1]); v[2] = gelu1(v[2]); v[3] = gelu1(v[3]); }
    if (ACT == 2) { v[0] = sigm1(v[0]); v[1] = sigm1(v[1]); v[2] = sigm1(v[2]); v[3] = sigm1(v[3]); }
    return v;
}
template <int ACT> __device__ __forceinline__ void store_tile_bf16(const f32x4 (&acc)[2][2][4][2], bf16_t* base, int ld, int row0) {
#pragma unroll
    for (int ai = 0; ai < 2; ++ai)
#pragma unroll
        for (int m = 0; m < 4; ++m) { bf16_t* rowp = base + (size_t)(row0 + ai * HALF + m * 16) * ld;
#pragma unroll
            for (int bj = 0; bj < 2; ++bj) *(u32x4*)(rowp + bj * HALF) = pack8(act4<ACT>(acc[ai][bj][m][0]), act4<ACT>(acc[ai][bj][m][1])); }
}

struct EpiProjF {
    static constexpr bool PERM = true, AFTER_DRAIN = false;
    unsigned char* ws;
    __device__ __forceinline__ void operator()(const f32x4 (&acc)[2][2][4][2], const Unit& u, int wr, int wc, int fr, int fq) const {
        const int pn = u.pn, row0 = u.pm * BM + wr * 64 + fr, c8 = wc * 32 + 8 * fq;
        if (pn < 8) store_tile_bf16<1>(acc, (bf16_t*)(ws + WS_U) + pn * 256 + c8, 2048, row0);
        else if (pn < 16) {
            bf16_t* base = (bf16_t*)(ws + WS_V) + (pn - 8) * 256 + c8; float* VST = (float*)(ws + WS_VST);
#pragma unroll
            for (int ai = 0; ai < 2; ++ai)
#pragma unroll
                for (int m = 0; m < 4; ++m) { const int row = row0 + ai * HALF + m * 16; float s = 0.f, q = 0.f;
#pragma unroll
                    for (int bj = 0; bj < 2; ++bj) { const f32x4 v0 = act4<1>(acc[ai][bj][m][0]), v1 = act4<1>(acc[ai][bj][m][1]);
                        s += (v0[0] + v0[1]) + (v0[2] + v0[3]) + (v1[0] + v1[1]) + (v1[2] + v1[3]);
                        q += (v0[0] * v0[0] + v0[1] * v0[1]) + (v0[2] * v0[2] + v0[3] * v0[3]) + (v1[0] * v1[0] + v1[1] * v1[1]) + (v1[2] * v1[2] + v1[3] * v1[3]);
                        *(u32x4*)(base + (size_t)row * 2048 + bj * HALF) = pack8(v0, v1); }
                    s += __shfl_xor(s, 16); s += __shfl_xor(s, 32); q += __shfl_xor(q, 16); q += __shfl_xor(q, 32);
                    if (fq == 0) *(f32x2*)(VST + ((size_t)row * 32 + (pn - 8) * 4 + wc) * 2) = (f32x2){s, q};
                    asm volatile("" ::: "memory"); }
        }
        else if (pn < 24) store_tile_bf16<0>(acc, (bf16_t*)(ws + WS_Q) + (pn - 16) * 256 + c8, 2048, row0);
        else if (pn < 26) {
            float* base = (float*)(ws + WS_CKR) + (pn - 24) * 256 + c8;
#pragma unroll
            for (int ai = 0; ai < 2; ++ai)
#pragma unroll
                for (int m = 0; m < 4; ++m) { float* rowp = base + (size_t)(row0 + ai * HALF + m * 16) * 512;
#pragma unroll
                    for (int bj = 0; bj < 2; ++bj) { *(f32x4*)(rowp + bj * HALF) = acc[ai][bj][m][0]; *(f32x4*)(rowp + bj * HALF + 4) = acc[ai][bj][m][1]; } }
        }
        else if (pn < 30) store_tile_bf16<0>(acc, (bf16_t*)(ws + WS_QI) + (pn - 26) * 256 + c8, 1024, row0);
        else if (pn == 30) {
            bf16_t* KI = (bf16_t*)(ws + WS_KI); float* WI = (float*)(ws + WS_WI);
#pragma unroll
            for (int ai = 0; ai < 2; ++ai)
#pragma unroll
                for (int m = 0; m < 4; ++m) { const size_t row = row0 + ai * HALF + m * 16;
                    if (c8 < 64) *(u32x4*)(KI + row * 64 + c8) = pack8(acc[ai][0][m][0], acc[ai][0][m][1]);
                    else if (c8 < 80) { *(f32x4*)(WI + row * 16 + (c8 - 64)) = acc[ai][0][m][0]; *(f32x4*)(WI + row * 16 + (c8 - 64) + 4) = acc[ai][0][m][1]; } }
        }
        else store_tile_bf16<2>(acc, (bf16_t*)(ws + WS_GA) + (size_t)(pn >= 39 ? (WS_GB - WS_GA) / 2 : 0) + ((pn - 31) & 7) * 256 + c8, 2048, row0);
    }
};
struct EpiQlatF {
    static constexpr bool PERM = true, AFTER_DRAIN = false;
    bf16_t* QL;
    __device__ __forceinline__ void operator()(const f32x4 (&acc)[2][2][4][2], const Unit& u, int wr, int wc, int fr, int fq) const {
        store_tile_bf16<0>(acc, QL + u.h * 512 + u.pn * 256 + wc * 32 + 8 * fq, 8192, u.pm * BM + wr * 64 + fr); }
};
struct EpiPlainF {
    static constexpr bool PERM = true, AFTER_DRAIN = false;
    bf16_t* O; int ld;
    __device__ __forceinline__ void operator()(const f32x4 (&acc)[2][2][4][2], const Unit& u, int wr, int wc, int fr, int fq) const {
        store_tile_bf16<0>(acc, O + u.pn * 256 + wc * 32 + 8 * fq, ld, u.pm * BM + wr * 64 + fr); }
};
__device__ __forceinline__ float blo(unsigned w) { return __uint_as_float(w << 16); }
__device__ __forceinline__ float bhi(unsigned w) { return __uint_as_float(w & 0xffff0000u); }
struct EpiGateAF {
    static constexpr bool PERM = true, AFTER_DRAIN = false;
    bf16_t* GA; bool dry;
    __device__ __forceinline__ void operator()(const f32x4 (&acc)[2][2][4][2], const Unit& u, int wr, int wc, int fr, int fq) const {
        bf16_t* base = GA + u.pn * 256 + wc * 32 + 8 * fq; const int row0 = u.pm * BM + wr * 64 + fr;
#pragma unroll
        for (int ai = 0; ai < 2; ++ai)
#pragma unroll
            for (int m = 0; m < 4; ++m) { bf16_t* rowp = base + (size_t)(row0 + ai * HALF + m * 16) * 2048;
#pragma unroll
                for (int bj = 0; bj < 2; ++bj) { const u32x4 g = *(const u32x4*)(rowp + bj * HALF); const f32x4 v0 = acc[ai][bj][m][0], v1 = acc[ai][bj][m][1];
                    const f32x4 o0 = {blo(g.x) * v0[0], bhi(g.x) * v0[1], blo(g.y) * v0[2], bhi(g.y) * v0[3]}, o1 = {blo(g.z) * v1[0], bhi(g.z) * v1[1], blo(g.w) * v1[2], bhi(g.w) * v1[3]};
                    if (!dry) *(u32x4*)(rowp + bj * HALF) = pack8(o0, o1); } }
    }
};
struct EpiGateBF {
    static constexpr bool PERM = true, AFTER_DRAIN = false;
    bf16_t* TMP; const bf16_t* GB; bool dry;
    __device__ __forceinline__ void operator()(const f32x4 (&acc)[2][2][4][2], const Unit& u, int wr, int wc, int fr, int fq) const {
        const int coff = u.pn * 256 + wc * 32 + 8 * fq, row0 = u.pm * BM + wr * 64 + fr;
#pragma unroll
        for (int ai = 0; ai < 2; ++ai)
#pragma unroll
            for (int m = 0; m < 4; ++m) { const size_t ro = (size_t)(row0 + ai * HALF + m * 16) * 2048 + coff;
#pragma unroll
                for (int bj = 0; bj < 2; ++bj) { const u32x4 g = *(const u32x4*)(GB + ro + bj * HALF), t = *(const u32x4*)(TMP + ro + bj * HALF); const f32x4 v0 = acc[ai][bj][m][0], v1 = acc[ai][bj][m][1];
                    const f32x4 o0 = {blo(t.x) + blo(g.x) * v0[0], bhi(t.x) + bhi(g.x) * v0[1], blo(t.y) + blo(g.y) * v0[2], bhi(t.y) + bhi(g.y) * v0[3]};
                    const f32x4 o1 = {blo(t.z) + blo(g.z) * v1[0], bhi(t.z) + bhi(g.z) * v1[1], blo(t.w) + blo(g.w) * v1[2], bhi(t.w) + bhi(g.w) * v1[3]};
                    if (!dry) *(u32x4*)(TMP + ro + bj * HALF) = pack8(o0, o1); } }
    }
};
struct EpiResF {
    static constexpr bool PERM = true, AFTER_DRAIN = false;
    const float* X; float* H; bf16_t* HB; float* HST;
    __device__ __forceinline__ void operator()(const f32x4 (&acc)[2][2][4][2], const Unit& u, int wr, int wc, int fr, int fq) const {
        const int coff = u.pn * 256 + wc * 32 + 8 * fq, row0 = u.pm * BM + wr * 64 + fr;
#pragma unroll
        for (int ai = 0; ai < 2; ++ai)
#pragma unroll
            for (int m = 0; m < 4; ++m) { const int row = row0 + ai * HALF + m * 16; const size_t ro = (size_t)row * 2048 + coff; float q = 0.f;
#pragma unroll
                for (int bj = 0; bj < 2; ++bj) { const f32x4 x0 = *(const f32x4*)(X + ro + bj * HALF), x1 = *(const f32x4*)(X + ro + bj * HALF + 4);
                    const f32x4 h0 = x0 + acc[ai][bj][m][0], h1 = x1 + acc[ai][bj][m][1];
                    *(f32x4*)(H + ro + bj * HALF) = h0; *(f32x4*)(H + ro + bj * HALF + 4) = h1; *(u32x4*)(HB + ro + bj * HALF) = pack8(h0, h1);
                    q += (h0[0] * h0[0] + h0[1] * h0[1]) + (h0[2] * h0[2] + h0[3] * h0[3]) + (h1[0] * h1[0] + h1[1] * h1[1]) + (h1[2] * h1[2] + h1[3] * h1[3]); }
                q += __shfl_xor(q, 16); q += __shfl_xor(q, 32);
                if (fq == 0) HST[(size_t)row * 32 + u.pn * 4 + wc] = q; }
    }
};
struct EpiSwigluF {
    static constexpr bool PERM = true, AFTER_DRAIN = false;
    const float* HST; bf16_t* FFo;
    __device__ __forceinline__ void operator()(const f32x4 (&acc)[2][2][4][2], const Unit& u, int wr, int wc, int fr, int fq) const {
        const int coff = u.pn * 128 + wc * 32 + 8 * fq, row0 = u.pm * BM + wr * 64 + fr;
#pragma unroll
        for (int ai = 0; ai < 2; ++ai)
#pragma unroll
            for (int m = 0; m < 4; ++m) { const int row = row0 + ai * HALF + m * 16; const f32x4* hp = (const f32x4*)(HST + (size_t)row * 32);
                f32x4 sv = hp[0];
#pragma unroll
                for (int j = 1; j < 8; ++j) sv = sv + hp[j];
                const float rs = rsqrtf(((sv[0] + sv[1]) + (sv[2] + sv[3])) * (1.f / 2048.f) + 1e-6f);
                f32x4 o0, o1;
#pragma unroll
                for (int e = 0; e < 4; ++e) { const float g0 = acc[ai][0][m][0][e] * rs, u0 = acc[ai][1][m][0][e] * rs, g1 = acc[ai][0][m][1][e] * rs, u1 = acc[ai][1][m][1][e] * rs;
                    o0[e] = g0 * sigm1(g0) * u0; o1[e] = g1 * sigm1(g1) * u1; }
                *(u32x4*)(FFo + (size_t)row * 5632 + coff) = pack8(o0, o1); }
    }
};
struct EpiRes2F {
    static constexpr bool PERM = true, AFTER_DRAIN = false;
    float* H; bool dry;
    __device__ __forceinline__ void operator()(const f32x4 (&acc)[2][2][4][2], const Unit& u, int wr, int wc, int fr, int fq) const {
        const int coff = u.pn * 256 + wc * 32 + 8 * fq, row0 = u.pm * BM + wr * 64 + fr;
#pragma unroll
        for (int ai = 0; ai < 2; ++ai)
#pragma unroll
            for (int m = 0; m < 4; ++m) { float* rp = H + (size_t)(row0 + ai * HALF + m * 16) * 2048 + coff;
#pragma unroll
                for (int bj = 0; bj < 2; ++bj) { const f32x4 h0 = *(const f32x4*)(rp + bj * HALF) + acc[ai][bj][m][0], h1 = *(const f32x4*)(rp + bj * HALF + 4) + acc[ai][bj][m][1];
                    if (!dry) { *(f32x4*)(rp + bj * HALF) = h0; *(f32x4*)(rp + bj * HALF + 4) = h1; } } }
    }
};

template <class Epi, class Sched, bool ALIGN_EPI = true, bool SP2 = true>
__device__ __forceinline__ void gemm_phase(PG8_LAS unsigned char* lds, const Gemm g, const Sched& S, const Epi& E) {
    const int tid = threadIdx.x, wid = __builtin_amdgcn_readfirstlane(tid >> 6), lane = tid & 63, wr = wid >> 2, wc = wid & 3, fr = lane & 15, fq = lane >> 4;
    const int K = g.K, nt = K / BK;
    unsigned voffA[2], voffB[2];
#pragma unroll
    for (int i = 0; i < 2; ++i) { int R, C; stage_rc(tid * 16 + i * 8192, R, C); const int Rb = Epi::PERM ? ((R & ~31) + perm32(R & 31)) : R;
        voffA[i] = (unsigned)(R * g.lda + C) * 2u; voffB[i] = (unsigned)(Rb * g.ldb + C) * 2u; }
    const size_t kstep = (size_t)(BK * 2);
    const size_t hsA = (size_t)HALF * g.lda * 2, hsB = (size_t)HALF * g.ldb * 2;
    const unsigned ldsw = (unsigned)wid * 1024u;
    const int aoff = lds_byte(wr * 64 + fr, fq * 8), boff = lds_byte(wc * 32 + fr, fq * 8);
#define PG8_SA(b, h) (((b) * 2 + (h)) * HTB)
#define PG8_SB(b, h) ((4 + (b) * 2 + (h)) * HTB)
#define PG8_STAGE(bufoff, gbase, voff) do { _Pragma("unroll") for (int _i = 0; _i < 2; ++_i) \
        __builtin_amdgcn_global_load_lds((const unsigned*)((const char*)(gbase) + (voff)[_i]), (PG8_LAS unsigned*)(lds + (bufoff) + ldsw + _i * 8192), 16, 0, 0); } while (0)
#define PG8_LDA(dst, b, h) do { _Pragma("unroll") for (int m = 0; m < 4; ++m) _Pragma("unroll") for (int k = 0; k < 2; ++k) dst[m][k] = *(const PG8_LAS bf16x8*)(lds + PG8_SA(b, h) + aoff + m * 2048 + k * 1024); } while (0)
#define PG8_LDB(dst, b, h) do { _Pragma("unroll") for (int n = 0; n < 2; ++n) _Pragma("unroll") for (int k = 0; k < 2; ++k) dst[n][k] = *(const PG8_LAS bf16x8*)(lds + PG8_SB(b, h) + boff + n * 2048 + k * 1024); } while (0)
#define PG8_MMA(ai, bj, At, Bt) do { __builtin_amdgcn_s_setprio(1); _Pragma("unroll") for (int m = 0; m < 4; ++m) _Pragma("unroll") for (int n = 0; n < 2; ++n) _Pragma("unroll") for (int k = 0; k < 2; ++k) \
        acc[ai][bj][m][n] = __builtin_amdgcn_mfma_f32_16x16x32_bf16(Bt[n][k], At[m][k], acc[ai][bj][m][n], 0, 0, 0); __builtin_amdgcn_s_setprio(0); } while (0)
#define PG8_WAIT_V(n) asm volatile("s_waitcnt vmcnt(" #n ")" ::: "memory")
#define PG8_WAIT_L(n) asm volatile("s_waitcnt lgkmcnt(" #n ")" ::: "memory")
#define PG8_BAR __builtin_amdgcn_s_barrier()
#define PG8_SCHED __builtin_amdgcn_sched_barrier(0)
    Unit cur, nxt; int ui = 0;
    if (!S.next(0, cur)) return;
    f32x4 acc[2][2][4][2];
#pragma unroll
    for (int a = 0; a < 2; ++a)
#pragma unroll
        for (int b = 0; b < 2; ++b)
#pragma unroll
            for (int m = 0; m < 4; ++m)
#pragma unroll
                for (int n = 0; n < 2; ++n) acc[a][b][m][n] = (f32x4){0.f, 0.f, 0.f, 0.f};
    bf16x8 At[4][2], B0[2][2], B1[2][2];
    const char* cA; const char* cB; S.ptrs(cur, g, cA, cB);
    S.a_ready(cur);
    if constexpr (SP2) {
        PG8_STAGE(PG8_SB(0, 0), cB, voffB); PG8_STAGE(PG8_SB(0, 1), cB + hsB, voffB); PG8_STAGE(PG8_SA(0, 0), cA, voffA); PG8_STAGE(PG8_SA(0, 1), cA + hsA, voffA);
        if (wr == 1) PG8_BAR;
        PG8_WAIT_V(2); PG8_BAR;
        PG8_STAGE(PG8_SB(1, 0), cB + kstep, voffB); PG8_STAGE(PG8_SA(1, 0), cA + kstep, voffA); PG8_STAGE(PG8_SB(1, 1), cB + hsB + kstep, voffB);
        PG8_WAIT_V(6); PG8_BAR;
    } else {
        PG8_STAGE(PG8_SB(0, 0), cB, voffB); PG8_STAGE(PG8_SA(0, 0), cA, voffA); PG8_STAGE(PG8_SB(0, 1), cB + hsB, voffB); PG8_STAGE(PG8_SA(0, 1), cA + hsA, voffA);
        if (wr == 1) PG8_BAR;
        PG8_WAIT_V(4); PG8_BAR;
        PG8_STAGE(PG8_SB(1, 0), cB + kstep, voffB); PG8_STAGE(PG8_SA(1, 0), cA + kstep, voffA); PG8_STAGE(PG8_SB(1, 1), cB + hsB + kstep, voffB);
        PG8_WAIT_V(6); PG8_BAR;
    }
    for (;;) {
        const bool has_next = S.next(ui + 1, nxt);
        const char* nA = cA; const char* nB = cB; if (has_next) S.ptrs(nxt, g, nA, nB);
        for (int t = 0; t < nt; t += 2) {
            const bool last = (t == nt - 2);
            const char* a1 = cA + (size_t)(t + 1) * kstep;
            const char* a2 = last ? nA : cA + (size_t)(t + 2) * kstep; const char* b2 = last ? nB : cB + (size_t)(t + 2) * kstep;
            const char* a3 = a2 + kstep; const char* b3 = b2 + kstep;
            if (last && has_next) S.a_ready(nxt);
            if constexpr (SP2) {
            PG8_LDB(B0, 0, 0); PG8_LDB(B1, 0, 1); PG8_SCHED; PG8_LDA(At, 0, 0); PG8_STAGE(PG8_SA(1, 1), a1 + hsA, voffA);
            PG8_WAIT_V(8); PG8_WAIT_L(0); PG8_BAR; PG8_MMA(0, 0, At, B0); PG8_MMA(0, 1, At, B1); PG8_BAR; PG8_SCHED;
            PG8_LDA(At, 0, 1); PG8_STAGE(PG8_SB(0, 0), b2, voffB); PG8_STAGE(PG8_SB(0, 1), b2 + hsB, voffB); PG8_STAGE(PG8_SA(0, 0), a2, voffA);
            PG8_WAIT_V(8); PG8_WAIT_L(0); PG8_BAR; PG8_MMA(1, 0, At, B0); PG8_MMA(1, 1, At, B1); PG8_BAR; PG8_SCHED;
            PG8_LDB(B0, 1, 0); PG8_LDB(B1, 1, 1); PG8_SCHED; PG8_LDA(At, 1, 0); PG8_STAGE(PG8_SA(0, 1), a2 + hsA, voffA);
            PG8_WAIT_V(8); PG8_WAIT_L(0); PG8_BAR; PG8_MMA(0, 0, At, B0); PG8_MMA(0, 1, At, B1); PG8_BAR; PG8_SCHED;
            PG8_LDA(At, 1, 1); PG8_STAGE(PG8_SB(1, 0), b3, voffB); PG8_STAGE(PG8_SB(1, 1), b3 + hsB, voffB); PG8_STAGE(PG8_SA(1, 0), a3, voffA);
            PG8_WAIT_V(8); PG8_WAIT_L(0); PG8_BAR; PG8_MMA(1, 0, At, B0); PG8_MMA(1, 1, At, B1); PG8_BAR; PG8_SCHED;
            } else {
            PG8_LDB(B0, 0, 0); PG8_SCHED; PG8_LDA(At, 0, 0); PG8_STAGE(PG8_SA(1, 1), a1 + hsA, voffA);
            PG8_WAIT_L(8); PG8_BAR; PG8_WAIT_L(0); PG8_MMA(0, 0, At, B0); PG8_BAR; PG8_SCHED;
            PG8_LDB(B1, 0, 1); PG8_STAGE(PG8_SB(0, 0), b2, voffB);
            PG8_BAR; PG8_WAIT_L(0); PG8_MMA(0, 1, At, B1); PG8_BAR;
            PG8_LDA(At, 0, 1); PG8_STAGE(PG8_SA(0, 0), a2, voffA);
            PG8_BAR; PG8_WAIT_L(0); PG8_MMA(1, 0, At, B0); PG8_BAR; PG8_SCHED;
            PG8_STAGE(PG8_SB(0, 1), b2 + hsB, voffB);
            PG8_WAIT_V(6); PG8_BAR; PG8_MMA(1, 1, At, B1); PG8_BAR;
            PG8_LDB(B0, 1, 0); PG8_SCHED; PG8_LDA(At, 1, 0); PG8_STAGE(PG8_SA(0, 1), a2 + hsA, voffA);
            PG8_WAIT_L(8); PG8_BAR; PG8_WAIT_L(0); PG8_MMA(0, 0, At, B0); PG8_BAR; PG8_SCHED;
            PG8_LDB(B1, 1, 1); PG8_STAGE(PG8_SB(1, 0), b3, voffB);
            PG8_BAR; PG8_WAIT_L(0); PG8_MMA(0, 1, At, B1); PG8_BAR;
            PG8_LDA(At, 1, 1); PG8_STAGE(PG8_SA(1, 0), a3, voffA);
            PG8_BAR; PG8_WAIT_L(0); PG8_MMA(1, 0, At, B0); PG8_BAR; PG8_SCHED;
            PG8_STAGE(PG8_SB(1, 1), b3 + hsB, voffB);
            PG8_WAIT_V(6); PG8_BAR; PG8_MMA(1, 1, At, B1); PG8_BAR;
            }
        }
        if constexpr (ALIGN_EPI) { if (wr == 0) PG8_BAR; }
        if constexpr (!Epi::AFTER_DRAIN) { E(acc, cur, wr, wc, fr, fq); S.done(cur); }
        if (!has_next) break;
#pragma unroll
        for (int a = 0; a < 2; ++a)
#pragma unroll
            for (int b = 0; b < 2; ++b)
#pragma unroll
                for (int m = 0; m < 4; ++m)
#pragma unroll
                    for (int n = 0; n < 2; ++n) acc[a][b][m][n] = (f32x4){0.f, 0.f, 0.f, 0.f};
        cur = nxt; cA = nA; cB = nB; ++ui;
        if constexpr (ALIGN_EPI) { if (wr == 1) PG8_BAR; }
    }
    PG8_WAIT_V(0);
    if constexpr (!ALIGN_EPI) { if (wr == 0) PG8_BAR; }
    PG8_BAR;
    if constexpr (Epi::AFTER_DRAIN) { E.fused(acc, cur, wr, wc, fr, fq, lds, wid, lane); S.done(cur); }
#undef PG8_SA
#undef PG8_SB
#undef PG8_STAGE
#undef PG8_LDA
#undef PG8_LDB
#undef PG8_MMA
#undef PG8_WAIT_V
#undef PG8_WAIT_L
#undef PG8_BAR
#undef PG8_SCHED
}
}

__device__ __forceinline__ void rows_xn(const float* x, const float* g, bf16* XN, int gw, int ngw, int lane) {
    for (int m = gw; m < M; m += ngw) {
        const f32x4* xr = (const f32x4*)(x + (size_t)m * D) + lane;
        f32x4 v[8]; float s = 0.f;
#pragma unroll
        for (int j = 0; j < 8; ++j) { v[j] = xr[64 * j]; s += v[j].x * v[j].x + v[j].y * v[j].y + v[j].z * v[j].z + v[j].w * v[j].w; }
        const float rs = rsqrtf(wave_sum(s) * (1.f / D) + EPS);
        u32x2* o = (u32x2*)(XN + (size_t)m * D) + lane;
#pragma unroll
        for (int j = 0; j < 8; ++j) {
            const f32x4 gg = ((const f32x4*)g)[lane + 64 * j];
            u32x2 w; w.x = (unsigned)f2bf(v[j].x * rs * gg.x) | ((unsigned)f2bf(v[j].y * rs * gg.y) << 16);
            w.y = (unsigned)f2bf(v[j].z * rs * gg.z) | ((unsigned)f2bf(v[j].w * rs * gg.w) << 16);
            o[64 * j] = w;
        }
    }
}
__device__ __forceinline__ void rows_cn(const float* CKR, const float* g, bf16* CN, int gw, int ngw, int lane) {
    for (int m = gw; m < M; m += ngw) {
        const f32x4* xr = (const f32x4*)(CKR + (size_t)m * CL) + lane;
        f32x4 v[2]; float s = 0.f;
#pragma unroll
        for (int j = 0; j < 2; ++j) { v[j] = xr[64 * j]; s += v[j].x * v[j].x + v[j].y * v[j].y + v[j].z * v[j].z + v[j].w * v[j].w; }
        const float rs = rsqrtf(wave_sum(s) * (1.f / CL) + EPS);
        u32x2* o = (u32x2*)(CN + (size_t)m * CL) + lane;
#pragma unroll
        for (int j = 0; j < 2; ++j) {
            const f32x4 gg = ((const f32x4*)g)[lane + 64 * j];
            u32x2 w; w.x = (unsigned)f2bf(v[j].x * rs * gg.x) | ((unsigned)f2bf(v[j].y * rs * gg.y) << 16);
            w.y = (unsigned)f2bf(v[j].z * rs * gg.z) | ((unsigned)f2bf(v[j].w * rs * gg.w) << 16);
            o[64 * j] = w;
        }
    }
}
__device__ __forceinline__ void rows_final(float* H, const float* g, int gw, int ngw, int lane) {
    for (int m = gw; m < M; m += ngw) {
        f32x4* xr = (f32x4*)(H + (size_t)m * D) + lane;
        f32x4 v[8]; float s = 0.f;
#pragma unroll
        for (int j = 0; j < 8; ++j) { v[j] = xr[64 * j]; s += v[j].x * v[j].x + v[j].y * v[j].y + v[j].z * v[j].z + v[j].w * v[j].w; }
        const float rs = rsqrtf(wave_sum(s) * (1.f / D) + EPS);
#pragma unroll
        for (int j = 0; j < 8; ++j) { const f32x4 gg = ((const f32x4*)g)[lane + 64 * j]; xr[64 * j] = v[j] * rs * gg; }
    }
}

__device__ __forceinline__ void naive_gating(float* lds, bf16* U, const bf16* V, const float* VST, const float* ln_g, const float* ln_b,
                                             const float* w_s, const float* b_s, int vb, int nb) {
    float* Wt = lds; float* vn = lds + 128 * 128; float* mr = vn + 128 * 64;
    const int tid = threadIdx.x;
    for (int unit = vb; unit < 2 * 32 * 8 * 4; unit += nb) {
        const int cq = unit & 3, g = (unit >> 2) & 7, n = (unit >> 5) & 31, b = unit >> 10;
        const int row0 = b * SEQ + n * 128, ch0 = g * 256 + cq * 64;
        __syncthreads();
        if (tid < 128) {
            float s = 0.f, q = 0.f;
            for (int j = 0; j < 32; ++j) { s += VST[((size_t)(row0 + tid) * 32 + j) * 2]; q += VST[((size_t)(row0 + tid) * 32 + j) * 2 + 1]; }
            const float mean = s * (1.f / D); const float var = q * (1.f / D) - mean * mean;
            mr[tid * 2] = mean; mr[tid * 2 + 1] = rsqrtf(fmaxf(var, 0.f) + EPS);
        }
        for (int i = tid; i < 128 * 128; i += NTHREADS) { const int p = i >> 7, q = i & 127; Wt[q * 128 + p] = ((q >> 6) <= (p >> 6)) ? w_s[(size_t)g * 16384 + p * 128 + q] : 0.f; }
        __syncthreads();
        for (int i = tid; i < 128 * 64; i += NTHREADS) { const int q = i >> 6, c = i & 63;
            vn[i] = (bf2f(V[(size_t)(row0 + q) * D + ch0 + c]) - mr[q * 2]) * mr[q * 2 + 1] * ln_g[ch0 + c] + ln_b[ch0 + c]; }
        __syncthreads();
        const int c = tid & 63, pg = tid >> 6;
        float acc[16];
#pragma unroll
        for (int i = 0; i < 16; ++i) acc[i] = 0.f;
        for (int q = 0; q < 128; ++q) {
            const float x = vn[q * 64 + c];
#pragma unroll
            for (int i4 = 0; i4 < 4; ++i4) { const f32x4 w = *(const f32x4*)(Wt + q * 128 + pg * 16 + i4 * 4);
                acc[i4 * 4 + 0] += w.x * x; acc[i4 * 4 + 1] += w.y * x; acc[i4 * 4 + 2] += w.z * x; acc[i4 * 4 + 3] += w.w * x; }
        }
#pragma unroll
        for (int i = 0; i < 16; ++i) { const int p = pg * 16 + i; const size_t idx = (size_t)(row0 + p) * D + ch0 + c;
            U[idx] = f2bf(bf2f(U[idx]) * (acc[i] + b_s[g * 128 + p])); }
    }
}

__device__ __forceinline__ void naive_scores(float* lds, const bf16* QI, const bf16* KI, const float* WI, float* SC, int vb, int nb) {
    float* qs = lds;
    float* ws = lds + 1024;
    const int tid = threadIdx.x;
    for (int t = vb; t < M; t += nb) {
        const int b = t / SEQ, pos = t % SEQ, nadm = ((pos >> 6) + 1) * 64;
        __syncthreads();
        for (int i = tid; i < 1024; i += NTHREADS) qs[i] = bf2f(QI[(size_t)t * 1024 + i]);
        if (tid < 16) ws[tid] = WI[(size_t)t * 16 + tid] * 0.25f;
        __syncthreads();
        float* out = SC + sc_off(b, pos);
        for (int s = tid; s < nadm; s += NTHREADS) {
            float k[64];
            const u32x4* kp = (const u32x4*)(KI + (size_t)(b * SEQ + s) * 64);
#pragma unroll
            for (int i = 0; i < 8; ++i) { const u32x4 w = kp[i]; const unsigned ww[4] = {w.x, w.y, w.z, w.w};
#pragma unroll
                for (int e = 0; e < 4; ++e) { k[i * 8 + e * 2] = __uint_as_float(ww[e] << 16); k[i * 8 + e * 2 + 1] = __uint_as_float(ww[e] & 0xffff0000u); } }
            float sc = 0.f;
            for (int h = 0; h < 16; ++h) {
                float l = 0.f;
#pragma unroll
                for (int d = 0; d < 64; ++d) l += qs[h * 64 + d] * k[d];
                sc += ws[h] * fmaxf(l * 0.125f, 0.f);
            }
            out[s] = sc;
        }
    }
}

__device__ __forceinline__ unsigned fkey(float f) { const unsigned u = __float_as_uint(f + 0.0f); return (u & 0x80000000u) ? ~u : (u | 0x80000000u); }
__device__ __forceinline__ void topk_rows(const float* SC, int* SEL, int gw, int ngw, int lane) {
    for (int t = gw; t < M; t += ngw) {
        const int b = t / SEQ, pos = t % SEQ, nadm = ((pos >> 6) + 1) * 64;
        int* sel = SEL + (size_t)t * TOPK;
        if (nadm <= TOPK) { for (int i = lane; i < nadm; i += 64) sel[i] = i; continue; }
        const float* sc = SC + sc_off(b, pos);
        const int nj = nadm >> 6;
        unsigned key[64];
#pragma unroll
        for (int j = 0; j < 64; ++j) key[j] = (j < nj) ? fkey(sc[j * 64 + lane]) : 0u;
        unsigned prefix = 0u;
        for (int bit = 31; bit >= 0; --bit) {
            const unsigned cand = prefix | (1u << bit);
            int cnt = 0;
#pragma unroll
            for (int j4 = 0; j4 < 16; ++j4) {
                if (j4 * 4 < nj) {
#pragma unroll
                    for (int jj = 0; jj < 4; ++jj) cnt += __builtin_popcountll(__ballot(key[j4 * 4 + jj] >= cand));
                }
            }
            if (cnt >= TOPK) prefix = cand;
        }
        int cgt = 0;
#pragma unroll
        for (int j4 = 0; j4 < 16; ++j4) {
            if (j4 * 4 < nj) {
#pragma unroll
                for (int jj = 0; jj < 4; ++jj) cgt += __builtin_popcountll(__ballot(key[j4 * 4 + jj] > prefix));
            }
        }
        int need = TOPK - cgt, obase = 0;
        const unsigned long long lt = (1ull << lane) - 1ull;
#pragma unroll
        for (int j = 0; j < 64; ++j) {
            if (j < nj) {
                const bool gt = key[j] > prefix, eq = key[j] == prefix;
                const unsigned long long me = __ballot(eq);
                const int erank = __builtin_popcountll(me & lt);
                const bool take = gt || (eq && erank < need);
                const unsigned long long ms = __ballot(take);
                if (take) sel[obase + __builtin_popcountll(ms & lt)] = j * 64 + lane;
                obase += __builtin_popcountll(ms);
                const int ne = __builtin_popcountll(me); need -= (ne < need ? ne : need);
            }
        }
    }
}

__device__ __forceinline__ void naive_attn(float* lds, bf16* QL, const bf16* CN, const int* SEL, int vb, int nb) {
    float* qs = lds;
    float* att = lds + 16 * 512;
    int* sl = (int*)(att + 16 * 256);
    const int tid = threadIdx.x, lane = tid & 63, wid = tid >> 6;
    for (int t = vb; t < M; t += nb) {
        const int b = t / SEQ, pos = t % SEQ, nadm = ((pos >> 6) + 1) * 64, nsel = nadm < TOPK ? nadm : TOPK;
        __syncthreads();
        for (int i = tid; i < 16 * 512; i += NTHREADS) qs[i] = bf2f(QL[(size_t)t * 8192 + i]);
        if (tid < 256) sl[tid] = (tid < nsel) ? SEL[(size_t)t * TOPK + tid] : 0;
        __syncthreads();
        {
            const int k = tid & 255, hh = tid >> 8;
            float a[8];
#pragma unroll
            for (int i = 0; i < 8; ++i) a[i] = 0.f;
            if (k < nsel) {
                const u32x4* cp = (const u32x4*)(CN + (size_t)(b * SEQ + sl[k]) * CL);
                for (int c8 = 0; c8 < 64; ++c8) {
                    const u32x4 w = cp[c8]; float cv[8];
                    cv[0] = __uint_as_float(w.x << 16); cv[1] = __uint_as_float(w.x & 0xffff0000u); cv[2] = __uint_as_float(w.y << 16); cv[3] = __uint_as_float(w.y & 0xffff0000u);
                    cv[4] = __uint_as_float(w.z << 16); cv[5] = __uint_as_float(w.z & 0xffff0000u); cv[6] = __uint_as_float(w.w << 16); cv[7] = __uint_as_float(w.w & 0xffff0000u);
#pragma unroll
                    for (int i = 0; i < 8; ++i) { const float* qh = qs + (hh * 8 + i) * 512 + c8 * 8;
                        const f32x4 q0 = *(const f32x4*)qh, q1 = *(const f32x4*)(qh + 4);
                        a[i] += q0.x * cv[0] + q0.y * cv[1] + q0.z * cv[2] + q0.w * cv[3] + q1.x * cv[4] + q1.y * cv[5] + q1.z * cv[6] + q1.w * cv[7]; }
                }
            }
#pragma unroll
            for (int i = 0; i < 8; ++i) att[(hh * 8 + i) * 256 + k] = (k < nsel) ? a[i] * 0.08838834764831845f : -INFINITY;
        }
        __syncthreads();
        {
#pragma unroll
            for (int hi = 0; hi < 2; ++hi) { float* row = att + (wid * 2 + hi) * 256;
                float v[4]; float mx = -INFINITY;
#pragma unroll
                for (int i = 0; i < 4; ++i) { v[i] = row[lane + 64 * i]; mx = fmaxf(mx, v[i]); }
                mx = wave_max(mx); float s = 0.f;
#pragma unroll
                for (int i = 0; i < 4; ++i) { v[i] = __expf(v[i] - mx); s += v[i]; }
                s = wave_sum(s); const float inv = 1.f / s;
#pragma unroll
                for (int i = 0; i < 4; ++i) row[lane + 64 * i] = v[i] * inv; }
        }
        __syncthreads();
        {
            float o[16];
#pragma unroll
            for (int i = 0; i < 16; ++i) o[i] = 0.f;
            for (int k = 0; k < nsel; ++k) {
                const float cv = bf2f(CN[(size_t)(b * SEQ + sl[k]) * CL + tid]);
#pragma unroll
                for (int h = 0; h < 16; ++h) o[h] += att[h * 256 + k] * cv;
            }
#pragma unroll
            for (int h = 0; h < 16; ++h) QL[(size_t)t * 8192 + h * 512 + tid] = f2bf(o[h]);
        }
    }
}


typedef short bf16x8v __attribute__((ext_vector_type(8)));
typedef float f32x16 __attribute__((ext_vector_type(16)));
typedef short v4i16_t __attribute__((ext_vector_type(4)));
__device__ __forceinline__ void fast_scores(const bf16* QI, const bf16* KI, const float* WI, float* SC, int vb, int nb, int wave, int lane) {
    const int r = lane & 31, hi = lane >> 5;
    const int arow_tok = (r >> 2) & 1, arow_head = (r & 3) + 4 * (r >> 3);
    constexpr int NUNITS = 1152;
    for (int u = vb; u < NUNITS; u += nb) {
        int c = 63, rem = u >> 1; const int b = u & 1;
        for (;;) { const int n = 2 * ((c + 8) >> 3); if (rem < n) break; rem -= n; --c; }
        const int hf = rem & 1, sg = rem >> 1;
        const int pos0 = c * 64 + hf * 32 + wave * 4, t0 = b * SEQ + pos0;
        const int k_lo = sg * 512, k_hi = (k_lo + 512 < (c + 1) * 64) ? k_lo + 512 : (c + 1) * 64;
        bf16x8v af[2][4]; float wsc[2][16]; float* outp[2];
#pragma unroll
        for (int p = 0; p < 2; ++p) {
#pragma unroll
            for (int ks = 0; ks < 4; ++ks) af[p][ks] = *(const bf16x8v*)(QI + (size_t)(t0 + 2 * p + arow_tok) * 1024 + arow_head * 64 + ks * 16 + 8 * hi);
            const f32x4* wp = (const f32x4*)(WI + (size_t)(t0 + 2 * p + hi) * 16);
#pragma unroll
            for (int j = 0; j < 4; ++j) { const f32x4 w = wp[j]; wsc[p][4 * j] = w[0] * 0.03125f; wsc[p][4 * j + 1] = w[1] * 0.03125f; wsc[p][4 * j + 2] = w[2] * 0.03125f; wsc[p][4 * j + 3] = w[3] * 0.03125f; }
            outp[p] = SC + sc_off(b, pos0 + 2 * p + hi) + r;
        }
        const bf16* kbase = KI + (size_t)(b * SEQ + r) * 64 + 8 * hi;
        bf16x8v bfr[4], bnx[4];
#pragma unroll
        for (int ks = 0; ks < 4; ++ks) bfr[ks] = *(const bf16x8v*)(kbase + (size_t)k_lo * 64 + ks * 16);
        for (int k0 = k_lo; k0 < k_hi; k0 += 32) {
            const int kn = (k0 + 32 < k_hi) ? k0 + 32 : k0;
#pragma unroll
            for (int ks = 0; ks < 4; ++ks) bnx[ks] = *(const bf16x8v*)(kbase + (size_t)kn * 64 + ks * 16);
#pragma unroll
            for (int p = 0; p < 2; ++p) {
                f32x16 acc = {0.f, 0.f, 0.f, 0.f, 0.f, 0.f, 0.f, 0.f, 0.f, 0.f, 0.f, 0.f, 0.f, 0.f, 0.f, 0.f};
#pragma unroll
                for (int ks = 0; ks < 4; ++ks) acc = __builtin_amdgcn_mfma_f32_32x32x16_bf16(af[p][ks], bfr[ks], acc, 0, 0, 0);
                float s = 0.f;
#pragma unroll
                for (int h = 0; h < 16; ++h) s += fmaxf(acc[h], 0.f) * wsc[p][h];
                outp[p][k0] = s;
            }
#pragma unroll
            for (int ks = 0; ks < 4; ++ks) bfr[ks] = bnx[ks];
        }
    }
}

constexpr int AT_ROWB = 1040;
constexpr int AT_CB = 64 * AT_ROWB;
constexpr int AT_SP = 2 * AT_CB;
constexpr int AT_PB = AT_SP + 2 * 16 * 68 * 4;
constexpr int AT_AL = AT_PB + 16 * 72 * 2;
constexpr int AT_END = AT_AL + 128;
__device__ __forceinline__ int at_nsel(int t) { const int nadm = (((t & (SEQ - 1)) >> 6) + 1) * 64; return nadm < TOPK ? nadm : TOPK; }
__device__ __forceinline__ void at_gather(LAS unsigned char* buf, const bf16* CN, const int* SEL, int t, int ch, int wave, int lane) {
    const int nsel = at_nsel(t), bbase = (t >> 12) * SEQ;
    int idx = 0; { const int i = ch * 64 + wave * 8 + (lane & 7); if (i < nsel) idx = SEL[(size_t)t * TOPK + i]; }
#pragma unroll
    for (int i = 0; i < 8; ++i) { const int row = __builtin_amdgcn_readlane(idx, i);
        __builtin_amdgcn_global_load_lds((const unsigned*)(CN + (size_t)(bbase + row) * CL + lane * 8), (LAS unsigned*)(buf + (wave * 8 + i) * AT_ROWB), 16, 0, 0); }
}
__device__ __forceinline__ void fast_attn(LAS unsigned char* lds, bf16* QL, const bf16* CN, const int* SEL, int vb, int nb, int wave, int lane, bool dostore = true) {
    const int g = lane >> 4, l15 = lane & 15, kt = wave & 3, kh = wave >> 2;
    LAS float* Sp = (LAS float*)(lds + AT_SP); LAS bf16* Pb = (LAS bf16*)(lds + AT_PB); LAS float* AL = (LAS float*)(lds + AT_AL);
    const int tbase = ((vb & 7) >> 2) * SEQ + ((vb & 3) * 32 + (vb >> 3)); int ti = 0;
    const bool remap = (nb == 256);
    int tok = remap ? tbase : vb, ch = 0, cur = 0;
    if (tok >= M) return;
    at_gather(lds, CN, SEL, tok, 0, wave, lane);
    bf16x8v qf[8];
    float m_run[2] = {-INFINITY, -INFINITY}, l_run[2] = {0.f, 0.f};
    f32x4 oacc[4];
    while (tok < M) {
        const int nsel = at_nsel(tok), nch = (nsel + 63) >> 6;
        int ntok = tok, nc = ch + 1; if (nc >= nch) { nc = 0; if (remap) { ++ti; ntok = (ti < 32) ? tbase + ti * 128 : M; } else ntok = tok + nb; }
        LAS unsigned char* buf = lds + cur * AT_CB;
        if (ch == 0) {
#pragma unroll
            for (int ks = 0; ks < 8; ++ks) qf[ks] = *(const bf16x8v*)(QL + (size_t)tok * 8192 + l15 * 512 + kh * 256 + ks * 32 + 8 * g);
            m_run[0] = -INFINITY; m_run[1] = -INFINITY; l_run[0] = 0.f; l_run[1] = 0.f;
#pragma unroll
            for (int n = 0; n < 4; ++n) oacc[n] = (f32x4){0.f, 0.f, 0.f, 0.f};
        }
        asm volatile("s_waitcnt vmcnt(0) lgkmcnt(0)" ::: "memory"); __builtin_amdgcn_s_barrier(); asm volatile("" ::: "memory");
        if (ntok < M) at_gather(lds + (cur ^ 1) * AT_CB, CN, SEL, ntok, nc, wave, lane);
        {   f32x4 sacc = {0.f, 0.f, 0.f, 0.f};
            const LAS unsigned char* cb = buf + (kt * 16 + l15) * AT_ROWB + (kh * 256 + 8 * g) * 2;
#pragma unroll
            for (int ks = 0; ks < 8; ++ks) { const bf16x8v cf = *(const LAS bf16x8v*)(cb + ks * 64); sacc = __builtin_amdgcn_mfma_f32_16x16x32_bf16(cf, qf[ks], sacc, 0, 0, 0); }
            *(LAS f32x4*)(Sp + (kh * 16 + l15) * 68 + kt * 16 + 4 * g) = sacc;
        }
        asm volatile("s_waitcnt lgkmcnt(0)" ::: "memory"); __builtin_amdgcn_s_barrier(); asm volatile("" ::: "memory");
#pragma unroll
        for (int hh = 0; hh < 2; ++hh) { const int h = 2 * wave + hh;
            float s = (Sp[h * 68 + lane] + Sp[(16 + h) * 68 + lane]) * 0.12751743074602468f;
            if (ch * 64 + lane >= nsel) s = -INFINITY;
            const float mn = fmaxf(m_run[hh], wave_max(s));
            const float alpha = __builtin_amdgcn_exp2f(m_run[hh] - mn), p = __builtin_amdgcn_exp2f(s - mn);
            l_run[hh] = l_run[hh] * alpha + wave_sum(p); m_run[hh] = mn;
            Pb[h * 72 + lane] = f2bf(p);
            if (lane == 0) AL[h] = alpha; }
        asm volatile("s_waitcnt lgkmcnt(0)" ::: "memory"); __builtin_amdgcn_s_barrier(); asm volatile("" ::: "memory");
        {   const float al = AL[l15];
#pragma unroll
            for (int n = 0; n < 4; ++n) oacc[n] = oacc[n] * al;
            bf16x8v pf[2];
#pragma unroll
            for (int ks = 0; ks < 2; ++ks) pf[ks] = *(const LAS bf16x8v*)((const LAS unsigned char*)Pb + l15 * 144 + (32 * ks + 8 * g) * 2);
            const LAS unsigned char* tb = buf + (8 * g + (l15 >> 2)) * AT_ROWB + (64 * wave + 4 * (l15 & 3)) * 2;
#pragma unroll
            for (int n = 0; n < 4; ++n)
#pragma unroll
                for (int ks = 0; ks < 2; ++ks) {
                    const v4i16_t t0 = __builtin_amdgcn_ds_read_tr16_b64_v4i16((LAS v4i16_t*)(tb + (32 * ks) * AT_ROWB + n * 32));
                    const v4i16_t t1 = __builtin_amdgcn_ds_read_tr16_b64_v4i16((LAS v4i16_t*)(tb + (32 * ks + 4) * AT_ROWB + n * 32));
                    const bf16x8v cf = {t0[0], t0[1], t0[2], t0[3], t1[0], t1[1], t1[2], t1[3]};
                    oacc[n] = __builtin_amdgcn_mfma_f32_16x16x32_bf16(cf, pf[ks], oacc[n], 0, 0, 0);
                }
        }
        if (nc == 0) {
            if (lane == 0) { AL[16 + 2 * wave] = 1.f / l_run[0]; AL[16 + 2 * wave + 1] = 1.f / l_run[1]; }
            asm volatile("s_waitcnt lgkmcnt(0)" ::: "memory"); __builtin_amdgcn_s_barrier(); asm volatile("" ::: "memory");
            const float li = AL[16 + l15];
            bf16* op = QL + (size_t)tok * 8192 + l15 * 512 + 64 * wave + 4 * g;
#pragma unroll
            for (int n = 0; n < 4; ++n) if (dostore) { const f32x4 o = oacc[n] * li; u32x2 w; w.x = pk2(o[0], o[1]); w.y = pk2(o[2], o[3]); *(u32x2*)(op + 16 * n) = w; }
        }
        tok = ntok; ch = nc; cur ^= 1;
    }
    asm volatile("s_waitcnt vmcnt(0) lgkmcnt(0)" ::: "memory"); __builtin_amdgcn_s_barrier();
}

constexpr int GT_ROWB = 528;
__device__ __forceinline__ void fast_gating(LAS unsigned char* lds, bf16* U, const bf16* V, const float* VST, const float* ln_g, const float* ln_b,
                                            const float* w_s, const float* b_s, int vb, int nb, int wave, int lane, bool dry = false) {
    LAS float* MR = (LAS float*)(lds + 128 * GT_ROWB);
    const int tid = threadIdx.x, g = lane >> 4, l15 = lane & 15, ph = wave >> 2, cq = wave & 3;
    for (int unit = vb; unit < 512; unit += nb) {
        const int gi = unit & 7, n = (unit >> 3) & 31, b = unit >> 8;
        const int row0 = b * SEQ + n * 128, ch0 = gi * 256;
        asm volatile("s_waitcnt lgkmcnt(0)" ::: "memory"); __builtin_amdgcn_s_barrier(); asm volatile("" ::: "memory");
        if (tid < 128) {
            const f32x4* vp = (const f32x4*)(VST + (size_t)(row0 + tid) * 64); float s = 0.f, q = 0.f;
#pragma unroll
            for (int j = 0; j < 16; ++j) { const f32x4 v = vp[j]; s += v[0] + v[2]; q += v[1] + v[3]; }
            const float mean = s * (1.f / D), var = q * (1.f / D) - mean * mean;
            MR[tid * 2] = mean; MR[tid * 2 + 1] = rsqrtf(fmaxf(var, 0.f) + EPS);
        }
        bf16x8v wf[4][4];
        const int nks = ph ? 4 : 2;
#pragma unroll
        for (int pt = 0; pt < 4; ++pt)
#pragma unroll
            for (int ks = 0; ks < 4; ++ks) { if (ks < nks) { const f32x4* wp = (const f32x4*)(w_s + (size_t)gi * 16384 + (ph * 64 + pt * 16 + l15) * 128 + ks * 32 + 8 * g); const f32x4 a = wp[0], c = wp[1];
                    const unsigned w0 = pk2(a[0], a[1]), w1 = pk2(a[2], a[3]), w2 = pk2(c[0], c[1]), w3 = pk2(c[2], c[3]);
                    wf[pt][ks] = __builtin_bit_cast(bf16x8v, (u32x4){w0, w1, w2, w3}); } else wf[pt][ks] = (bf16x8v){0, 0, 0, 0, 0, 0, 0, 0}; }
        asm volatile("s_waitcnt lgkmcnt(0)" ::: "memory"); __builtin_amdgcn_s_barrier(); asm volatile("" ::: "memory");
        {
            const int c8 = tid & 31; float lg[8], lb[8];
            { const f32x4* gp = (const f32x4*)(ln_g + ch0 + c8 * 8); const f32x4* bp = (const f32x4*)(ln_b + ch0 + c8 * 8); const f32x4 g0 = gp[0], g1 = gp[1], b0 = bp[0], b1 = bp[1];
              lg[0] = g0[0]; lg[1] = g0[1]; lg[2] = g0[2]; lg[3] = g0[3]; lg[4] = g1[0]; lg[5] = g1[1]; lg[6] = g1[2]; lg[7] = g1[3];
              lb[0] = b0[0]; lb[1] = b0[1]; lb[2] = b0[2]; lb[3] = b0[3]; lb[4] = b1[0]; lb[5] = b1[1]; lb[6] = b1[2]; lb[7] = b1[3]; }
#pragma unroll
            for (int i = 0; i < 8; ++i) { const int q = (tid >> 5) + 16 * i;
                const u32x4 raw = *(const u32x4*)(V + (size_t)(row0 + q) * D + ch0 + c8 * 8); const float mean = MR[q * 2], rs = MR[q * 2 + 1];
                const unsigned ww[4] = {raw.x, raw.y, raw.z, raw.w}; u32x4 o; unsigned oo[4];
#pragma unroll
                for (int e = 0; e < 4; ++e) oo[e] = pk2((bflo(ww[e]) - mean) * rs * lg[2 * e] + lb[2 * e], (bfhi(ww[e]) - mean) * rs * lg[2 * e + 1] + lb[2 * e + 1]);
                o.x = oo[0]; o.y = oo[1]; o.z = oo[2]; o.w = oo[3];
                *(LAS u32x4*)(lds + q * GT_ROWB + c8 * 16) = o; }
        }
        asm volatile("s_waitcnt lgkmcnt(0)" ::: "memory"); __builtin_amdgcn_s_barrier(); asm volatile("" ::: "memory");
        f32x4 acc[4][4];
#pragma unroll
        for (int ct = 0; ct < 4; ++ct)
#pragma unroll
            for (int pt = 0; pt < 4; ++pt) acc[ct][pt] = (f32x4){0.f, 0.f, 0.f, 0.f};
        const LAS unsigned char* tb = lds + (8 * g + (l15 >> 2)) * GT_ROWB + (cq * 64 + 4 * (l15 & 3)) * 2;
#pragma unroll
        for (int ks = 0; ks < 4; ++ks) { if (ks < nks) {
#pragma unroll
            for (int ct = 0; ct < 4; ++ct) {
                const v4i16_t t0 = __builtin_amdgcn_ds_read_tr16_b64_v4i16((LAS v4i16_t*)(tb + (32 * ks) * GT_ROWB + ct * 32));
                const v4i16_t t1 = __builtin_amdgcn_ds_read_tr16_b64_v4i16((LAS v4i16_t*)(tb + (32 * ks + 4) * GT_ROWB + ct * 32));
                const bf16x8v cf = {t0[0], t0[1], t0[2], t0[3], t1[0], t1[1], t1[2], t1[3]};
#pragma unroll
                for (int pt = 0; pt < 4; ++pt) acc[ct][pt] = __builtin_amdgcn_mfma_f32_16x16x32_bf16(cf, wf[pt][ks], acc[ct][pt], 0, 0, 0);
            } } }
#pragma unroll
        for (int pt = 0; pt < 4; ++pt) { const int p = ph * 64 + pt * 16 + l15; const float bs = b_s[gi * 128 + p];
#pragma unroll
            for (int ct = 0; ct < 4; ++ct) { bf16* up = U + (size_t)(row0 + p) * D + ch0 + cq * 64 + ct * 16 + 4 * g; const u32x2 uu = *(const u32x2*)up; const f32x4 a = acc[ct][pt];
                u32x2 o; o.x = pk2(bflo(uu.x) * (a[0] + bs), bfhi(uu.x) * (a[1] + bs)); o.y = pk2(bflo(uu.y) * (a[2] + bs), bfhi(uu.y) * (a[3] + bs)); if (!dry) *(u32x2*)up = o; } }
    }
    asm volatile("s_waitcnt lgkmcnt(0)" ::: "memory"); __builtin_amdgcn_s_barrier(); asm volatile("" ::: "memory");
}

typedef short bf16x4v __attribute__((ext_vector_type(4)));
constexpr int A2_ROWB = 1056;
constexpr int A2_WB = 16 * A2_ROWB;
__device__ __forceinline__ void attn_wave(LAS unsigned char* lds, bf16* QL, const bf16* CN, const int* SEL, int vb, int nb, int wave, int lane) {
    const int g = lane >> 4, l15 = lane & 15;
    LAS unsigned char* buf = lds + wave * A2_WB;
    int tlist0, tstep, ntok;
    if (nb == 256) { const int bsel = (vb & 7) >> 2, w = (((vb & 3) * 32 + (vb >> 3)) * 8 + wave); tlist0 = bsel * SEQ + w; tstep = 1024; ntok = 4; }
    else { tlist0 = vb * 8 + wave; tstep = nb * 8; ntok = (M - tlist0 + tstep - 1) / tstep; }
    const LAS unsigned char* cb = buf + l15 * A2_ROWB + 8 * g * 2;
    const LAS unsigned char* tb = buf + (4 * g + (l15 >> 2)) * A2_ROWB + 4 * (l15 & 3) * 2;
    for (int it = 0; it < ntok; ++it) {
        const int tok = tlist0 + it * tstep;
        const int nadm = (((tok & (SEQ - 1)) >> 6) + 1) * 64, nsel = nadm < TOPK ? nadm : TOPK, nch = nsel >> 4, bbase = (tok >> 12) * SEQ;
        bf16x8v qf[16];
#pragma unroll
        for (int ks = 0; ks < 16; ++ks) qf[ks] = *(const bf16x8v*)(QL + (size_t)tok * 8192 + l15 * 512 + ks * 32 + 8 * g);
        f32x4 oacc[32];
#pragma unroll
        for (int n = 0; n < 32; ++n) oacc[n] = (f32x4){0.f, 0.f, 0.f, 0.f};
        float m_run = -INFINITY, l_run = 0.f;
        for (int ch = 0; ch < nch; ++ch) {
            const int idx = SEL[(size_t)tok * TOPK + ch * 16 + l15];
            asm volatile("s_waitcnt lgkmcnt(0)" ::: "memory");
#pragma unroll
            for (int i = 0; i < 16; ++i) { const int row = __builtin_amdgcn_readlane(idx, i);
                __builtin_amdgcn_global_load_lds((const unsigned*)(CN + (size_t)(bbase + row) * CL + lane * 8), (LAS unsigned*)(buf + i * A2_ROWB), 16, 0, 0); }
            asm volatile("s_waitcnt vmcnt(0)" ::: "memory");
            f32x4 s = {0.f, 0.f, 0.f, 0.f};
#pragma unroll
            for (int ks = 0; ks < 16; ++ks) { const bf16x8v cf = *(const LAS bf16x8v*)(cb + ks * 64); s = __builtin_amdgcn_mfma_f32_16x16x32_bf16(cf, qf[ks], s, 0, 0, 0); }
            s = s * 0.12751743074602468f;
            float mx = fmaxf(fmaxf(s[0], s[1]), fmaxf(s[2], s[3]));
            mx = fmaxf(mx, __shfl_xor(mx, 16)); mx = fmaxf(mx, __shfl_xor(mx, 32));
            const float mn = fmaxf(m_run, mx), alpha = __builtin_amdgcn_exp2f(m_run - mn);
            const float p0 = __builtin_amdgcn_exp2f(s[0] - mn), p1 = __builtin_amdgcn_exp2f(s[1] - mn), p2 = __builtin_amdgcn_exp2f(s[2] - mn), p3 = __builtin_amdgcn_exp2f(s[3] - mn);
            float ps = (p0 + p1) + (p2 + p3); ps += __shfl_xor(ps, 16); ps += __shfl_xor(ps, 32);
            l_run = l_run * alpha + ps; m_run = mn;
            const unsigned pw0 = pk2(p0, p1), pw1 = pk2(p2, p3);
            const bf16x4v pf = __builtin_bit_cast(bf16x4v, (u32x2){pw0, pw1});
#pragma unroll
            for (int n = 0; n < 32; ++n) {
                const v4i16_t t = __builtin_amdgcn_ds_read_tr16_b64_v4i16((LAS v4i16_t*)(tb + n * 32));
                oacc[n] = __builtin_amdgcn_mfma_f32_16x16x16bf16_1k(__builtin_bit_cast(bf16x4v, t), pf, oacc[n] * alpha, 0, 0, 0);
            }
        }
        const float li = 1.f / l_run;
        bf16* op = QL + (size_t)tok * 8192 + l15 * 512 + 4 * g;
#pragma unroll
        for (int n = 0; n < 32; ++n) { const f32x4 o = oacc[n] * li; u32x2 w; w.x = pk2(o[0], o[1]); w.y = pk2(o[2], o[3]); *(u32x2*)(op + 16 * n) = w; }
    }
    asm volatile("s_waitcnt vmcnt(0) lgkmcnt(0)" ::: "memory");
}

#ifdef NAIVEMASK
template <bool DUAL, class Epi>
__device__ __forceinline__ void naive_gemm(float* lds, const bf16* A, int lda, const float* W, const float* W2, int ldw, const float* kscale,
                                           int Mrows, int N, int K, const Epi& epi, int vb, int nb) {
    float* As = lds;
    float* Ws = lds + 16 * 132;
    float* Ws2 = lds + 32 * 132;
    const int tid = threadIdx.x, tx = tid & 31, ty = tid >> 5;
    const int ntn = (N + 127) / 128, ntm = Mrows / 128;
    for (int tile = vb; tile < ntm * ntn; tile += nb) {
        const int tm = tile / ntn, tn = tile % ntn;
        const int row0 = tm * 128, col0 = tn * 128;
        float acc[8][4], acc2[8][4];
#pragma unroll
        for (int i = 0; i < 8; ++i)
#pragma unroll
            for (int j = 0; j < 4; ++j) { acc[i][j] = 0.f; acc2[i][j] = 0.f; }
        for (int k0 = 0; k0 < K; k0 += 16) {
            {
                const int r = tid >> 2, k4 = (tid & 3) * 4;
                const u32x2 raw = *(const u32x2*)(A + (size_t)(row0 + r) * lda + k0 + k4);
                As[(k4 + 0) * 132 + r] = __uint_as_float(raw.x << 16);
                As[(k4 + 1) * 132 + r] = __uint_as_float(raw.x & 0xffff0000u);
                As[(k4 + 2) * 132 + r] = __uint_as_float(raw.y << 16);
                As[(k4 + 3) * 132 + r] = __uint_as_float(raw.y & 0xffff0000u);
            }
            {
                const int k = tid >> 5, c4 = (tid & 31) * 4;
                f32x4 w = {0.f, 0.f, 0.f, 0.f}, w2 = {0.f, 0.f, 0.f, 0.f};
                if (col0 + c4 < N) {
                    w = *(const f32x4*)(W + (size_t)(k0 + k) * ldw + col0 + c4);
                    if (DUAL) w2 = *(const f32x4*)(W2 + (size_t)(k0 + k) * ldw + col0 + c4);
                    if (kscale) { const float s = kscale[k0 + k]; w = w * s; w2 = w2 * s; }
                }
                *(f32x4*)(Ws + k * 132 + c4) = w;
                if (DUAL) *(f32x4*)(Ws2 + k * 132 + c4) = w2;
            }
            __syncthreads();
#pragma unroll
            for (int k = 0; k < 16; ++k) {
                const f32x4 a0 = *(const f32x4*)(As + k * 132 + ty * 8), a1 = *(const f32x4*)(As + k * 132 + ty * 8 + 4);
                const f32x4 w = *(const f32x4*)(Ws + k * 132 + tx * 4);
                const float a[8] = {a0.x, a0.y, a0.z, a0.w, a1.x, a1.y, a1.z, a1.w};
#pragma unroll
                for (int i = 0; i < 8; ++i) { acc[i][0] += a[i] * w.x; acc[i][1] += a[i] * w.y; acc[i][2] += a[i] * w.z; acc[i][3] += a[i] * w.w; }
                if (DUAL) {
                    const f32x4 w2 = *(const f32x4*)(Ws2 + k * 132 + tx * 4);
#pragma unroll
                    for (int i = 0; i < 8; ++i) { acc2[i][0] += a[i] * w2.x; acc2[i][1] += a[i] * w2.y; acc2[i][2] += a[i] * w2.z; acc2[i][3] += a[i] * w2.w; }
                }
            }
            __syncthreads();
        }
#pragma unroll
        for (int i = 0; i < 8; ++i)
#pragma unroll
            for (int j = 0; j < 4; ++j) { const int r = row0 + ty * 8 + i, c = col0 + tx * 4 + j; if (c < N) epi(r, c, acc[i][j], acc2[i][j]); }
    }
}

struct EpiProj {
    bf16 *U, *V, *Q, *QI, *KI, *GA, *GB; float *CKR, *WI; int coff;
    __device__ __forceinline__ void operator()(int r, int c, float v, float) const {
        c += coff;
        if (c < 2048) U[(size_t)r * 2048 + c] = f2bf(gelu_tanh(v));
        else if (c < 4096) V[(size_t)r * 2048 + c - 2048] = f2bf(gelu_tanh(v));
        else if (c < 6144) Q[(size_t)r * 2048 + c - 4096] = f2bf(v);
        else if (c < 6656) CKR[(size_t)r * 512 + c - 6144] = v;
        else if (c < 7680) QI[(size_t)r * 1024 + c - 6656] = f2bf(v);
        else if (c < 7744) KI[(size_t)r * 64 + c - 7680] = f2bf(v);
        else if (c < 7760) WI[(size_t)r * 16 + c - 7744] = v;
        else if (c < 9808) GA[(size_t)r * 2048 + c - 7760] = f2bf(sigmoidf(v));
        else GB[(size_t)r * 2048 + c - 9808] = f2bf(sigmoidf(v));
    }
};
struct EpiGateA {
    bf16* GA;
    __device__ __forceinline__ void operator()(int r, int c, float v, float) const { const size_t i = (size_t)r * 2048 + c; GA[i] = f2bf(bf2f(GA[i]) * v); }
};
struct EpiGateB {
    bf16* TMP; const bf16* GB;
    __device__ __forceinline__ void operator()(int r, int c, float v, float) const { const size_t i = (size_t)r * 2048 + c; TMP[i] = f2bf(bf2f(TMP[i]) + bf2f(GB[i]) * v); }
};
struct EpiRes {
    const float* X; float* H; bf16* HB;
    __device__ __forceinline__ void operator()(int r, int c, float v, float) const { const size_t i = (size_t)r * 2048 + c; const float h = X[i] + v; H[i] = h; HB[i] = f2bf(h); }
};
struct EpiSwiglu {
    const float* HST; bf16* FFo;
    __device__ __forceinline__ void operator()(int r, int c, float g, float u) const {
        float ss = 0.f;
        for (int j = 0; j < 32; ++j) ss += HST[(size_t)r * 32 + j];
        const float rs = rsqrtf(ss * (1.f / D) + EPS);
        const float gg = g * rs, uu = u * rs;
        FFo[(size_t)r * FF + c] = f2bf(gg * sigmoidf(gg) * uu);
    }
};
struct EpiRes2 {
    float* H;
    __device__ __forceinline__ void operator()(int r, int c, float v, float) const { const size_t i = (size_t)r * 2048 + c; H[i] = H[i] + v; }
};

__device__ __forceinline__ void rows_vst(const bf16* V, float* VST, int gw, int ngw, int lane) {
    for (int m = gw; m < M; m += ngw) {
        const int j = lane >> 1, hf = lane & 1;
        const u32x4* p = (const u32x4*)(V + (size_t)m * D + j * 64 + hf * 32);
        float s = 0.f, q = 0.f;
#pragma unroll
        for (int i = 0; i < 4; ++i) { const u32x4 w = p[i]; const unsigned ww[4] = {w.x, w.y, w.z, w.w};
#pragma unroll
            for (int e = 0; e < 4; ++e) { const float a = __uint_as_float(ww[e] << 16), b = __uint_as_float(ww[e] & 0xffff0000u); s += a + b; q += a * a + b * b; } }
        s += __shfl_xor(s, 1); q += __shfl_xor(q, 1);
        if (hf == 0) { VST[((size_t)m * 32 + j) * 2] = s; VST[((size_t)m * 32 + j) * 2 + 1] = q; }
    }
}
__device__ __forceinline__ void rows_hst(const float* H, float* HST, int gw, int ngw, int lane) {
    for (int m = gw; m < M; m += ngw) {
        const int j = lane >> 1, hf = lane & 1;
        const f32x4* p = (const f32x4*)(H + (size_t)m * D + j * 64 + hf * 32);
        float q = 0.f;
#pragma unroll
        for (int i = 0; i < 8; ++i) { const f32x4 w = p[i]; q += w.x * w.x + w.y * w.y + w.z * w.z + w.w * w.w; }
        q += __shfl_xor(q, 1);
        if (hf == 0) HST[(size_t)m * 32 + j] = q;
    }
}
__device__ __forceinline__ void naive_qlat(float* lds, const bf16* Q, const float* w_uk, bf16* QL, int vb, int nb) {
    float* qs = lds;
    const int tid = threadIdx.x;
    for (int unit = vb; unit < (M / 32) * NH; unit += nb) {
        const int h = unit % NH, t0 = (unit / NH) * 32;
        __syncthreads();
        for (int i = tid; i < 32 * 128; i += NTHREADS) qs[i] = bf2f(Q[(size_t)(t0 + (i >> 7)) * D + h * 128 + (i & 127)]);
        __syncthreads();
        float acc[32];
#pragma unroll
        for (int i = 0; i < 32; ++i) acc[i] = 0.f;
        const f32x4* wr = (const f32x4*)(w_uk + (size_t)tid * 2048 + h * 128);
        for (int d4 = 0; d4 < 32; ++d4) {
            const f32x4 w = wr[d4];
#pragma unroll
            for (int i = 0; i < 32; ++i) { const f32x4 q = *(const f32x4*)(qs + i * 128 + d4 * 4); acc[i] += w.x * q.x + w.y * q.y + w.z * q.z + w.w * q.w; }
        }
#pragma unroll
        for (int i = 0; i < 32; ++i) QL[((size_t)(t0 + i) * NH + h) * CL + tid] = f2bf(acc[i]);
    }
}
__device__ __forceinline__ void naive_yb(float* lds, const bf16* OL, const float* w_uv, bf16* YB, int vb, int nb) {
    float* os = lds;
    const int tid = threadIdx.x, d = tid & 127, tq = tid >> 7;
    for (int unit = vb; unit < (M / 32) * NH; unit += nb) {
        const int h = unit % NH, t0 = (unit / NH) * 32;
        __syncthreads();
        for (int i = tid; i < 32 * 512; i += NTHREADS) os[i] = bf2f(OL[((size_t)(t0 + (i >> 9)) * NH + h) * CL + (i & 511)]);
        __syncthreads();
        float acc[8];
#pragma unroll
        for (int i = 0; i < 8; ++i) acc[i] = 0.f;
        for (int c = 0; c < CL; ++c) {
            const float w = w_uv[(size_t)c * 2048 + h * 128 + d];
#pragma unroll
            for (int i = 0; i < 8; ++i) acc[i] += w * os[(tq * 8 + i) * 512 + c];
        }
#pragma unroll
        for (int i = 0; i < 8; ++i) YB[(size_t)(t0 + tq * 8 + i) * D + h * 128 + d] = f2bf(acc[i]);
    }
}

#endif
#ifdef DBG_CHECK
__device__ __forceinline__ void dbg_scores(float* lds, const bf16* QI, const bf16* KI, const float* WI, const float* SC, unsigned* res, int vb, int nb) {
    float* qs = lds;
    float* ws = lds + 1024;
    const int tid = threadIdx.x;
    float dmax = 0.f, rmax = 0.f;
    for (int ii = vb; ii < 256; ii += nb) { const int t = ii * 32 + 17;
        const int b = t / SEQ, pos = t % SEQ, nadm = ((pos >> 6) + 1) * 64;
        __syncthreads();
        for (int i = tid; i < 1024; i += NTHREADS) qs[i] = bf2f(QI[(size_t)t * 1024 + i]);
        if (tid < 16) ws[tid] = WI[(size_t)t * 16 + tid] * 0.25f;
        __syncthreads();
        const float* out = SC + sc_off(b, pos);
        for (int s = tid; s < nadm; s += NTHREADS) {
            float k[64];
            const u32x4* kp = (const u32x4*)(KI + (size_t)(b * SEQ + s) * 64);
#pragma unroll
            for (int i = 0; i < 8; ++i) { const u32x4 w = kp[i]; const unsigned ww[4] = {w.x, w.y, w.z, w.w};
#pragma unroll
                for (int e = 0; e < 4; ++e) { k[i * 8 + e * 2] = __uint_as_float(ww[e] << 16); k[i * 8 + e * 2 + 1] = __uint_as_float(ww[e] & 0xffff0000u); } }
            float sc = 0.f;
            for (int h = 0; h < 16; ++h) {
                float l = 0.f;
#pragma unroll
                for (int d = 0; d < 64; ++d) l += qs[h * 64 + d] * k[d];
                sc += ws[h] * fmaxf(l * 0.125f, 0.f);
            }
            dmax = fmaxf(dmax, fabsf(out[s] - sc)); rmax = fmaxf(rmax, fabsf(sc));
        }
    }
    atomicMax(res + 0, __float_as_uint(dmax)); atomicMax(res + 1, __float_as_uint(rmax));
}
__device__ __forceinline__ void dbg_attn(float* lds, bf16* QS, const bf16* QLfast, const bf16* CN, const int* SEL, unsigned* res, int vb, int nb) {
    float* qs = lds;
    float* att = lds + 16 * 512;
    int* sl = (int*)(att + 16 * 256);
    const int tid = threadIdx.x, lane = tid & 63, wid = tid >> 6;
    float dmax = 0.f, rmax = 0.f;
    for (int ii = vb; ii < 256; ii += nb) { const int t = ii * 32 + 17; bf16* QL = QS + (size_t)ii * 8192 - (size_t)t * 8192;
        const int b = t / SEQ, pos = t % SEQ, nadm = ((pos >> 6) + 1) * 64, nsel = nadm < TOPK ? nadm : TOPK;
        __syncthreads();
        for (int i = tid; i < 16 * 512; i += NTHREADS) qs[i] = bf2f(QL[(size_t)t * 8192 + i]);
        if (tid < 256) sl[tid] = (tid < nsel) ? SEL[(size_t)t * TOPK + tid] : 0;
        __syncthreads();
        {
            const int k = tid & 255, hh = tid >> 8;
            float a[8];
#pragma unroll
            for (int i = 0; i < 8; ++i) a[i] = 0.f;
            if (k < nsel) {
                const u32x4* cp = (const u32x4*)(CN + (size_t)(b * SEQ + sl[k]) * CL);
                for (int c8 = 0; c8 < 64; ++c8) {
                    const u32x4 w = cp[c8]; float cv[8];
                    cv[0] = __uint_as_float(w.x << 16); cv[1] = __uint_as_float(w.x & 0xffff0000u); cv[2] = __uint_as_float(w.y << 16); cv[3] = __uint_as_float(w.y & 0xffff0000u);
                    cv[4] = __uint_as_float(w.z << 16); cv[5] = __uint_as_float(w.z & 0xffff0000u); cv[6] = __uint_as_float(w.w << 16); cv[7] = __uint_as_float(w.w & 0xffff0000u);
#pragma unroll
                    for (int i = 0; i < 8; ++i) { const float* qh = qs + (hh * 8 + i) * 512 + c8 * 8;
                        const f32x4 q0 = *(const f32x4*)qh, q1 = *(const f32x4*)(qh + 4);
                        a[i] += q0.x * cv[0] + q0.y * cv[1] + q0.z * cv[2] + q0.w * cv[3] + q1.x * cv[4] + q1.y * cv[5] + q1.z * cv[6] + q1.w * cv[7]; }
                }
            }
#pragma unroll
            for (int i = 0; i < 8; ++i) att[(hh * 8 + i) * 256 + k] = (k < nsel) ? a[i] * 0.08838834764831845f : -INFINITY;
        }
        __syncthreads();
        {
#pragma unroll
            for (int hi = 0; hi < 2; ++hi) { float* row = att + (wid * 2 + hi) * 256;
                float v[4]; float mx = -INFINITY;
#pragma unroll
                for (int i = 0; i < 4; ++i) { v[i] = row[lane + 64 * i]; mx = fmaxf(mx, v[i]); }
                mx = wave_max(mx); float s = 0.f;
#pragma unroll
                for (int i = 0; i < 4; ++i) { v[i] = __expf(v[i] - mx); s += v[i]; }
                s = wave_sum(s); const float inv = 1.f / s;
#pragma unroll
                for (int i = 0; i < 4; ++i) row[lane + 64 * i] = v[i] * inv; }
        }
        __syncthreads();
        {
            float o[16];
#pragma unroll
            for (int i = 0; i < 16; ++i) o[i] = 0.f;
            for (int k = 0; k < nsel; ++k) {
                const float cv = bf2f(CN[(size_t)(b * SEQ + sl[k]) * CL + tid]);
#pragma unroll
                for (int h = 0; h < 16; ++h) o[h] += att[h * 256 + k] * cv;
            }
#pragma unroll
            for (int h = 0; h < 16; ++h) { const float f = bf2f(QLfast[(size_t)t * 8192 + h * 512 + tid]); dmax = fmaxf(dmax, fabsf(f - o[h])); rmax = fmaxf(rmax, fabsf(o[h])); }
        }
    }
    atomicMax(res + 2, __float_as_uint(dmax)); atomicMax(res + 3, __float_as_uint(rmax));
}
#endif
#define XB_TMO      128
#define XB_XCNT(j)  (256  + 64 * (j))
#define XB_XSUB(j)  (1280 + 64 * (j))
#define XB_XGEN(j)  (2304 + 64 * (j))
#define XB_TOP      3328
#define XB_TOPGEN   3392
#define XCD_BAR_WORDS 3456
#define XB_SPIN_CAP (1u << 18)

__device__ __forceinline__ unsigned xb_ld(unsigned* p)              { return __hip_atomic_load(p, __ATOMIC_RELAXED, __HIP_MEMORY_SCOPE_AGENT); }
__device__ __forceinline__ unsigned xb_add(unsigned* p, unsigned v) { return __hip_atomic_fetch_add(p, v, __ATOMIC_RELAXED, __HIP_MEMORY_SCOPE_AGENT); }
__device__ __forceinline__ unsigned xb_xcc_id() { return (unsigned)__builtin_amdgcn_s_getreg((3 << 11) | 20) & 0xFu; }
#define XB_SPIN(cond, bar) do { unsigned _sp = 0; while (cond) { __builtin_amdgcn_s_sleep(1); \
    if ((++_sp & 255u) == 0u) { if (xb_ld(&(bar)[XB_TMO])) break; if (_sp > XB_SPIN_CAP) { atomicAdd(&(bar)[XB_TMO], 1u); break; } } } } while (0)

struct XcdBarrier {
    unsigned* bar; unsigned x;
    volatile LAS unsigned* st;
};

__device__ __forceinline__ XcdBarrier xcd_barrier_post(unsigned* bar, volatile LAS unsigned* st) {
    XcdBarrier b; b.bar = bar; b.x = xb_xcc_id(); b.st = st;
    if (threadIdx.x == 0) (void)xb_add(&bar[XB_XCNT(b.x)], 1u);
    return b;
}
__device__ __forceinline__ void xcd_barrier_complete(unsigned* bar, unsigned x, unsigned& nloc, unsigned& nx) {
    const unsigned G = gridDim.x * gridDim.y * gridDim.z;
    unsigned sum, cnt, mine, sp = 0u;
    for (;;) {
        sum = 0u; cnt = 0u; mine = 0u;
#pragma unroll
        for (unsigned j = 0; j < 16; ++j) { const unsigned c = xb_ld(&bar[XB_XCNT(j)]); sum += c; cnt += (c > 0u) ? 1u : 0u; mine = (j == x) ? c : mine; }
        if (sum == G) break;
        __builtin_amdgcn_s_sleep(1);
        if ((++sp & 255u) == 0u) { if (xb_ld(&bar[XB_TMO])) break; if (sp > XB_SPIN_CAP) { atomicAdd(&bar[XB_TMO], 1u); break; } }
    }
    nloc = mine > 0u ? mine : 1u; nx = cnt > 0u ? cnt : 1u;
}

__device__ __forceinline__ void xcd_barrier(const XcdBarrier& b) {
    asm volatile("s_waitcnt vmcnt(0)" ::: "memory");
    __syncthreads();
    if (threadIdx.x == 0) {
        unsigned* bar = b.bar;
        __builtin_amdgcn_s_waitcnt(0);
        unsigned nloc = b.st[0], nx = b.st[1];
        if (nloc == 0u) { xcd_barrier_complete(bar, b.x, nloc, nx); b.st[0] = nloc; b.st[1] = nx; }
        const unsigned old = xb_add(&bar[XB_XSUB(b.x)], 1u);
        const unsigned gen = old / nloc;
        if (old + 1u == (gen + 1u) * nloc) {
            __builtin_amdgcn_fence(__ATOMIC_RELEASE, "agent");
            asm volatile("s_waitcnt vmcnt(0)" ::: "memory");
            const unsigned og = xb_add(&bar[XB_TOP], 1u);
            const unsigned tg = og / nx;
            if (og + 1u == (tg + 1u) * nx) xb_add(&bar[XB_TOPGEN], 1u);
            else XB_SPIN(xb_ld(&bar[XB_TOPGEN]) == tg, bar);
            __builtin_amdgcn_fence(__ATOMIC_ACQUIRE, "agent");
            xb_add(&bar[XB_XGEN(b.x)], 1u);
            asm volatile("s_waitcnt vmcnt(0)" ::: "memory");
        } else {
            XB_SPIN(xb_ld(&bar[XB_XGEN(b.x)]) == gen, bar);
            __builtin_amdgcn_fence(__ATOMIC_ACQUIRE, "agent");
            asm volatile("s_waitcnt vmcnt(0)" ::: "memory");
        }
    }
    __syncthreads();
}

#define LDS_WAIT() asm volatile("s_waitcnt lgkmcnt(0)" ::: "memory")
#define VM_WAIT() asm volatile("s_waitcnt vmcnt(0)" ::: "memory")
template <class ColMap>
__device__ __forceinline__ void transpose_item(const float* W, int ldw, int ks0, bf16* WT, int ldd, int kd0, int n0, const ColMap& cm, const float* kscale, LAS float* scr, int lane) {
    const int sc = cm(n0 + (lane & 31));
#pragma unroll 8
    for (int i = 0; i < 32; ++i) { const int kk = 2 * i + (lane >> 5); float v = 0.f;
        if (sc >= 0) { v = W[(size_t)(ks0 + kk) * ldw + sc]; if (kscale) v *= kscale[ks0 + kk]; }
        scr[kk * 33 + (lane & 31)] = v; }
    LDS_WAIT(); asm volatile("" ::: "memory");
    const int c = lane & 7;
#pragma unroll
    for (int j = 0; j < 4; ++j) { const int n = (lane >> 3) + 8 * j; const LAS float* s = scr + (8 * c) * 33 + n;
        u32x4 o; o.x = pk2(s[0 * 33], s[1 * 33]); o.y = pk2(s[2 * 33], s[3 * 33]); o.z = pk2(s[4 * 33], s[5 * 33]); o.w = pk2(s[6 * 33], s[7 * 33]);
        *(u32x4*)(WT + (size_t)(n0 + n) * ldd + kd0 + 8 * c) = o; }
    LDS_WAIT(); asm volatile("" ::: "memory");
}
struct CmIdent { __device__ __forceinline__ int operator()(int n) const { return n; } };
struct CmWin { __device__ __forceinline__ int operator()(int n) const { return n < 7760 ? n : (n < 7936 ? -1 : n - 176); } };
struct CmGU { __device__ __forceinline__ int operator()(int n) const { return (n >> 8) * 128 + (n & 127); } };

__device__ __forceinline__ void p0_prologue(LAS unsigned char* lds, const float* x, const float* norm1_g, const float* w_in, const float* w_uk, const float* w_uv,
                                            const float* w_oa, const float* w_ob, const float* w_out, bf16* XN, bf16* WIN, bf16* WUK, bf16* WUV, bf16* WOA, bf16* WOB, bf16* WOUT,
                                            int gw, int ngw, int wave, int lane) {
    LAS float* scr = (LAS float*)(lds + wave * 16384);
    constexpr int I_IN = 32 * (NINP / 32), I_SQ = 32 * 64, I_UV = 16 * 64;
    constexpr int NITEMS = I_IN + 3 * I_SQ + I_UV;
    for (int it = gw; it < NITEMS; it += ngw) {
        int r = it;
        if (r < I_IN) { const int nb = r % (NINP / 32), kb = r / (NINP / 32); transpose_item(w_in, NIN, kb * 64, WIN, D, kb * 64, nb * 32, CmWin(), nullptr, scr, lane); continue; } r -= I_IN;
        if (r < I_SQ) { transpose_item(w_oa, D, (r / 64) * 64, WOA, D, (r / 64) * 64, (r % 64) * 32, CmIdent(), nullptr, scr, lane); continue; } r -= I_SQ;
        if (r < I_SQ) { transpose_item(w_ob, D, (r / 64) * 64, WOB, D, (r / 64) * 64, (r % 64) * 32, CmIdent(), nullptr, scr, lane); continue; } r -= I_SQ;
        if (r < I_SQ) { transpose_item(w_out, D, (r / 64) * 64, WOUT, D, (r / 64) * 64, (r % 64) * 32, CmIdent(), nullptr, scr, lane); continue; } r -= I_SQ;
        {
            const int nb = r % 64, kb = r / 64, h = nb >> 2; const bool data = (kb >> 3) == (h & 1);
            if (data) transpose_item(w_uv, D, (kb & 7) * 64, WUV, 1024, kb * 64, nb * 32, CmIdent(), nullptr, scr, lane);
            else { const int c = lane & 7;
#pragma unroll
                for (int j = 0; j < 4; ++j) { const int n = (lane >> 3) + 8 * j; *(u32x4*)(WUV + (size_t)(nb * 32 + n) * 1024 + kb * 64 + 8 * c) = (u32x4){0u, 0u, 0u, 0u}; } }
        }
    }
    for (int i = gw * 64 + lane; i < 16 * 512 * 16; i += ngw * 64) { const int d8 = i & 15, c = (i >> 4) & 511, h = i >> 13;
        const f32x4* s = (const f32x4*)(w_uk + (size_t)c * 2048 + h * 128 + d8 * 8); const f32x4 a = s[0], b = s[1];
        u32x4 o; o.x = pk2(a[0], a[1]); o.y = pk2(a[2], a[3]); o.z = pk2(b[0], b[1]); o.w = pk2(b[2], b[3]);
        *(u32x4*)(WUK + ((size_t)h * 512 + c) * 128 + d8 * 8) = o; }
    rows_xn(x, norm1_g, XN, gw, ngw, lane);
}
__device__ __forceinline__ void p_convert_ffn(LAS unsigned char* lds, const float* w_fg, const float* w_fu, const float* w_fd, const float* norm2_g, bf16* WGU, bf16* WD, int gw, int ngw, int wave, int lane) {
    LAS float* scr = (LAS float*)(lds + wave * 16384);
    constexpr int I_GU = 32 * (11264 / 32), I_D = 88 * 64;
    for (int it = gw; it < I_GU + I_D; it += ngw) {
        int r = it;
        if (r < I_GU) { const int nb = r % 352, kb = r / 352; const bool up = ((nb * 32) & 128) != 0;
            transpose_item(up ? w_fu : w_fg, FF, kb * 64, WGU, D, kb * 64, nb * 32, CmGU(), norm2_g, scr, lane); continue; } r -= I_GU;
        transpose_item(w_fd, D, (r / 64) * 64, WD, FF, (r / 64) * 64, (r % 64) * 32, CmIdent(), nullptr, scr, lane);
    }
}

#ifndef REPEAT_MASK
#define REPEAT_MASK 0
#endif
__device__ __forceinline__ int opaque_one() { int x = 1; asm volatile("" : "+s"(x)); return x; }
#define REP(k) for (int rep_ = 0, repn_ = (((REPEAT_MASK >> (k)) & 1) ? 1 + opaque_one() : 1); rep_ < repn_; ++rep_)

#define P_X ((const float*)ka->in[0])
#define P_NORM1 ((const float*)ka->in[1])
#define P_WIN_F ((const float*)ka->in[2])
#define P_LNG ((const float*)ka->in[3])
#define P_LNB ((const float*)ka->in[4])
#define P_WS_F ((const float*)ka->in[5])
#define P_BS_F ((const float*)ka->in[6])
#define P_KVG ((const float*)ka->in[7])
#define P_WUK_F ((const float*)ka->in[8])
#define P_WUV_F ((const float*)ka->in[9])
#define P_WOA_F ((const float*)ka->in[10])
#define P_WOB_F ((const float*)ka->in[11])
#define P_WOUT_F ((const float*)ka->in[12])
#define P_NORM2 ((const float*)ka->in[13])
#define P_WFG ((const float*)ka->in[14])
#define P_WFU ((const float*)ka->in[15])
#define P_WFD ((const float*)ka->in[16])
#define P_FING ((const float*)ka->in[17])
#define B16(off) ((bf16*)(ws + (off)))
#define F32(off) ((float*)(ws + (off)))
constexpr int CW_BAR = 4096;
struct Args { const float* in[18]; float* out; unsigned char* ws; int ph_lo, ph_hi, use_bar, pad; };
constexpr int N_PHASES = 12;

template <int ONLY> __global__ void __launch_bounds__(NTHREADS, 2) mk_fwd(Args a) {
    extern __shared__ __attribute__((aligned(16))) unsigned char lds_g[];
    LAS unsigned char* lds = (LAS unsigned char*)lds_g;
    float* ldsf = (float*)lds_g;
    const int tid = threadIdx.x, lane = tid & 63, wave = __builtin_amdgcn_readfirstlane(tid >> 6);
    const int G = gridDim.x, vb = blockIdx.x;
    const int gw = vb * NWAVES + wave, ngw = G * NWAVES;
    const __attribute__((address_space(4))) Args* ka = (const __attribute__((address_space(4))) Args*)__builtin_amdgcn_kernarg_segment_ptr();
    unsigned char* const ws = a.ws;
    for (int u = tid; u < (LDS_BYTES - LDSCTL_OFF) / 4; u += NTHREADS) ((LAS unsigned*)(lds + LDSCTL_OFF))[u] = 0u;
    __syncthreads();
    XcdBarrier bar; bar.bar = (unsigned*)(ws + WS_CTL) + CW_BAR; bar.x = 0; bar.st = nullptr;
    if (a.use_bar) bar = xcd_barrier_post((unsigned*)(ws + WS_CTL) + CW_BAR, (volatile LAS unsigned*)(lds + MISC_OFF) + 8);
    const int lo = a.ph_lo, hi = a.ph_hi;
#ifndef SKIPMASK
#define SKIPMASK 0
#endif
#define IN(k) (!((SKIPMASK >> (k)) & 1) && (ONLY < 0 || ONLY == (k)) && lo <= (k) && (k) < hi)
#ifdef DBG_TIME
#define STAMP(i) do { if (vb == 0 && tid == 0) ((unsigned long long*)(ws + WS_CTL + 32768))[i] = __builtin_amdgcn_s_memrealtime(); } while (0)
#define SEAM(k) do { STAMP(2 * (k) + 1); if (IN(k) && IN((k) + 1)) xcd_barrier(bar); STAMP(2 * (k) + 2); } while (0)
#else
#define STAMP(i) do { } while (0)
#ifdef DBG_BAR2
#define SEAM(k) do { if (IN(k) && IN((k) + 1)) { xcd_barrier(bar); xcd_barrier(bar); } } while (0)
#else
#define SEAM(k) do { if (IN(k) && IN((k) + 1)) xcd_barrier(bar); } while (0)
#endif
#endif

    STAMP(0);
    if (IN(0)) REP(0) { p0_prologue(lds, P_X, P_NORM1, P_WIN_F, P_WUK_F, P_WUV_F, P_WOA_F, P_WOB_F, P_WOUT_F, B16(WS_XN), B16(WS_WIN), B16(WS_WUK), B16(WS_WUV), B16(WS_WOA), B16(WS_WOB), B16(WS_WOUT), gw, ngw, wave, lane); }
    SEAM(0);
#if defined(NAIVEMASK) && (NAIVEMASK & (1 << 1))
    if (IN(1)) { EpiProj e{B16(WS_U), B16(WS_V), B16(WS_Q), B16(WS_QI), B16(WS_KI), B16(WS_GA), B16(WS_GB), F32(WS_CKR), F32(WS_WI), 0}; naive_gemm<false>(ldsf, B16(WS_XN), D, P_WIN_F, nullptr, NIN, nullptr, M, NIN, D, e, vb, G); }
#else
    if (IN(1)) REP(1) { pg8::Gemm g{B16(WS_XN), B16(WS_WIN), D, D, D}; pg8::StaticOrder S; S.init(M, NINP, G, vb);
        pg8::EpiProjF E{ws};
        pg8::gemm_phase<pg8::EpiProjF, pg8::StaticOrder, true, true>(lds, g, S, E); }
#endif
    SEAM(1);
#if defined(NAIVEMASK)
    if (ONLY == 101) { rows_vst(B16(WS_V), F32(WS_VST), gw, ngw, lane); }
    if (ONLY == 102) { rows_hst(ka->out, F32(WS_HST), gw, ngw, lane); }
#endif
    if (IN(2)) { REP(11) rows_cn(F32(WS_CKR), P_KVG, B16(WS_CN), gw, ngw, lane); REP(12) fast_gating(lds, B16(WS_U), B16(WS_V), F32(WS_VST), P_LNG, P_LNB, P_WS_F, P_BS_F, vb, G, wave, lane, rep_ + 1 < repn_); REP(2) fast_scores(B16(WS_QI), B16(WS_KI), F32(WS_WI), F32(WS_SC), vb, G, wave, lane); __syncthreads(); }
    SEAM(2);
#ifdef DBG_CHECK
    if (IN(3)) { dbg_scores(ldsf, B16(WS_QI), B16(WS_KI), F32(WS_WI), F32(WS_SC), (unsigned*)(ws + WS_CTL) + 3000, vb, G); __syncthreads(); }
#endif
#if defined(NAIVEMASK) && (NAIVEMASK & (1 << 3))
    if (IN(3)) { EpiGateA e{B16(WS_GA)}; naive_gemm<false>(ldsf, B16(WS_U), D, P_WOA_F, nullptr, D, nullptr, M, D, D, e, vb, G); topk_rows(F32(WS_SC), (int*)(ws + WS_SEL), gw, ngw, lane); }
#else
    if (IN(3)) { pg8::Gemm g{B16(WS_U), B16(WS_WOA), D, D, D}; pg8::StaticOrder S; S.init(M, D, G, vb);
        for (int rep_ = ((REPEAT_MASK >> 13) & 1) ? 0 : 1; rep_ < 2; ++rep_) { pg8::EpiGateAF E{B16(WS_GA), rep_ == 0}; pg8::gemm_phase<pg8::EpiGateAF, pg8::StaticOrder, true, true>(lds, g, S, E); }
        topk_rows(F32(WS_SC), (int*)(ws + WS_SEL), gw, ngw, lane); }
#endif
    SEAM(3);
#if defined(NAIVEMASK) && (NAIVEMASK & (1 << 4))
    if (IN(4)) { naive_qlat(ldsf, B16(WS_Q), P_WUK_F, B16(WS_QL), vb, G); }
#else
    if (IN(4)) REP(4) { int kq = 128; asm volatile("" : "+s"(kq)); pg8::Gemm g{B16(WS_Q), B16(WS_WUK), D, 128, kq}; pg8::HeadOrderQ S{G, vb}; pg8::EpiQlatF E{B16(WS_QL)};
        pg8::gemm_phase<pg8::EpiQlatF, pg8::HeadOrderQ, true, true>(lds, g, S, E); }
#endif
    SEAM(4);
#ifdef DBG_CHECK
    if (IN(5)) { for (int ii = vb; ii < 256; ii += G) { const u32x4* src = (const u32x4*)(B16(WS_QL) + (size_t)(ii * 32 + 17) * 8192); u32x4* dst = (u32x4*)(ws + 326 * MiB) + (size_t)ii * 1024; for (int e = tid; e < 1024; e += NTHREADS) dst[e] = src[e]; } xcd_barrier(bar); }
#endif
    if (IN(5)) { attn_wave(lds, B16(WS_QL), B16(WS_CN), (const int*)(ws + WS_SEL), vb, G, wave, lane); __syncthreads(); }
    SEAM(5);
#ifdef DBG_CHECK
    if (IN(6)) { dbg_attn(ldsf, (bf16*)(ws + 326 * MiB), B16(WS_QL), B16(WS_CN), (const int*)(ws + WS_SEL), (unsigned*)(ws + WS_CTL) + 3000, vb, G); __syncthreads(); }
#endif
#if defined(NAIVEMASK) && (NAIVEMASK & (1 << 6))
    if (IN(6)) { naive_yb(ldsf, B16(WS_QL), P_WUV_F, B16(WS_Q), vb, G); }
#else
    if (IN(6)) REP(6) { pg8::Gemm g{B16(WS_QL), B16(WS_WUV), 8192, 1024, 1024}; pg8::PairOrderYB S{G, vb}; pg8::EpiPlainF E{B16(WS_Q), D};
        pg8::gemm_phase<pg8::EpiPlainF, pg8::PairOrderYB, true, true>(lds, g, S, E); }
#endif
    SEAM(6);
#if defined(NAIVEMASK) && (NAIVEMASK & (1 << 7))
    if (IN(7)) { EpiGateB e{B16(WS_GA), B16(WS_GB)}; naive_gemm<false>(ldsf, B16(WS_Q), D, P_WOB_F, nullptr, D, nullptr, M, D, D, e, vb, G); p_convert_ffn(lds, P_WFG, P_WFU, P_WFD, P_NORM2, B16(WS_WGU), B16(WS_WD), gw, ngw, wave, lane); }
#else
    if (IN(7)) { pg8::Gemm g{B16(WS_Q), B16(WS_WOB), D, D, D}; pg8::StaticOrder S; S.init(M, D, G, vb); for (int rep_ = ((REPEAT_MASK >> 14) & 1) ? 0 : 1; rep_ < 2; ++rep_) { pg8::EpiGateBF E{B16(WS_GA), B16(WS_GB), rep_ == 0}; pg8::gemm_phase<pg8::EpiGateBF, pg8::StaticOrder, true, true>(lds, g, S, E); }
        REP(15) p_convert_ffn(lds, P_WFG, P_WFU, P_WFD, P_NORM2, B16(WS_WGU), B16(WS_WD), gw, ngw, wave, lane); }
#endif
    SEAM(7);
#if defined(NAIVEMASK) && (NAIVEMASK & (1 << 8))
    if (IN(8)) { EpiRes e{P_X, ka->out, B16(WS_HB)}; naive_gemm<false>(ldsf, B16(WS_GA), D, P_WOUT_F, nullptr, D, nullptr, M, D, D, e, vb, G); }
#else
    if (IN(8)) REP(8) { pg8::Gemm g{B16(WS_GA), B16(WS_WOUT), D, D, D}; pg8::StaticOrder S; S.init(M, D, G, vb); pg8::EpiResF E{P_X, ka->out, B16(WS_HB), F32(WS_HST)};
        pg8::gemm_phase<pg8::EpiResF, pg8::StaticOrder, true, true>(lds, g, S, E); }
#endif
    SEAM(8);
#if defined(NAIVEMASK) && (NAIVEMASK & (1 << 9))
    if (IN(9)) { EpiSwiglu e{F32(WS_HST), B16(WS_FF)}; naive_gemm<true>(ldsf, B16(WS_HB), D, P_WFG, P_WFU, FF, P_NORM2, M, FF, D, e, vb, G); }
#else
    if (IN(9)) REP(9) { pg8::Gemm g{B16(WS_HB), B16(WS_WGU), D, D, D}; pg8::StaticOrder S; S.init(M, 11264, G, vb); pg8::EpiSwigluF E{F32(WS_HST), B16(WS_FF)};
        pg8::gemm_phase<pg8::EpiSwigluF, pg8::StaticOrder, true, true>(lds, g, S, E); }
#endif
    SEAM(9);
#if defined(NAIVEMASK) && (NAIVEMASK & (1 << 10))
    if (IN(10)) { EpiRes2 e{ka->out}; naive_gemm<false>(ldsf, B16(WS_FF), FF, P_WFD, nullptr, D, nullptr, M, D, FF, e, vb, G); }
#else
    if (IN(10)) { pg8::Gemm g{B16(WS_FF), B16(WS_WD), FF, FF, FF}; pg8::StaticOrder S; S.init(M, D, G, vb); for (int rep_ = ((REPEAT_MASK >> 10) & 1) ? 0 : 1; rep_ < 2; ++rep_) { pg8::EpiRes2F E{ka->out, rep_ == 0}; pg8::gemm_phase<pg8::EpiRes2F, pg8::StaticOrder, true, true>(lds, g, S, E); } }
#endif
    SEAM(10);
    if (IN(11)) rows_final(ka->out, P_FING, gw, ngw, lane);
#ifdef DBG_TIME
    if (IN(11)) { STAMP(23); xcd_barrier(bar); if (vb == 0) { const unsigned long long* ts = (const unsigned long long*)(ws + WS_CTL + 32768);
            float total = (float)(ts[23] - ts[0]) * 0.01f; float barsum = 0.f; for (int k = 0; k < 11; ++k) barsum += (float)(ts[2 * k + 2] - ts[2 * k + 1]) * 0.01f;
            float ph[12]; for (int k = 0; k < 12; ++k) ph[k] = (float)(ts[2 * k + 1] - ts[2 * k]) * 0.01f;
            const float A = DBG_A, B = DBG_B;
            for (int e = tid; e < (1 << 20); e += NTHREADS) ka->out[e] += B;
            __syncthreads(); if (tid == 0) ka->out[0] = A; } }
#endif
#ifdef DBG_CHECK
    if (IN(11)) { xcd_barrier(bar); if (vb == 0 && tid == 0) { const unsigned* res = (const unsigned*)(ws + WS_CTL) + 3000; const float d = __uint_as_float(res[DBG_CHECK * 2]), r = __uint_as_float(res[DBG_CHECK * 2 + 1]); ka->out[0] = 1.0e6f * d / r + 100.f; } }
#endif
#undef IN
#undef SEAM
}

#ifndef MK_N_LAUNCHES
#define MK_N_LAUNCHES 1
#endif

template <int P> static void launch_one(int grid, Args a, hipStream_t stream) {
    static bool attr = false;
    if (!attr) { (void)hipFuncSetAttribute((const void*)mk_fwd<P>, hipFuncAttributeMaxDynamicSharedMemorySize, LDS_BYTES); attr = true; }
    a.ph_lo = (P < 0 || P > 99) ? 0 : P; a.ph_hi = (P < 0) ? N_PHASES : ((P > 99) ? 0 : P + 1); a.use_bar = (P < 0) ? 1 : 0;
    hipLaunchKernelGGL(mk_fwd<P>, dim3(grid), dim3(NTHREADS), LDS_BYTES, stream, a);
}
extern "C" void kernel_launch(void* const* d_in, const int* in_sizes, int n_in, void* d_out, int out_size, void* d_ws, size_t ws_size, hipStream_t stream) {
    static int grid = 0;
    if (grid == 0) {
        if (n_in != 18 || out_size != M * D || ws_size < WS_END) { fprintf(stderr, "kernel_launch: unexpected shapes n_in %d out %d ws %zu\n", n_in, out_size, ws_size); grid = -1; return; }
        int dev = 0, cus = 0;
        (void)hipGetDevice(&dev); (void)hipDeviceGetAttribute(&cus, hipDeviceAttributeMultiprocessorCount, dev);
        grid = cus > 0 ? cus : 256;
    }
    if (grid < 0) return;
    (void)hipMemsetAsync((char*)d_ws + WS_CTL, 0, CTL_ZERO_BYTES, stream);
    Args a{};
    for (int i = 0; i < 18; ++i) a.in[i] = (const float*)d_in[i];
    a.out = (float*)d_out; a.ws = (unsigned char*)d_ws;
#if MK_N_LAUNCHES == 1
    launch_one<-1>(grid, a, stream);
#else
    launch_one<0>(grid, a, stream); launch_one<1>(grid, a, stream);
#if defined(NAIVEMASK) && (NAIVEMASK & 2)
    launch_one<101>(grid, a, stream);
#endif
    launch_one<2>(grid, a, stream); launch_one<3>(grid, a, stream); launch_one<4>(grid, a, stream); launch_one<5>(grid, a, stream);
    launch_one<6>(grid, a, stream); launch_one<7>(grid, a, stream); launch_one<8>(grid, a, stream);
#if defined(NAIVEMASK) && (NAIVEMASK & (1 << 8))
    launch_one<102>(grid, a, stream);
#endif
    launch_one<9>(grid, a, stream); launch_one<10>(grid, a, stream); launch_one<11>(grid, a, stream);
#endif
}
```

```cpp
#include <hip/hip_runtime.h>
#include <cstdio>
#include <cstdint>

#define DBG_A W[5]
#define DBG_B W[2]
constexpr int BATCH = 2, SEQ = 4096, D = 2048, M = BATCH * SEQ, NIN = 11856, FF = 5632;
constexpr int CL = 512, NH = 16, HD = 128, IH = 16, IDM = 64, TOPK = 256, CHUNK = 64;
constexpr int NINP = 12032;
constexpr float EPS = 1e-6f;
constexpr int NTHREADS = 512, NWAVES = 8;

#define LAS __attribute__((address_space(3)))
#define GAS __attribute__((address_space(1)))
typedef unsigned short bf16;
typedef float f32x4 __attribute__((ext_vector_type(4)));
typedef float f32x2 __attribute__((ext_vector_type(2)));
typedef unsigned u32x4 __attribute__((ext_vector_type(4)));
typedef unsigned u32x2 __attribute__((ext_vector_type(2)));

__device__ __forceinline__ float bf2f(bf16 v) { return __uint_as_float(((unsigned)v) << 16); }
__device__ __forceinline__ bf16 f2bf(float f) { unsigned u = __float_as_uint(f); return (bf16)((u + 0x7fffu + ((u >> 16) & 1u)) >> 16); }
__device__ __forceinline__ unsigned pk2(float lo, float hi) { return (unsigned)f2bf(lo) | ((unsigned)f2bf(hi) << 16); }
__device__ __forceinline__ float bflo(unsigned w) { return __uint_as_float(w << 16); }
__device__ __forceinline__ float bfhi(unsigned w) { return __uint_as_float(w & 0xffff0000u); }
__device__ __forceinline__ float wave_sum(float v) {
#pragma unroll
    for (int o = 1; o < 64; o <<= 1) v += __shfl_xor(v, o);
    return v;
}
__device__ __forceinline__ float wave_max(float v) {
#pragma unroll
    for (int o = 1; o < 64; o <<= 1) v = fmaxf(v, __shfl_xor(v, o));
    return v;
}
__device__ __forceinline__ float gelu_tanh(float x) {
    const float u2 = 1.5957691216057308f * (x + 0.044715f * x * x * x);
    return x * __builtin_amdgcn_rcpf(1.f + __expf(-u2));
}
__device__ __forceinline__ float sigmoidf(float x) { return __builtin_amdgcn_rcpf(1.f + __expf(-x)); }

constexpr size_t MiB = 1u << 20;
constexpr size_t WS_CTL = 0, CTL_ZERO_BYTES = 64 * 1024;
constexpr size_t WS_VST = 1 * MiB;
constexpr size_t WS_HST = 3 * MiB;
constexpr size_t WS_WI = 4 * MiB;
constexpr size_t WS_KI = 5 * MiB;
constexpr size_t WS_SEL = 6 * MiB;
constexpr size_t WS_CN = 14 * MiB;
constexpr size_t WS_CKR = 22 * MiB;
constexpr size_t WS_QI = 38 * MiB;
constexpr size_t WS_WUK = 54 * MiB;
constexpr size_t WS_WUV = 56 * MiB;
constexpr size_t WS_WOA = 60 * MiB;
constexpr size_t WS_WOB = 68 * MiB;
constexpr size_t WS_WOUT = 76 * MiB;
constexpr size_t WS_WIN = 86 * MiB;
constexpr size_t WS_XN = 133 * MiB;
constexpr size_t WS_SC = 101 * MiB;
constexpr size_t WS_QL = 102 * MiB;
constexpr size_t WS_U = 166 * MiB;
constexpr size_t WS_V = 198 * MiB;
constexpr size_t WS_Q = 230 * MiB;
constexpr size_t WS_GA = 262 * MiB;
constexpr size_t WS_GB = 294 * MiB;
constexpr size_t WS_WGU = 86 * MiB;
constexpr size_t WS_WD = 130 * MiB;
constexpr size_t WS_HB = 152 * MiB;
constexpr size_t WS_FF = 230 * MiB;
constexpr size_t WS_END = 326 * MiB;

constexpr int RING_BYTES = 131072;
constexpr int LDS_BYTES = 163840;
constexpr int LDSCTL_OFF = LDS_BYTES - 512, MISC_OFF = LDSCTL_OFF + 320;
constexpr size_t SC_PER_BATCH = 8519680;

__device__ __forceinline__ size_t sc_off(int b, int pos) {
    const int c = pos >> 6, r = pos & 63;
    return (size_t)b * SC_PER_BATCH + (size_t)2048 * c * (c + 1) + (size_t)r * 64 * (c + 1);
}
namespace pg8 {
#define PG8_LAS __attribute__((address_space(3)))
typedef unsigned short bf16_t;
typedef short bf16x8 __attribute__((ext_vector_type(8)));
typedef float f32x4 __attribute__((ext_vector_type(4)));
typedef unsigned u32x4 __attribute__((ext_vector_type(4)));
constexpr int BM = 256, BK = 64, HALF = 128, HTB = HALF * BK * 2  , STAGE_BYTES = 8 * HTB, NXCD = 8, WGM = 8;

__host__ __device__ __forceinline__ int lds_byte(int r, int c) { const int st = (r >> 4) * 2 + (c >> 5), rr = r & 15, cc = c & 31, ob = rr * 64 + cc * 2; return st * 1024 + (ob ^ (((ob >> 9) & 1) << 5)); }
__host__ __device__ __forceinline__ void stage_rc(int b, int& R, int& C) { const int st = b / 1024, sb = b % 1024, swz = sb ^ (((sb >> 9) & 1) << 5); R = (st >> 1) * 16 + swz / 64; C = (st & 1) * 32 + (swz % 64) / 2; }
__host__ __device__ __forceinline__ int perm32(int rho) { const int n = rho >> 4, i = rho & 15; return 8 * (i >> 2) + 4 * n + (i & 3); }

struct Unit { int pm, pn, h; };
struct Gemm { const bf16_t* A; const bf16_t* Bt; int lda, ldb, K; };

struct StaticOrder {
    int nM, nN, nwg, G, c;
    __host__ __device__ void init(int M_, int N_, int G_, int c_) { nM = M_ / BM; nN = N_ / BM; nwg = nM * nN; G = G_; c = c_; }
    __host__ __device__ bool next(int i, Unit& u) const {
        const long L = (long)i * G + c; if (L >= nwg) return false;
        int wgid = (int)L; { const int q = nwg / NXCD, r = nwg % NXCD, xcd = wgid % NXCD, off = wgid / NXCD; wgid = (xcd < r ? xcd * (q + 1) : r * (q + 1) + (xcd - r) * q) + off; }
        const int nig = WGM * nN, gid = wgid / nig, fm = gid * WGM, gsz = (nM - fm) < WGM ? (nM - fm) : WGM;
        u.pm = fm + ((wgid % nig) % gsz); u.pn = (wgid % nig) / gsz; u.h = 0; return true;
    }
    __device__ __forceinline__ void ptrs(const Unit& u, const Gemm& g, const char*& a, const char*& b) const {
        a = (const char*)g.A + (size_t)u.pm * BM * g.lda * 2; b = (const char*)g.Bt + (size_t)u.pn * BM * g.ldb * 2; }
    __device__ __forceinline__ void a_ready(const Unit&) const {}
    __device__ __forceinline__ void done(const Unit&) const {}
};
struct HeadOrderQ {
    int G, c;
    __device__ bool next(int i, Unit& u) const { const int L = i * G + c; if (L >= 1024) return false; u.h = L >> 6; u.pn = (L >> 5) & 1; u.pm = L & 31; return true; }
    __device__ __forceinline__ void ptrs(const Unit& u, const Gemm& g, const char*& a, const char*& b) const {
        a = (const char*)g.A + ((size_t)u.pm * BM * g.lda + u.h * 128) * 2; b = (const char*)g.Bt + (size_t)(u.h * 512 + u.pn * BM) * g.ldb * 2; }
    __device__ __forceinline__ void a_ready(const Unit&) const {}
    __device__ __forceinline__ void done(const Unit&) const {}
};
struct PairOrderYB {
    int G, c;
    __device__ bool next(int i, Unit& u) const { const int L = i * G + c; if (L >= 256) return false; u.h = 0; u.pn = L >> 5; u.pm = L & 31; return true; }
    __device__ __forceinline__ void ptrs(const Unit& u, const Gemm& g, const char*& a, const char*& b) const {
        a = (const char*)g.A + ((size_t)u.pm * BM * g.lda + u.pn * 1024) * 2; b = (const char*)g.Bt + (size_t)(u.pn * BM) * g.ldb * 2; }
    __device__ __forceinline__ void a_ready(const Unit&) const {}
    __device__ __forceinline__ void done(const Unit&) const {}
};

typedef __bf16 bf16x2_t __attribute__((ext_vector_type(2)));
typedef float f32x2c __attribute__((ext_vector_type(2)));
__device__ __forceinline__ unsigned cvt_pk_bf16(float lo, float hi) { const f32x2c v = {lo, hi}; const bf16x2_t b = __builtin_convertvector(v, bf16x2_t); return __builtin_bit_cast(unsigned, b); }
__device__ __forceinline__ u32x4 pack8(const f32x4 v0, const f32x4 v1) { u32x4 w; w.x = cvt_pk_bf16(v0[0], v0[1]); w.y = cvt_pk_bf16(v0[2], v0[3]); w.z = cvt_pk_bf16(v1[0], v1[1]); w.w = cvt_pk_bf16(v1[2], v1[3]); return w; }
__device__ __forceinline__ float gelu1(float x) { const float u2 = 1.5957691216057308f * (x + 0.044715f * x * x * x); return x * __builtin_amdgcn_rcpf(1.f + __expf(-u2)); }
__device__ __forceinline__ float sigm1(float x) { return __builtin_amdgcn_rcpf(1.f + __expf(-x)); }
template <int ACT> __device__ __forceinline__ f32x4 act4(f32x4 v) {
    if (ACT == 1) { v[0] = gelu1(v[0]); v[1] = gelu1(v[1]); v[2] = gelu1(v[2]); v[3] = gelu1(v[3]); }
    if (ACT == 2) { v[0] = sigm1(v[0]); v[1] = sigm1(v[1]); v[2] = sigm1(v[2]); v[3] = sigm1(v[3]); }
    return v;
}
template <int ACT> __device__ __forceinline__ void store_tile_bf16(const f32x4 (&acc)[2][2][4][2], bf16_t* base, int ld, int row0) {
#pragma unroll
    for (int ai = 0; ai < 2; ++ai)
#pragma unroll
        for (int m = 0; m < 4; ++m) { bf16_t* rowp = base + (size_t)(row0 + ai * HALF + m * 16) * ld;
#pragma unroll
            for (int bj = 0; bj < 2; ++bj) *(u32x4*)(rowp + bj * HALF) = pack8(act4<ACT>(acc[ai][bj][m][0]), act4<ACT>(acc[ai][bj][m][1])); }
}

struct EpiProjF {
    static constexpr bool PERM = true, AFTER_DRAIN = false;
    unsigned char* ws;
    __device__ __forceinline__ void operator()(const f32x4 (&acc)[2][2][4][2], const Unit& u, int wr, int wc, int fr, int fq) const {
        const int pn = u.pn, row0 = u.pm * BM + wr * 64 + fr, c8 = wc * 32 + 8 * fq;
        if (pn < 8) store_tile_bf16<1>(acc, (bf16_t*)(ws + WS_U) + pn * 256 + c8, 2048, row0);
        else if (pn < 16) {
            bf16_t* base = (bf16_t*)(ws + WS_V) + (pn - 8) * 256 + c8; float* VST = (float*)(ws + WS_VST);
#pragma unroll
            for (int ai = 0; ai < 2; ++ai)
#pragma unroll
                for (int m = 0; m < 4; ++m) { const int row = row0 + ai * HALF + m * 16; float s = 0.f, q = 0.f;
#pragma unroll
                    for (int bj = 0; bj < 2; ++bj) { const f32x4 v0 = act4<1>(acc[ai][bj][m][0]), v1 = act4<1>(acc[ai][bj][m][1]);
                        s += (v0[0] + v0[1]) + (v0[2] + v0[3]) + (v1[0] + v1[1]) + (v1[2] + v1[3]);
                        q += (v0[0] * v0[0] + v0[1] * v0[1]) + (v0[2] * v0[2] + v0[3] * v0[3]) + (v1[0] * v1[0] + v1[1] * v1[1]) + (v1[2] * v1[2] + v1[3] * v1[3]);
                        *(u32x4*)(base + (size_t)row * 2048 + bj * HALF) = pack8(v0, v1); }
                    s += __shfl_xor(s, 16); s += __shfl_xor(s, 32); q += __shfl_xor(q, 16); q += __shfl_xor(q, 32);
                    if (fq == 0) *(f32x2*)(VST + ((size_t)row * 32 + (pn - 8) * 4 + wc) * 2) = (f32x2){s, q};
                    asm volatile("" ::: "memory"); }
        }
        else if (pn < 24) store_tile_bf16<0>(acc, (bf16_t*)(ws + WS_Q) + (pn - 16) * 256 + c8, 2048, row0);
        else if (pn < 26) {
            float* base = (float*)(ws + WS_CKR) + (pn - 24) * 256 + c8;
#pragma unroll
            for (int ai = 0; ai < 2; ++ai)
#pragma unroll
                for (int m = 0; m < 4; ++m) { float* rowp = base + (size_t)(row0 + ai * HALF + m * 16) * 512;
#pragma unroll
                    for (int bj = 0; bj < 2; ++bj) { *(f32x4*)(rowp + bj * HALF) = acc[ai][bj][m][0]; *(f32x4*)(rowp + bj * HALF + 4) = acc[ai][bj][m][1]; } }
        }
        else if (pn < 30) store_tile_bf16<0>(acc, (bf16_t*)(ws + WS_QI) + (pn - 26) * 256 + c8, 1024, row0);
        else if (pn == 30) {
            bf16_t* KI = (bf16_t*)(ws + WS_KI); float* WI = (float*)(ws + WS_WI);
#pragma unroll
            for (int ai = 0; ai < 2; ++ai)
#pragma unroll
                for (int m = 0; m < 4; ++m) { const size_t row = row0 + ai * HALF + m * 16;
                    if (c8 < 64) *(u32x4*)(KI + row * 64 + c8) = pack8(acc[ai][0][m][0], acc[ai][0][m][1]);
                    else if (c8 < 80) { *(f32x4*)(WI + row * 16 + (c8 - 64)) = acc[ai][0][m][0]; *(f32x4*)(WI + row * 16 + (c8 - 64) + 4) = acc[ai][0][m][1]; } }
        }
        else store_tile_bf16<2>(acc, (bf16_t*)(ws + WS_GA) + (size_t)(pn >= 39 ? (WS_GB - WS_GA) / 2 : 0) + ((pn - 31) & 7) * 256 + c8, 2048, row0);
    }
};
struct EpiQlatF {
    static constexpr bool PERM = true, AFTER_DRAIN = false;
    bf16_t* QL;
    __device__ __forceinline__ void operator()(const f32x4 (&acc)[2][2][4][2], const Unit& u, int wr, int wc, int fr, int fq) const {
        store_tile_bf16<0>(acc, QL + u.h * 512 + u.pn * 256 + wc * 32 + 8 * fq, 8192, u.pm * BM + wr * 64 + fr); }
};
struct EpiPlainF {
    static constexpr bool PERM = true, AFTER_DRAIN = false;
    bf16_t* O; int ld;
    __device__ __forceinline__ void operator()(const f32x4 (&acc)[2][2][4][2], const Unit& u, int wr, int wc, int fr, int fq) const {
        store_tile_bf16<0>(acc, O + u.pn * 256 + wc * 32 + 8 * fq, ld, u.pm * BM + wr * 64 + fr); }
};
__device__ __forceinline__ float blo(unsigned w) { return __uint_as_float(w << 16); }
__device__ __forceinline__ float bhi(unsigned w) { return __uint_as_float(w & 0xffff0000u); }
struct EpiGateAF {
    static constexpr bool PERM = true, AFTER_DRAIN = false;
    bf16_t* GA; bool dry;
    __device__ __forceinline__ void operator()(const f32x4 (&acc)[2][2][4][2], const Unit& u, int wr, int wc, int fr, int fq) const {
        bf16_t* base = GA + u.pn * 256 + wc * 32 + 8 * fq; const int row0 = u.pm * BM + wr * 64 + fr;
#pragma unroll
        for (int ai = 0; ai < 2; ++ai)
#pragma unroll
            for (int m = 0; m < 4; ++m) { bf16_t* rowp = base + (size_t)(row0 + ai * HALF + m * 16) * 2048;
#pragma unroll
                for (int bj = 0; bj < 2; ++bj) { const u32x4 g = *(const u32x4*)(rowp + bj * HALF); const f32x4 v0 = acc[ai][bj][m][0], v1 = acc[ai][bj][m][1];
                    const f32x4 o0 = {blo(g.x) * v0[0], bhi(g.x) * v0[1], blo(g.y) * v0[2], bhi(g.y) * v0[3]}, o1 = {blo(g.z) * v1[0], bhi(g.z) * v1[1], blo(g.w) * v1[2], bhi(g.w) * v1[3]};
                    if (!dry) *(u32x4*)(rowp + bj * HALF) = pack8(o0, o1); } }
    }
};
struct EpiGateBF {
    static constexpr bool PERM = true, AFTER_DRAIN = false;
    bf16_t* TMP; const bf16_t* GB; bool dry;
    __device__ __forceinline__ void operator()(const f32x4 (&acc)[2][2][4][2], const Unit& u, int wr, int wc, int fr, int fq) const {
        const int coff = u.pn * 256 + wc * 32 + 8 * fq, row0 = u.pm * BM + wr * 64 + fr;
#pragma unroll
        for (int ai = 0; ai < 2; ++ai)
#pragma unroll
            for (int m = 0; m < 4; ++m) { const size_t ro = (size_t)(row0 + ai * HALF + m * 16) * 2048 + coff;
#pragma unroll
                for (int bj = 0; bj < 2; ++bj) { const u32x4 g = *(const u32x4*)(GB + ro + bj * HALF), t = *(const u32x4*)(TMP + ro + bj * HALF); const f32x4 v0 = acc[ai][bj][m][0], v1 = acc[ai][bj][m][1];
                    const f32x4 o0 = {blo(t.x) + blo(g.x) * v0[0], bhi(t.x) + bhi(g.x) * v0[1], blo(t.y) + blo(g.y) * v0[2], bhi(t.y) + bhi(g.y) * v0[3]};
                    const f32x4 o1 = {blo(t.z) + blo(g.z) * v1[0], bhi(t.z) + bhi(g.z) * v1[1], blo(t.w) + blo(g.w) * v1[2], bhi(t.w) + bhi(g.w) * v1[3]};
                    if (!dry) *(u32x4*)(TMP + ro + bj * HALF) = pack8(o0, o1); } }
    }
};
struct EpiResF {
    static constexpr bool PERM = true, AFTER_DRAIN = false;
    const float* X; float* H; bf16_t* HB; float* HST;
    __device__ __forceinline__ void operator()(const f32x4 (&acc)[2][2][4][2], const Unit& u, int wr, int wc, int fr, int fq) const {
        const int coff = u.pn * 256 + wc * 32 + 8 * fq, row0 = u.pm * BM + wr * 64 + fr;
#pragma unroll
        for (int ai = 0; ai < 2; ++ai)
#pragma unroll
            for (int m = 0; m < 4; ++m) { const int row = row0 + ai * HALF + m * 16; const size_t ro = (size_t)row * 2048 + coff; float q = 0.f;
#pragma unroll
                for (int bj = 0; bj < 2; ++bj) { const f32x4 x0 = *(const f32x4*)(X + ro + bj * HALF), x1 = *(const f32x4*)(X + ro + bj * HALF + 4);
                    const f32x4 h0 = x0 + acc[ai][bj][m][0], h1 = x1 + acc[ai][bj][m][1];
                    *(f32x4*)(H + ro + bj * HALF) = h0; *(f32x4*)(H + ro + bj * HALF + 4) = h1; *(u32x4*)(HB + ro + bj * HALF) = pack8(h0, h1);
                    q += (h0[0] * h0[0] + h0[1] * h0[1]) + (h0[2] * h0[2] + h0[3] * h0[3]) + (h1[0] * h1[0] + h1[1] * h1[1]) + (h1[2] * h1[2] + h1[3] * h1[3]); }
                q += __shfl_xor(q, 16); q += __shfl_xor(q, 32);
                if (fq == 0) HST[(size_t)row * 32 + u.pn * 4 + wc] = q; }
    }
};
struct EpiSwigluF {
    static constexpr bool PERM = true, AFTER_DRAIN = false;
    const float* HST; bf16_t* FFo;
    __device__ __forceinline__ void operator()(const f32x4 (&acc)[2][2][4][2], const Unit& u, int wr, int wc, int fr, int fq) const {
        const int coff = u.pn * 128 + wc * 32 + 8 * fq, row0 = u.pm * BM + wr * 64 + fr;
#pragma unroll
        for (int ai = 0; ai < 2; ++ai)
#pragma unroll
            for (int m = 0; m < 4; ++m) { const int row = row0 + ai * HALF + m * 16; const f32x4* hp = (const f32x4*)(HST + (size_t)row * 32);
                f32x4 sv = hp[0];
#pragma unroll
                for (int j = 1; j < 8; ++j) sv = sv + hp[j];
                const float rs = rsqrtf(((sv[0] + sv[1]) + (sv[2] + sv[3])) * (1.f / 2048.f) + 1e-6f);
                f32x4 o0, o1;
#pragma unroll
                for (int e = 0; e < 4; ++e) { const float g0 = acc[ai][0][m][0][e] * rs, u0 = acc[ai][1][m][0][e] * rs, g1 = acc[ai][0][m][1][e] * rs, u1 = acc[ai][1][m][1][e] * rs;
                    o0[e] = g0 * sigm1(g0) * u0; o1[e] = g1 * sigm1(g1) * u1; }
                *(u32x4*)(FFo + (size_t)row * 5632 + coff) = pack8(o0, o1); }
    }
};
struct EpiRes2F {
    static constexpr bool PERM = true, AFTER_DRAIN = false;
    float* H; bool dry;
    __device__ __forceinline__ void operator()(const f32x4 (&acc)[2][2][4][2], const Unit& u, int wr, int wc, int fr, int fq) const {
        const int coff = u.pn * 256 + wc * 32 + 8 * fq, row0 = u.pm * BM + wr * 64 + fr;
#pragma unroll
        for (int ai = 0; ai < 2; ++ai)
#pragma unroll
            for (int m = 0; m < 4; ++m) { float* rp = H + (size_t)(row0 + ai * HALF + m * 16) * 2048 + coff;
#pragma unroll
                for (int bj = 0; bj < 2; ++bj) { const f32x4 h0 = *(const f32x4*)(rp + bj * HALF) + acc[ai][bj][m][0], h1 = *(const f32x4*)(rp + bj * HALF + 4) + acc[ai][bj][m][1];
                    if (!dry) { *(f32x4*)(rp + bj * HALF) = h0; *(f32x4*)(rp + bj * HALF + 4) = h1; } } }
    }
};

template <class Epi, class Sched, bool ALIGN_EPI = true, bool SP2 = true>
__device__ __forceinline__ void gemm_phase(PG8_LAS unsigned char* lds, const Gemm g, const Sched& S, const Epi& E) {
    const int tid = threadIdx.x, wid = __builtin_amdgcn_readfirstlane(tid >> 6), lane = tid & 63, wr = wid >> 2, wc = wid & 3, fr = lane & 15, fq = lane >> 4;
    const int K = g.K, nt = K / BK;
    unsigned voffA[2], voffB[2];
#pragma unroll
    for (int i = 0; i < 2; ++i) { int R, C; stage_rc(tid * 16 + i * 8192, R, C); const int Rb = Epi::PERM ? ((R & ~31) + perm32(R & 31)) : R;
        voffA[i] = (unsigned)(R * g.lda + C) * 2u; voffB[i] = (unsigned)(Rb * g.ldb + C) * 2u; }
    const size_t kstep = (size_t)(BK * 2);
    const size_t hsA = (size_t)HALF * g.lda * 2, hsB = (size_t)HALF * g.ldb * 2;
    const unsigned ldsw = (unsigned)wid * 1024u;
    const int aoff = lds_byte(wr * 64 + fr, fq * 8), boff = lds_byte(wc * 32 + fr, fq * 8);
#define PG8_SA(b, h) (((b) * 2 + (h)) * HTB)
#define PG8_SB(b, h) ((4 + (b) * 2 + (h)) * HTB)
#define PG8_STAGE(bufoff, gbase, voff) do { _Pragma("unroll") for (int _i = 0; _i < 2; ++_i) \
        __builtin_amdgcn_global_load_lds((const unsigned*)((const char*)(gbase) + (voff)[_i]), (PG8_LAS unsigned*)(lds + (bufoff) + ldsw + _i * 8192), 16, 0, 0); } while (0)
#define PG8_LDA(dst, b, h) do { _Pragma("unroll") for (int m = 0; m < 4; ++m) _Pragma("unroll") for (int k = 0; k < 2; ++k) dst[m][k] = *(const PG8_LAS bf16x8*)(lds + PG8_SA(b, h) + aoff + m * 2048 + k * 1024); } while (0)
#define PG8_LDB(dst, b, h) do { _Pragma("unroll") for (int n = 0; n < 2; ++n) _Pragma("unroll") for (int k = 0; k < 2; ++k) dst[n][k] = *(const PG8_LAS bf16x8*)(lds + PG8_SB(b, h) + boff + n * 2048 + k * 1024); } while (0)
#define PG8_MMA(ai, bj, At, Bt) do { __builtin_amdgcn_s_setprio(1); _Pragma("unroll") for (int m = 0; m < 4; ++m) _Pragma("unroll") for (int n = 0; n < 2; ++n) _Pragma("unroll") for (int k = 0; k < 2; ++k) \
        acc[ai][bj][m][n] = __builtin_amdgcn_mfma_f32_16x16x32_bf16(Bt[n][k], At[m][k], acc[ai][bj][m][n], 0, 0, 0); __builtin_amdgcn_s_setprio(0); } while (0)
#define PG8_WAIT_V(n) asm volatile("s_waitcnt vmcnt(" #n ")" ::: "memory")
#define PG8_WAIT_L(n) asm volatile("s_waitcnt lgkmcnt(" #n ")" ::: "memory")
#define PG8_BAR __builtin_amdgcn_s_barrier()
#define PG8_SCHED __builtin_amdgcn_sched_barrier(0)
    Unit cur, nxt; int ui = 0;
    if (!S.next(0, cur)) return;
    f32x4 acc[2][2][4][2];
#pragma unroll
    for (int a = 0; a < 2; ++a)
#pragma unroll
        for (int b = 0; b < 2; ++b)
#pragma unroll
            for (int m = 0; m < 4; ++m)
#pragma unroll
                for (int n = 0; n < 2; ++n) acc[a][b][m][n] = (f32x4){0.f, 0.f, 0.f, 0.f};
    bf16x8 At[4][2], B0[2][2], B1[2][2];
    const char* cA; const char* cB; S.ptrs(cur, g, cA, cB);
    S.a_ready(cur);
    if constexpr (SP2) {
        PG8_STAGE(PG8_SB(0, 0), cB, voffB); PG8_STAGE(PG8_SB(0, 1), cB + hsB, voffB); PG8_STAGE(PG8_SA(0, 0), cA, voffA); PG8_STAGE(PG8_SA(0, 1), cA + hsA, voffA);
        if (wr == 1) PG8_BAR;
        PG8_WAIT_V(2); PG8_BAR;
        PG8_STAGE(PG8_SB(1, 0), cB + kstep, voffB); PG8_STAGE(PG8_SA(1, 0), cA + kstep, voffA); PG8_STAGE(PG8_SB(1, 1), cB + hsB + kstep, voffB);
        PG8_WAIT_V(6); PG8_BAR;
    } else {
        PG8_STAGE(PG8_SB(0, 0), cB, voffB); PG8_STAGE(PG8_SA(0, 0), cA, voffA); PG8_STAGE(PG8_SB(0, 1), cB + hsB, voffB); PG8_STAGE(PG8_SA(0, 1), cA + hsA, voffA);
        if (wr == 1) PG8_BAR;
        PG8_WAIT_V(4); PG8_BAR;
        PG8_STAGE(PG8_SB(1, 0), cB + kstep, voffB); PG8_STAGE(PG8_SA(1, 0), cA + kstep, voffA); PG8_STAGE(PG8_SB(1, 1), cB + hsB + kstep, voffB);
        PG8_WAIT_V(6); PG8_BAR;
    }
    for (;;) {
        const bool has_next = S.next(ui + 1, nxt);
        const char* nA = cA; const char* nB = cB; if (has_next) S.ptrs(nxt, g, nA, nB);
        for (int t = 0; t < nt; t += 2) {
            const bool last = (t == nt - 2);
            const char* a1 = cA + (size_t)(t + 1) * kstep;
            const char* a2 = last ? nA : cA + (size_t)(t + 2) * kstep; const char* b2 = last ? nB : cB + (size_t)(t + 2) * kstep;
            const char* a3 = a2 + kstep; const char* b3 = b2 + kstep;
            if (last && has_next) S.a_ready(nxt);
            if constexpr (SP2) {
            PG8_LDB(B0, 0, 0); PG8_LDB(B1, 0, 1); PG8_SCHED; PG8_LDA(At, 0, 0); PG8_STAGE(PG8_SA(1, 1), a1 + hsA, voffA);
            PG8_WAIT_V(8); PG8_WAIT_L(0); PG8_BAR; PG8_MMA(0, 0, At, B0); PG8_MMA(0, 1, At, B1); PG8_BAR; PG8_SCHED;
            PG8_LDA(At, 0, 1); PG8_STAGE(PG8_SB(0, 0), b2, voffB); PG8_STAGE(PG8_SB(0, 1), b2 + hsB, voffB); PG8_STAGE(PG8_SA(0, 0), a2, voffA);
            PG8_WAIT_V(8); PG8_WAIT_L(0); PG8_BAR; PG8_MMA(1, 0, At, B0); PG8_MMA(1, 1, At, B1); PG8_BAR; PG8_SCHED;
            PG8_LDB(B0, 1, 0); PG8_LDB(B1, 1, 1); PG8_SCHED; PG8_LDA(At, 1, 0); PG8_STAGE(PG8_SA(0, 1), a2 + hsA, voffA);
            PG8_WAIT_V(8); PG8_WAIT_L(0); PG8_BAR; PG8_MMA(0, 0, At, B0); PG8_MMA(0, 1, At, B1); PG8_BAR; PG8_SCHED;
            PG8_LDA(At, 1, 1); PG8_STAGE(PG8_SB(1, 0), b3, voffB); PG8_STAGE(PG8_SB(1, 1), b3 + hsB, voffB); PG8_STAGE(PG8_SA(1, 0), a3, voffA);
            PG8_WAIT_V(8); PG8_WAIT_L(0); PG8_BAR; PG8_MMA(1, 0, At, B0); PG8_MMA(1, 1, At, B1); PG8_BAR; PG8_SCHED;
            } else {
            PG8_LDB(B0, 0, 0); PG8_SCHED; PG8_LDA(At, 0, 0); PG8_STAGE(PG8_SA(1, 1), a1 + hsA, voffA);
            PG8_WAIT_L(8); PG8_BAR; PG8_WAIT_L(0); PG8_MMA(0, 0, At, B0); PG8_BAR; PG8_SCHED;
            PG8_LDB(B1, 0, 1); PG8_STAGE(PG8_SB(0, 0), b2, voffB);
            PG8_BAR; PG8_WAIT_L(0); PG8_MMA(0, 1, At, B1); PG8_BAR;
            PG8_LDA(At, 0, 1); PG8_STAGE(PG8_SA(0, 0), a2, voffA);
            PG8_BAR; PG8_WAIT_L(0); PG8_MMA(1, 0, At, B0); PG8_BAR; PG8_SCHED;
            PG8_STAGE(PG8_SB(0, 1), b2 + hsB, voffB);
            PG8_WAIT_V(6); PG8_BAR; PG8_MMA(1, 1, At, B1); PG8_BAR;
            PG8_LDB(B0, 1, 0); PG8_SCHED; PG8_LDA(At, 1, 0); PG8_STAGE(PG8_SA(0, 1), a2 + hsA, voffA);
            PG8_WAIT_L(8); PG8_BAR; PG8_WAIT_L(0); PG8_MMA(0, 0, At, B0); PG8_BAR; PG8_SCHED;
            PG8_LDB(B1, 1, 1); PG8_STAGE(PG8_SB(1, 0), b3, voffB);
            PG8_BAR; PG8_WAIT_L(0); PG8_MMA(0, 1, At, B1); PG8_BAR;
            PG8_LDA(At, 1, 1); PG8_STAGE(PG8_SA(1, 0), a3, voffA);
            PG8_BAR; PG8_WAIT_L(0); PG8_MMA(1, 0, At, B0); PG8_BAR; PG8_SCHED;
            PG8_STAGE(PG8_SB(1, 1), b3 + hsB, voffB);
            PG8_WAIT_V(6); PG8_BAR; PG8_MMA(1, 1, At, B1); PG8_BAR;
            }
        }
        if constexpr (ALIGN_EPI) { if (wr == 0) PG8_BAR; }
        if constexpr (!Epi::AFTER_DRAIN) { E(acc, cur, wr, wc, fr, fq); S.done(cur); }
        if (!has_next) break;
#pragma unroll
        for (int a = 0; a < 2; ++a)
#pragma unroll
            for (int b = 0; b < 2; ++b)
#pragma unroll
                for (int m = 0; m < 4; ++m)
#pragma unroll
                    for (int n = 0; n < 2; ++n) acc[a][b][m][n] = (f32x4){0.f, 0.f, 0.f, 0.f};
        cur = nxt; cA = nA; cB = nB; ++ui;
        if constexpr (ALIGN_EPI) { if (wr == 1) PG8_BAR; }
    }
    PG8_WAIT_V(0);
    if constexpr (!ALIGN_EPI) { if (wr == 0) PG8_BAR; }
    PG8_BAR;
    if constexpr (Epi::AFTER_DRAIN) { E.fused(acc, cur, wr, wc, fr, fq, lds, wid, lane); S.done(cur); }
#undef PG8_SA
#undef PG8_SB
#undef PG8_STAGE
#undef PG8_LDA
#undef PG8_LDB
#undef PG8_MMA
#undef PG8_WAIT_V
#undef PG8_WAIT_L
#undef PG8_BAR
#undef PG8_SCHED
}
}

__device__ __forceinline__ void rows_xn(const float* x, const float* g, bf16* XN, int gw, int ngw, int lane) {
    for (int m = gw; m < M; m += ngw) {
        const f32x4* xr = (const f32x4*)(x + (size_t)m * D) + lane;
        f32x4 v[8]; float s = 0.f;
#pragma unroll
        for (int j = 0; j < 8; ++j) { v[j] = xr[64 * j]; s += v[j].x * v[j].x + v[j].y * v[j].y + v[j].z * v[j].z + v[j].w * v[j].w; }
        const float rs = rsqrtf(wave_sum(s) * (1.f / D) + EPS);
        u32x2* o = (u32x2*)(XN + (size_t)m * D) + lane;
#pragma unroll
        for (int j = 0; j < 8; ++j) {
            const f32x4 gg = ((const f32x4*)g)[lane + 64 * j];
            u32x2 w; w.x = (unsigned)f2bf(v[j].x * rs * gg.x) | ((unsigned)f2bf(v[j].y * rs * gg.y) << 16);
            w.y = (unsigned)f2bf(v[j].z * rs * gg.z) | ((unsigned)f2bf(v[j].w * rs * gg.w) << 16);
            o[64 * j] = w;
        }
    }
}
__device__ __forceinline__ void rows_cn(const float* CKR, const float* g, bf16* CN, int gw, int ngw, int lane) {
    for (int m = gw; m < M; m += ngw) {
        const f32x4* xr = (const f32x4*)(CKR + (size_t)m * CL) + lane;
        f32x4 v[2]; float s = 0.f;
#pragma unroll
        for (int j = 0; j < 2; ++j) { v[j] = xr[64 * j]; s += v[j].x * v[j].x + v[j].y * v[j].y + v[j].z * v[j].z + v[j].w * v[j].w; }
        const float rs = rsqrtf(wave_sum(s) * (1.f / CL) + EPS);
        u32x2* o = (u32x2*)(CN + (size_t)m * CL) + lane;
#pragma unroll
        for (int j = 0; j < 2; ++j) {
            const f32x4 gg = ((const f32x4*)g)[lane + 64 * j];
            u32x2 w; w.x = (unsigned)f2bf(v[j].x * rs * gg.x) | ((unsigned)f2bf(v[j].y * rs * gg.y) << 16);
            w.y = (unsigned)f2bf(v[j].z * rs * gg.z) | ((unsigned)f2bf(v[j].w * rs * gg.w) << 16);
            o[64 * j] = w;
        }
    }
}
__device__ __forceinline__ void rows_final(float* H, const float* g, int gw, int ngw, int lane, bool dry = false) {
    for (int m = gw; m < M; m += ngw) {
        f32x4* xr = (f32x4*)(H + (size_t)m * D) + lane;
        f32x4 v[8]; float s = 0.f;
#pragma unroll
        for (int j = 0; j < 8; ++j) { v[j] = xr[64 * j]; s += v[j].x * v[j].x + v[j].y * v[j].y + v[j].z * v[j].z + v[j].w * v[j].w; }
        const float rs = rsqrtf(wave_sum(s) * (1.f / D) + EPS);
#pragma unroll
        for (int j = 0; j < 8; ++j) { const f32x4 gg = ((const f32x4*)g)[lane + 64 * j]; if (!dry) xr[64 * j] = v[j] * rs * gg; }
    }
}

__device__ __forceinline__ void naive_gating(float* lds, bf16* U, const bf16* V, const float* VST, const float* ln_g, const float* ln_b,
                                             const float* w_s, const float* b_s, int vb, int nb) {
    float* Wt = lds; float* vn = lds + 128 * 128; float* mr = vn + 128 * 64;
    const int tid = threadIdx.x;
    for (int unit = vb; unit < 2 * 32 * 8 * 4; unit += nb) {
        const int cq = unit & 3, g = (unit >> 2) & 7, n = (unit >> 5) & 31, b = unit >> 10;
        const int row0 = b * SEQ + n * 128, ch0 = g * 256 + cq * 64;
        __syncthreads();
        if (tid < 128) {
            float s = 0.f, q = 0.f;
            for (int j = 0; j < 32; ++j) { s += VST[((size_t)(row0 + tid) * 32 + j) * 2]; q += VST[((size_t)(row0 + tid) * 32 + j) * 2 + 1]; }
            const float mean = s * (1.f / D); const float var = q * (1.f / D) - mean * mean;
            mr[tid * 2] = mean; mr[tid * 2 + 1] = rsqrtf(fmaxf(var, 0.f) + EPS);
        }
        for (int i = tid; i < 128 * 128; i += NTHREADS) { const int p = i >> 7, q = i & 127; Wt[q * 128 + p] = ((q >> 6) <= (p >> 6)) ? w_s[(size_t)g * 16384 + p * 128 + q] : 0.f; }
        __syncthreads();
        for (int i = tid; i < 128 * 64; i += NTHREADS) { const int q = i >> 6, c = i & 63;
            vn[i] = (bf2f(V[(size_t)(row0 + q) * D + ch0 + c]) - mr[q * 2]) * mr[q * 2 + 1] * ln_g[ch0 + c] + ln_b[ch0 + c]; }
        __syncthreads();
        const int c = tid & 63, pg = tid >> 6;
        float acc[16];
#pragma unroll
        for (int i = 0; i < 16; ++i) acc[i] = 0.f;
        for (int q = 0; q < 128; ++q) {
            const float x = vn[q * 64 + c];
#pragma unroll
            for (int i4 = 0; i4 < 4; ++i4) { const f32x4 w = *(const f32x4*)(Wt + q * 128 + pg * 16 + i4 * 4);
                acc[i4 * 4 + 0] += w.x * x; acc[i4 * 4 + 1] += w.y * x; acc[i4 * 4 + 2] += w.z * x; acc[i4 * 4 + 3] += w.w * x; }
        }
#pragma unroll
        for (int i = 0; i < 16; ++i) { const int p = pg * 16 + i; const size_t idx = (size_t)(row0 + p) * D + ch0 + c;
            U[idx] = f2bf(bf2f(U[idx]) * (acc[i] + b_s[g * 128 + p])); }
    }
}

__device__ __forceinline__ void naive_scores(float* lds, const bf16* QI, const bf16* KI, const float* WI, float* SC, int vb, int nb) {
    float* qs = lds;
    float* ws = lds + 1024;
    const int tid = threadIdx.x;
    for (int t = vb; t < M; t += nb) {
        const int b = t / SEQ, pos = t % SEQ, nadm = ((pos >> 6) + 1) * 64;
        __syncthreads();
        for (int i = tid; i < 1024; i += NTHREADS) qs[i] = bf2f(QI[(size_t)t * 1024 + i]);
        if (tid < 16) ws[tid] = WI[(size_t)t * 16 + tid] * 0.25f;
        __syncthreads();
        float* out = SC + sc_off(b, pos);
        for (int s = tid; s < nadm; s += NTHREADS) {
            float k[64];
            const u32x4* kp = (const u32x4*)(KI + (size_t)(b * SEQ + s) * 64);
#pragma unroll
            for (int i = 0; i < 8; ++i) { const u32x4 w = kp[i]; const unsigned ww[4] = {w.x, w.y, w.z, w.w};
#pragma unroll
                for (int e = 0; e < 4; ++e) { k[i * 8 + e * 2] = __uint_as_float(ww[e] << 16); k[i * 8 + e * 2 + 1] = __uint_as_float(ww[e] & 0xffff0000u); } }
            float sc = 0.f;
            for (int h = 0; h < 16; ++h) {
                float l = 0.f;
#pragma unroll
                for (int d = 0; d < 64; ++d) l += qs[h * 64 + d] * k[d];
                sc += ws[h] * fmaxf(l * 0.125f, 0.f);
            }
            out[s] = sc;
        }
    }
}

__device__ __forceinline__ unsigned fkey(float f) { const unsigned u = __float_as_uint(f + 0.0f); return (u & 0x80000000u) ? ~u : (u | 0x80000000u); }
__device__ __forceinline__ void topk_rows(const float* SC, int* SEL, int gw, int ngw, int lane, bool dry = false) {
    for (int t = gw; t < M; t += ngw) {
        const int b = t / SEQ, pos = t % SEQ, nadm = ((pos >> 6) + 1) * 64;
        int* sel = SEL + (size_t)t * TOPK;
        if (nadm <= TOPK) { for (int i = lane; i < nadm; i += 64) sel[i] = i; continue; }
        const float* sc = SC + sc_off(b, pos);
        const int nj = nadm >> 6;
        unsigned key[64];
#pragma unroll
        for (int j = 0; j < 64; ++j) key[j] = (j < nj) ? fkey(sc[j * 64 + lane]) : 0u;
        unsigned prefix = 0u;
        for (int bit = 31; bit >= 0; --bit) {
            const unsigned cand = prefix | (1u << bit);
            int cnt = 0;
#pragma unroll
            for (int j4 = 0; j4 < 16; ++j4) {
                if (j4 * 4 < nj) {
#pragma unroll
                    for (int jj = 0; jj < 4; ++jj) cnt += __builtin_popcountll(__ballot(key[j4 * 4 + jj] >= cand));
                }
            }
            if (cnt >= TOPK) prefix = cand;
        }
        int cgt = 0;
#pragma unroll
        for (int j4 = 0; j4 < 16; ++j4) {
            if (j4 * 4 < nj) {
#pragma unroll
                for (int jj = 0; jj < 4; ++jj) cgt += __builtin_popcountll(__ballot(key[j4 * 4 + jj] > prefix));
            }
        }
        int need = TOPK - cgt, obase = 0;
        const unsigned long long lt = (1ull << lane) - 1ull;
#pragma unroll
        for (int j = 0; j < 64; ++j) {
            if (j < nj) {
                const bool gt = key[j] > prefix, eq = key[j] == prefix;
                const unsigned long long me = __ballot(eq);
                const int erank = __builtin_popcountll(me & lt);
                const bool take = gt || (eq && erank < need);
                const unsigned long long ms = __ballot(take);
                if (take && !dry) sel[obase + __builtin_popcountll(ms & lt)] = j * 64 + lane;
                obase += __builtin_popcountll(ms);
                const int ne = __builtin_popcountll(me); need -= (ne < need ? ne : need);
            }
        }
    }
}

__device__ __forceinline__ void naive_attn(float* lds, bf16* QL, const bf16* CN, const int* SEL, int vb, int nb) {
    float* qs = lds;
    float* att = lds + 16 * 512;
    int* sl = (int*)(att + 16 * 256);
    const int tid = threadIdx.x, lane = tid & 63, wid = tid >> 6;
    for (int t = vb; t < M; t += nb) {
        const int b = t / SEQ, pos = t % SEQ, nadm = ((pos >> 6) + 1) * 64, nsel = nadm < TOPK ? nadm : TOPK;
        __syncthreads();
        for (int i = tid; i < 16 * 512; i += NTHREADS) qs[i] = bf2f(QL[(size_t)t * 8192 + i]);
        if (tid < 256) sl[tid] = (tid < nsel) ? SEL[(size_t)t * TOPK + tid] : 0;
        __syncthreads();
        {
            const int k = tid & 255, hh = tid >> 8;
            float a[8];
#pragma unroll
            for (int i = 0; i < 8; ++i) a[i] = 0.f;
            if (k < nsel) {
                const u32x4* cp = (const u32x4*)(CN + (size_t)(b * SEQ + sl[k]) * CL);
                for (int c8 = 0; c8 < 64; ++c8) {
                    const u32x4 w = cp[c8]; float cv[8];
                    cv[0] = __uint_as_float(w.x << 16); cv[1] = __uint_as_float(w.x & 0xffff0000u); cv[2] = __uint_as_float(w.y << 16); cv[3] = __uint_as_float(w.y & 0xffff0000u);
                    cv[4] = __uint_as_float(w.z << 16); cv[5] = __uint_as_float(w.z & 0xffff0000u); cv[6] = __uint_as_float(w.w << 16); cv[7] = __uint_as_float(w.w & 0xffff0000u);
#pragma unroll
                    for (int i = 0; i < 8; ++i) { const float* qh = qs + (hh * 8 + i) * 512 + c8 * 8;
                        const f32x4 q0 = *(const f32x4*)qh, q1 = *(const f32x4*)(qh + 4);
                        a[i] += q0.x * cv[0] + q0.y * cv[1] + q0.z * cv[2] + q0.w * cv[3] + q1.x * cv[4] + q1.y * cv[5] + q1.z * cv[6] + q1.w * cv[7]; }
                }
            }
#pragma unroll
            for (int i = 0; i < 8; ++i) att[(hh * 8 + i) * 256 + k] = (k < nsel) ? a[i] * 0.08838834764831845f : -INFINITY;
        }
        __syncthreads();
        {
#pragma unroll
            for (int hi = 0; hi < 2; ++hi) { float* row = att + (wid * 2 + hi) * 256;
                float v[4]; float mx = -INFINITY;
#pragma unroll
                for (int i = 0; i < 4; ++i) { v[i] = row[lane + 64 * i]; mx = fmaxf(mx, v[i]); }
                mx = wave_max(mx); float s = 0.f;
#pragma unroll
                for (int i = 0; i < 4; ++i) { v[i] = __expf(v[i] - mx); s += v[i]; }
                s = wave_sum(s); const float inv = 1.f / s;
#pragma unroll
                for (int i = 0; i < 4; ++i) row[lane + 64 * i] = v[i] * inv; }
        }
        __syncthreads();
        {
            float o[16];
#pragma unroll
            for (int i = 0; i < 16; ++i) o[i] = 0.f;
            for (int k = 0; k < nsel; ++k) {
                const float cv = bf2f(CN[(size_t)(b * SEQ + sl[k]) * CL + tid]);
#pragma unroll
                for (int h = 0; h < 16; ++h) o[h] += att[h * 256 + k] * cv;
            }
#pragma unroll
            for (int h = 0; h < 16; ++h) QL[(size_t)t * 8192 + h * 512 + tid] = f2bf(o[h]);
        }
    }
}


typedef short bf16x8v __attribute__((ext_vector_type(8)));
typedef float f32x16 __attribute__((ext_vector_type(16)));
typedef short v4i16_t __attribute__((ext_vector_type(4)));
__device__ __forceinline__ void fast_scores(const bf16* QI, const bf16* KI, const float* WI, float* SC, int vb, int nb, int wave, int lane) {
    const int r = lane & 31, hi = lane >> 5;
    const int arow_tok = (r >> 2) & 1, arow_head = (r & 3) + 4 * (r >> 3);
    constexpr int NUNITS = 1152;
    for (int u = vb; u < NUNITS; u += nb) {
        int c = 63, rem = u >> 1; const int b = u & 1;
        for (;;) { const int n = 2 * ((c + 8) >> 3); if (rem < n) break; rem -= n; --c; }
        const int hf = rem & 1, sg = rem >> 1;
        const int pos0 = c * 64 + hf * 32 + wave * 4, t0 = b * SEQ + pos0;
        const int k_lo = sg * 512, k_hi = (k_lo + 512 < (c + 1) * 64) ? k_lo + 512 : (c + 1) * 64;
        bf16x8v af[2][4]; float wsc[2][16]; float* outp[2];
#pragma unroll
        for (int p = 0; p < 2; ++p) {
#pragma unroll
            for (int ks = 0; ks < 4; ++ks) af[p][ks] = *(const bf16x8v*)(QI + (size_t)(t0 + 2 * p + arow_tok) * 1024 + arow_head * 64 + ks * 16 + 8 * hi);
            const f32x4* wp = (const f32x4*)(WI + (size_t)(t0 + 2 * p + hi) * 16);
#pragma unroll
            for (int j = 0; j < 4; ++j) { const f32x4 w = wp[j]; wsc[p][4 * j] = w[0] * 0.03125f; wsc[p][4 * j + 1] = w[1] * 0.03125f; wsc[p][4 * j + 2] = w[2] * 0.03125f; wsc[p][4 * j + 3] = w[3] * 0.03125f; }
            outp[p] = SC + sc_off(b, pos0 + 2 * p + hi) + r;
        }
        const bf16* kbase = KI + (size_t)(b * SEQ + r) * 64 + 8 * hi;
        bf16x8v bfr[4], bnx[4];
#pragma unroll
        for (int ks = 0; ks < 4; ++ks) bfr[ks] = *(const bf16x8v*)(kbase + (size_t)k_lo * 64 + ks * 16);
        for (int k0 = k_lo; k0 < k_hi; k0 += 32) {
            const int kn = (k0 + 32 < k_hi) ? k0 + 32 : k0;
#pragma unroll
            for (int ks = 0; ks < 4; ++ks) bnx[ks] = *(const bf16x8v*)(kbase + (size_t)kn * 64 + ks * 16);
#pragma unroll
            for (int p = 0; p < 2; ++p) {
                f32x16 acc = {0.f, 0.f, 0.f, 0.f, 0.f, 0.f, 0.f, 0.f, 0.f, 0.f, 0.f, 0.f, 0.f, 0.f, 0.f, 0.f};
#pragma unroll
                for (int ks = 0; ks < 4; ++ks) acc = __builtin_amdgcn_mfma_f32_32x32x16_bf16(af[p][ks], bfr[ks], acc, 0, 0, 0);
                float s = 0.f;
#pragma unroll
                for (int h = 0; h < 16; ++h) s += fmaxf(acc[h], 0.f) * wsc[p][h];
                outp[p][k0] = s;
            }
#pragma unroll
            for (int ks = 0; ks < 4; ++ks) bfr[ks] = bnx[ks];
        }
    }
}

constexpr int AT_ROWB = 1040;
constexpr int AT_CB = 64 * AT_ROWB;
constexpr int AT_SP = 2 * AT_CB;
constexpr int AT_PB = AT_SP + 2 * 16 * 68 * 4;
constexpr int AT_AL = AT_PB + 16 * 72 * 2;
constexpr int AT_END = AT_AL + 128;
__device__ __forceinline__ int at_nsel(int t) { const int nadm = (((t & (SEQ - 1)) >> 6) + 1) * 64; return nadm < TOPK ? nadm : TOPK; }
__device__ __forceinline__ void at_gather(LAS unsigned char* buf, const bf16* CN, const int* SEL, int t, int ch, int wave, int lane) {
    const int nsel = at_nsel(t), bbase = (t >> 12) * SEQ;
    int idx = 0; { const int i = ch * 64 + wave * 8 + (lane & 7); if (i < nsel) idx = SEL[(size_t)t * TOPK + i]; }
#pragma unroll
    for (int i = 0; i < 8; ++i) { const int row = __builtin_amdgcn_readlane(idx, i);
        __builtin_amdgcn_global_load_lds((const unsigned*)(CN + (size_t)(bbase + row) * CL + lane * 8), (LAS unsigned*)(buf + (wave * 8 + i) * AT_ROWB), 16, 0, 0); }
}
__device__ __forceinline__ void fast_attn(LAS unsigned char* lds, bf16* QL, const bf16* CN, const int* SEL, int vb, int nb, int wave, int lane, bool dostore = true) {
    const int g = lane >> 4, l15 = lane & 15, kt = wave & 3, kh = wave >> 2;
    LAS float* Sp = (LAS float*)(lds + AT_SP); LAS bf16* Pb = (LAS bf16*)(lds + AT_PB); LAS float* AL = (LAS float*)(lds + AT_AL);
    const int tbase = ((vb & 7) >> 2) * SEQ + ((vb & 3) * 32 + (vb >> 3)); int ti = 0;
    const bool remap = (nb == 256);
    int tok = remap ? tbase : vb, ch = 0, cur = 0;
    if (tok >= M) return;
    at_gather(lds, CN, SEL, tok, 0, wave, lane);
    bf16x8v qf[8];
    float m_run[2] = {-INFINITY, -INFINITY}, l_run[2] = {0.f, 0.f};
    f32x4 oacc[4];
    while (tok < M) {
        const int nsel = at_nsel(tok), nch = (nsel + 63) >> 6;
        int ntok = tok, nc = ch + 1; if (nc >= nch) { nc = 0; if (remap) { ++ti; ntok = (ti < 32) ? tbase + ti * 128 : M; } else ntok = tok + nb; }
        LAS unsigned char* buf = lds + cur * AT_CB;
        if (ch == 0) {
#pragma unroll
            for (int ks = 0; ks < 8; ++ks) qf[ks] = *(const bf16x8v*)(QL + (size_t)tok * 8192 + l15 * 512 + kh * 256 + ks * 32 + 8 * g);
            m_run[0] = -INFINITY; m_run[1] = -INFINITY; l_run[0] = 0.f; l_run[1] = 0.f;
#pragma unroll
            for (int n = 0; n < 4; ++n) oacc[n] = (f32x4){0.f, 0.f, 0.f, 0.f};
        }
        asm volatile("s_waitcnt vmcnt(0) lgkmcnt(0)" ::: "memory"); __builtin_amdgcn_s_barrier(); asm volatile("" ::: "memory");
        if (ntok < M) at_gather(lds + (cur ^ 1) * AT_CB, CN, SEL, ntok, nc, wave, lane);
        {   f32x4 sacc = {0.f, 0.f, 0.f, 0.f};
            const LAS unsigned char* cb = buf + (kt * 16 + l15) * AT_ROWB + (kh * 256 + 8 * g) * 2;
#pragma unroll
            for (int ks = 0; ks < 8; ++ks) { const bf16x8v cf = *(const LAS bf16x8v*)(cb + ks * 64); sacc = __builtin_amdgcn_mfma_f32_16x16x32_bf16(cf, qf[ks], sacc, 0, 0, 0); }
            *(LAS f32x4*)(Sp + (kh * 16 + l15) * 68 + kt * 16 + 4 * g) = sacc;
        }
        asm volatile("s_waitcnt lgkmcnt(0)" ::: "memory"); __builtin_amdgcn_s_barrier(); asm volatile("" ::: "memory");
#pragma unroll
        for (int hh = 0; hh < 2; ++hh) { const int h = 2 * wave + hh;
            float s = (Sp[h * 68 + lane] + Sp[(16 + h) * 68 + lane]) * 0.12751743074602468f;
            if (ch * 64 + lane >= nsel) s = -INFINITY;
            const float mn = fmaxf(m_run[hh], wave_max(s));
            const float alpha = __builtin_amdgcn_exp2f(m_run[hh] - mn), p = __builtin_amdgcn_exp2f(s - mn);
            l_run[hh] = l_run[hh] * alpha + wave_sum(p); m_run[hh] = mn;
            Pb[h * 72 + lane] = f2bf(p);
            if (lane == 0) AL[h] = alpha; }
        asm volatile("s_waitcnt lgkmcnt(0)" ::: "memory"); __builtin_amdgcn_s_barrier(); asm volatile("" ::: "memory");
        {   const float al = AL[l15];
#pragma unroll
            for (int n = 0; n < 4; ++n) oacc[n] = oacc[n] * al;
            bf16x8v pf[2];
#pragma unroll
            for (int ks = 0; ks < 2; ++ks) pf[ks] = *(const LAS bf16x8v*)((const LAS unsigned char*)Pb + l15 * 144 + (32 * ks + 8 * g) * 2);
            const LAS unsigned char* tb = buf + (8 * g + (l15 >> 2)) * AT_ROWB + (64 * wave + 4 * (l15 & 3)) * 2;
#pragma unroll
            for (int n = 0; n < 4; ++n)
#pragma unroll
                for (int ks = 0; ks < 2; ++ks) {
                    const v4i16_t t0 = __builtin_amdgcn_ds_read_tr16_b64_v4i16((LAS v4i16_t*)(tb + (32 * ks) * AT_ROWB + n * 32));
                    const v4i16_t t1 = __builtin_amdgcn_ds_read_tr16_b64_v4i16((LAS v4i16_t*)(tb + (32 * ks + 4) * AT_ROWB + n * 32));
                    const bf16x8v cf = {t0[0], t0[1], t0[2], t0[3], t1[0], t1[1], t1[2], t1[3]};
                    oacc[n] = __builtin_amdgcn_mfma_f32_16x16x32_bf16(cf, pf[ks], oacc[n], 0, 0, 0);
                }
        }
        if (nc == 0) {
            if (lane == 0) { AL[16 + 2 * wave] = 1.f / l_run[0]; AL[16 + 2 * wave + 1] = 1.f / l_run[1]; }
            asm volatile("s_waitcnt lgkmcnt(0)" ::: "memory"); __builtin_amdgcn_s_barrier(); asm volatile("" ::: "memory");
            const float li = AL[16 + l15];
            bf16* op = QL + (size_t)tok * 8192 + l15 * 512 + 64 * wave + 4 * g;
#pragma unroll
            for (int n = 0; n < 4; ++n) if (dostore) { const f32x4 o = oacc[n] * li; u32x2 w; w.x = pk2(o[0], o[1]); w.y = pk2(o[2], o[3]); *(u32x2*)(op + 16 * n) = w; }
        }
        tok = ntok; ch = nc; cur ^= 1;
    }
    asm volatile("s_waitcnt vmcnt(0) lgkmcnt(0)" ::: "memory"); __builtin_amdgcn_s_barrier();
}

constexpr int GT_ROWB = 528;
__device__ __forceinline__ void fast_gating(LAS unsigned char* lds, bf16* U, const bf16* V, const float* VST, const float* ln_g, const float* ln_b,
                                            const float* w_s, const float* b_s, int vb, int nb, int wave, int lane, bool dry = false) {
    LAS float* MR = (LAS float*)(lds + 128 * GT_ROWB);
    const int tid = threadIdx.x, g = lane >> 4, l15 = lane & 15, ph = wave >> 2, cq = wave & 3;
    for (int unit = vb; unit < 512; unit += nb) {
        const int gi = unit & 7, n = (unit >> 3) & 31, b = unit >> 8;
        const int row0 = b * SEQ + n * 128, ch0 = gi * 256;
        asm volatile("s_waitcnt lgkmcnt(0)" ::: "memory"); __builtin_amdgcn_s_barrier(); asm volatile("" ::: "memory");
        if (tid < 128) {
            const f32x4* vp = (const f32x4*)(VST + (size_t)(row0 + tid) * 64); float s = 0.f, q = 0.f;
#pragma unroll
            for (int j = 0; j < 16; ++j) { const f32x4 v = vp[j]; s += v[0] + v[2]; q += v[1] + v[3]; }
            const float mean = s * (1.f / D), var = q * (1.f / D) - mean * mean;
            MR[tid * 2] = mean; MR[tid * 2 + 1] = rsqrtf(fmaxf(var, 0.f) + EPS);
        }
        bf16x8v wf[4][4];
        const int nks = ph ? 4 : 2;
#pragma unroll
        for (int pt = 0; pt < 4; ++pt)
#pragma unroll
            for (int ks = 0; ks < 4; ++ks) { if (ks < nks) { const f32x4* wp = (const f32x4*)(w_s + (size_t)gi * 16384 + (ph * 64 + pt * 16 + l15) * 128 + ks * 32 + 8 * g); const f32x4 a = wp[0], c = wp[1];
                    const unsigned w0 = pk2(a[0], a[1]), w1 = pk2(a[2], a[3]), w2 = pk2(c[0], c[1]), w3 = pk2(c[2], c[3]);
                    wf[pt][ks] = __builtin_bit_cast(bf16x8v, (u32x4){w0, w1, w2, w3}); } else wf[pt][ks] = (bf16x8v){0, 0, 0, 0, 0, 0, 0, 0}; }
        asm volatile("s_waitcnt lgkmcnt(0)" ::: "memory"); __builtin_amdgcn_s_barrier(); asm volatile("" ::: "memory");
        {
            const int c8 = tid & 31; float lg[8], lb[8];
            { const f32x4* gp = (const f32x4*)(ln_g + ch0 + c8 * 8); const f32x4* bp = (const f32x4*)(ln_b + ch0 + c8 * 8); const f32x4 g0 = gp[0], g1 = gp[1], b0 = bp[0], b1 = bp[1];
              lg[0] = g0[0]; lg[1] = g0[1]; lg[2] = g0[2]; lg[3] = g0[3]; lg[4] = g1[0]; lg[5] = g1[1]; lg[6] = g1[2]; lg[7] = g1[3];
              lb[0] = b0[0]; lb[1] = b0[1]; lb[2] = b0[2]; lb[3] = b0[3]; lb[4] = b1[0]; lb[5] = b1[1]; lb[6] = b1[2]; lb[7] = b1[3]; }
#pragma unroll
            for (int i = 0; i < 8; ++i) { const int q = (tid >> 5) + 16 * i;
                const u32x4 raw = *(const u32x4*)(V + (size_t)(row0 + q) * D + ch0 + c8 * 8); const float mean = MR[q * 2], rs = MR[q * 2 + 1];
                const unsigned ww[4] = {raw.x, raw.y, raw.z, raw.w}; u32x4 o; unsigned oo[4];
#pragma unroll
                for (int e = 0; e < 4; ++e) oo[e] = pk2((bflo(ww[e]) - mean) * rs * lg[2 * e] + lb[2 * e], (bfhi(ww[e]) - mean) * rs * lg[2 * e + 1] + lb[2 * e + 1]);
                o.x = oo[0]; o.y = oo[1]; o.z = oo[2]; o.w = oo[3];
                *(LAS u32x4*)(lds + q * GT_ROWB + c8 * 16) = o; }
        }
        asm volatile("s_waitcnt lgkmcnt(0)" ::: "memory"); __builtin_amdgcn_s_barrier(); asm volatile("" ::: "memory");
        f32x4 acc[4][4];
#pragma unroll
        for (int ct = 0; ct < 4; ++ct)
#pragma unroll
            for (int pt = 0; pt < 4; ++pt) acc[ct][pt] = (f32x4){0.f, 0.f, 0.f, 0.f};
        const LAS unsigned char* tb = lds + (8 * g + (l15 >> 2)) * GT_ROWB + (cq * 64 + 4 * (l15 & 3)) * 2;
#pragma unroll
        for (int ks = 0; ks < 4; ++ks) { if (ks < nks) {
#pragma unroll
            for (int ct = 0; ct < 4; ++ct) {
                const v4i16_t t0 = __builtin_amdgcn_ds_read_tr16_b64_v4i16((LAS v4i16_t*)(tb + (32 * ks) * GT_ROWB + ct * 32));
                const v4i16_t t1 = __builtin_amdgcn_ds_read_tr16_b64_v4i16((LAS v4i16_t*)(tb + (32 * ks + 4) * GT_ROWB + ct * 32));
                const bf16x8v cf = {t0[0], t0[1], t0[2], t0[3], t1[0], t1[1], t1[2], t1[3]};
#pragma unroll
                for (int pt = 0; pt < 4; ++pt) acc[ct][pt] = __builtin_amdgcn_mfma_f32_16x16x32_bf16(cf, wf[pt][ks], acc[ct][pt], 0, 0, 0);
            } } }
#pragma unroll
        for (int pt = 0; pt < 4; ++pt) { const int p = ph * 64 + pt * 16 + l15; const float bs = b_s[gi * 128 + p];
#pragma unroll
            for (int ct = 0; ct < 4; ++ct) { bf16* up = U + (size_t)(row0 + p) * D + ch0 + cq * 64 + ct * 16 + 4 * g; const u32x2 uu = *(const u32x2*)up; const f32x4 a = acc[ct][pt];
                u32x2 o; o.x = pk2(bflo(uu.x) * (a[0] + bs), bfhi(uu.x) * (a[1] + bs)); o.y = pk2(bflo(uu.y) * (a[2] + bs), bfhi(uu.y) * (a[3] + bs)); if (!dry) *(u32x2*)up = o; } }
    }
    asm volatile("s_waitcnt lgkmcnt(0)" ::: "memory"); __builtin_amdgcn_s_barrier(); asm volatile("" ::: "memory");
}

typedef short bf16x4v __attribute__((ext_vector_type(4)));
constexpr int A2_ROWB = 1056;
constexpr int A2_WB = 16 * A2_ROWB;
__device__ __forceinline__ void attn_wave(LAS unsigned char* lds, bf16* QL, const bf16* CN, const int* SEL, int vb, int nb, int wave, int lane, bool dry = false) {
    const int g = lane >> 4, l15 = lane & 15;
    LAS unsigned char* buf = lds + wave * A2_WB;
    int tlist0, tstep, ntok;
    if (nb == 256) { const int bsel = (vb & 7) >> 2, w = (((vb & 3) * 32 + (vb >> 3)) * 8 + wave); tlist0 = bsel * SEQ + w; tstep = 1024; ntok = 4; }
    else { tlist0 = vb * 8 + wave; tstep = nb * 8; ntok = (M - tlist0 + tstep - 1) / tstep; }
    const LAS unsigned char* cb = buf + l15 * A2_ROWB + 8 * g * 2;
    const LAS unsigned char* tb = buf + (4 * g + (l15 >> 2)) * A2_ROWB + 4 * (l15 & 3) * 2;
    for (int it = 0; it < ntok; ++it) {
        const int tok = tlist0 + it * tstep;
        const int nadm = (((tok & (SEQ - 1)) >> 6) + 1) * 64, nsel = nadm < TOPK ? nadm : TOPK, nch = nsel >> 4, bbase = (tok >> 12) * SEQ;
        bf16x8v qf[16];
#pragma unroll
        for (int ks = 0; ks < 16; ++ks) qf[ks] = *(const bf16x8v*)(QL + (size_t)tok * 8192 + l15 * 512 + ks * 32 + 8 * g);
        f32x4 oacc[32];
#pragma unroll
        for (int n = 0; n < 32; ++n) oacc[n] = (f32x4){0.f, 0.f, 0.f, 0.f};
        float m_run = -INFINITY, l_run = 0.f;
        for (int ch = 0; ch < nch; ++ch) {
            const int idx = SEL[(size_t)tok * TOPK + ch * 16 + l15];
            asm volatile("s_waitcnt lgkmcnt(0)" ::: "memory");
#pragma unroll
            for (int i = 0; i < 16; ++i) { const int row = __builtin_amdgcn_readlane(idx, i);
                __builtin_amdgcn_global_load_lds((const unsigned*)(CN + (size_t)(bbase + row) * CL + lane * 8), (LAS unsigned*)(buf + i * A2_ROWB), 16, 0, 0); }
            asm volatile("s_waitcnt vmcnt(0)" ::: "memory");
            f32x4 s = {0.f, 0.f, 0.f, 0.f};
#pragma unroll
            for (int ks = 0; ks < 16; ++ks) { const bf16x8v cf = *(const LAS bf16x8v*)(cb + ks * 64); s = __builtin_amdgcn_mfma_f32_16x16x32_bf16(cf, qf[ks], s, 0, 0, 0); }
            s = s * 0.12751743074602468f;
            float mx = fmaxf(fmaxf(s[0], s[1]), fmaxf(s[2], s[3]));
            mx = fmaxf(mx, __shfl_xor(mx, 16)); mx = fmaxf(mx, __shfl_xor(mx, 32));
            const float mn = fmaxf(m_run, mx), alpha = __builtin_amdgcn_exp2f(m_run - mn);
            const float p0 = __builtin_amdgcn_exp2f(s[0] - mn), p1 = __builtin_amdgcn_exp2f(s[1] - mn), p2 = __builtin_amdgcn_exp2f(s[2] - mn), p3 = __builtin_amdgcn_exp2f(s[3] - mn);
            float ps = (p0 + p1) + (p2 + p3); ps += __shfl_xor(ps, 16); ps += __shfl_xor(ps, 32);
            l_run = l_run * alpha + ps; m_run = mn;
            const unsigned pw0 = pk2(p0, p1), pw1 = pk2(p2, p3);
            const bf16x4v pf = __builtin_bit_cast(bf16x4v, (u32x2){pw0, pw1});
#pragma unroll
            for (int n = 0; n < 32; ++n) {
                const v4i16_t t = __builtin_amdgcn_ds_read_tr16_b64_v4i16((LAS v4i16_t*)(tb + n * 32));
                oacc[n] = __builtin_amdgcn_mfma_f32_16x16x16bf16_1k(__builtin_bit_cast(bf16x4v, t), pf, oacc[n] * alpha, 0, 0, 0);
            }
        }
        const float li = 1.f / l_run;
        bf16* op = QL + (size_t)tok * 8192 + l15 * 512 + 4 * g;
#pragma unroll
        for (int n = 0; n < 32; ++n) { const f32x4 o = oacc[n] * li; u32x2 w; w.x = pk2(o[0], o[1]); w.y = pk2(o[2], o[3]); if (!dry) *(u32x2*)(op + 16 * n) = w; }
    }
    asm volatile("s_waitcnt vmcnt(0) lgkmcnt(0)" ::: "memory");
}

__device__ __forceinline__ void sc_decode(int u, int& b, int& c, int& hf, int& sg) {
    c = 63; int rem = u >> 1; b = u & 1;
    for (;;) { const int n = 2 * ((c + 8) >> 3); if (rem < n) break; rem -= n; --c; }
    hf = rem & 1; sg = rem >> 1;
}
__device__ __forceinline__ void sc_stage(LAS unsigned char* buf, const bf16* KI, int u, int wave, int lane) {
    int b, c, hf, sg; sc_decode(u, b, c, hf, sg);
    const int k_lo = sg * 512, k_hi = (k_lo + 512 < (c + 1) * 64) ? k_lo + 512 : (c + 1) * 64, nrd = (k_hi - k_lo) >> 6;
    const int row = wave * 8 + (lane >> 3), sl = lane & 7;
    const bf16* src = KI + (size_t)(b * SEQ + k_lo + row) * 64 + ((sl ^ ((row >> 1) & 7)) * 8);
    for (int rd = 0; rd < nrd; ++rd)
        __builtin_amdgcn_global_load_lds((const unsigned*)(src + (size_t)rd * 64 * 64), (LAS unsigned*)(buf + rd * 8192 + wave * 1024), 16, 0, 0);
}
__device__ __forceinline__ void fast_scores2(LAS unsigned char* lds, const bf16* QI, const bf16* KI, const float* WI, float* SC, int vb, int nb, int wave, int lane) {
    const int r = lane & 31, hi = lane >> 5;
    const int arow_tok = (r >> 2) & 1, arow_head = (r & 3) + 4 * (r >> 3);
    constexpr int NUNITS = 1152;
    int boff[4];
#pragma unroll
    for (int ks = 0; ks < 4; ++ks) boff[ks] = r * 128 + (((2 * ks + hi) ^ ((r >> 1) & 7)) * 16);
    if (vb < NUNITS) sc_stage(lds, KI, vb, wave, lane);
    int cur = 0;
    for (int u = vb; u < NUNITS; u += nb, cur ^= 1) {
        int b, c, hf, sg; sc_decode(u, b, c, hf, sg);
        const int pos0 = c * 64 + hf * 32 + wave * 4, t0 = b * SEQ + pos0;
        const int k_lo = sg * 512, k_hi = (k_lo + 512 < (c + 1) * 64) ? k_lo + 512 : (c + 1) * 64;
        bf16x8v af[2][4]; float wsc[2][16]; float* outp[2];
#pragma unroll
        for (int p = 0; p < 2; ++p) {
#pragma unroll
            for (int ks = 0; ks < 4; ++ks) af[p][ks] = *(const bf16x8v*)(QI + (size_t)(t0 + 2 * p + arow_tok) * 1024 + arow_head * 64 + ks * 16 + 8 * hi);
            const f32x4* wp = (const f32x4*)(WI + (size_t)(t0 + 2 * p + hi) * 16);
#pragma unroll
            for (int j = 0; j < 4; ++j) { const f32x4 w = wp[j]; wsc[p][4 * j] = w[0] * 0.03125f; wsc[p][4 * j + 1] = w[1] * 0.03125f; wsc[p][4 * j + 2] = w[2] * 0.03125f; wsc[p][4 * j + 3] = w[3] * 0.03125f; }
            outp[p] = SC + sc_off(b, pos0 + 2 * p + hi) + r + k_lo;
        }
        asm volatile("s_waitcnt vmcnt(0) lgkmcnt(0)" ::: "memory"); __builtin_amdgcn_s_barrier(); asm volatile("" ::: "memory");
        if (u + nb < NUNITS) sc_stage(lds + (cur ^ 1) * 65536, KI, u + nb, wave, lane);
        const LAS unsigned char* kb = lds + cur * 65536;
        const int ntile = (k_hi - k_lo) >> 5;
        for (int tl = 0; tl < ntile; ++tl) {
            bf16x8v bfr[4];
#pragma unroll
            for (int ks = 0; ks < 4; ++ks) bfr[ks] = *(const LAS bf16x8v*)(kb + tl * 4096 + boff[ks]);
#pragma unroll
            for (int p = 0; p < 2; ++p) {
                f32x16 acc = {0.f, 0.f, 0.f, 0.f, 0.f, 0.f, 0.f, 0.f, 0.f, 0.f, 0.f, 0.f, 0.f, 0.f, 0.f, 0.f};
#pragma unroll
                for (int ks = 0; ks < 4; ++ks) acc = __builtin_amdgcn_mfma_f32_32x32x16_bf16(af[p][ks], bfr[ks], acc, 0, 0, 0);
                float s = 0.f;
#pragma unroll
                for (int h = 0; h < 16; ++h) s += fmaxf(acc[h], 0.f) * wsc[p][h];
                outp[p][tl * 32] = s;
            }
        }
    }
    asm volatile("s_waitcnt vmcnt(0) lgkmcnt(0)" ::: "memory"); __builtin_amdgcn_s_barrier(); asm volatile("" ::: "memory");
}

constexpr int TK_WB = 4 * 260 * 4;
__device__ __forceinline__ void topk_rows2(LAS unsigned char* lds, const float* SC, int* SEL, int gw, int ngw, int wave, int lane, bool dry = false) {
    LAS unsigned* hist = (LAS unsigned*)(lds + wave * TK_WB);
    LAS unsigned* myh = hist + (lane & 3) * 260;
    for (int t = gw; t < M; t += ngw) {
        const int b = t / SEQ, pos = t % SEQ, nadm = ((pos >> 6) + 1) * 64;
        int* sel = SEL + (size_t)t * TOPK;
        if (nadm <= TOPK) { for (int i = lane; i < nadm; i += 64) sel[i] = i; continue; }
        const float* sc = SC + sc_off(b, pos);
        const int nj = nadm >> 6;
        unsigned key[64];
#pragma unroll
        for (int j = 0; j < 64; ++j) key[j] = (j < nj) ? fkey(sc[j * 64 + lane]) : 0u;
        unsigned prefix = 0u; int need = TOPK;
#pragma unroll 1
        for (int pass = 0; pass < 4; ++pass) {
            const int shift = 24 - 8 * pass;
            asm volatile("s_waitcnt lgkmcnt(0)" ::: "memory");
#pragma unroll
            for (int k = 0; k < 16; ++k) hist[lane + 64 * k] = 0u;
            if (lane < 16) hist[1024 + lane] = 0u;
            asm volatile("s_waitcnt lgkmcnt(0)" ::: "memory");
            const unsigned pmask = (pass == 0) ? 0u : (0xffffffffu << (shift + 8));
#pragma unroll
            for (int j4 = 0; j4 < 16; ++j4) {
                if (j4 * 4 < nj) {
#pragma unroll
                    for (int jj = 0; jj < 4; ++jj) { const unsigned kk = key[j4 * 4 + jj];
                        if (((kk ^ prefix) & pmask) == 0u) __hip_atomic_fetch_add(myh + ((kk >> shift) & 255u), 1u, __ATOMIC_RELAXED, __HIP_MEMORY_SCOPE_WORKGROUP); }
                }
            }
            asm volatile("s_waitcnt lgkmcnt(0)" ::: "memory");
            u32x4 c = *(const LAS u32x4*)(hist + 4 * lane);
#pragma unroll
            for (int cp = 1; cp < 4; ++cp) { const u32x4 d = *(const LAS u32x4*)(hist + cp * 260 + 4 * lane); c = c + d; }
            const int s = (int)(c.x + c.y + c.z + c.w);
            int S = s;
#pragma unroll
            for (int o = 1; o < 64; o <<= 1) { const int v = __shfl_down(S, o); if (lane + o < 64) S += v; }
            const int E = S - s;
            const bool cross = (E < need) && (S >= need);
            const unsigned long long bm = __ballot(cross);
            const int Lc = __builtin_ctzll(bm);
            int acc = E, dig = 0, nn = need;
            { bool done = false; const int cc[4] = {(int)c.x, (int)c.y, (int)c.z, (int)c.w};
#pragma unroll
              for (int i = 3; i >= 0; --i) { if (!done) { if (acc + cc[i] >= need) { dig = 4 * lane + i; nn = need - acc; done = true; } else acc += cc[i]; } } }
            const int digit = __builtin_amdgcn_readlane(dig, Lc); need = __builtin_amdgcn_readlane(nn, Lc);
            prefix |= (unsigned)digit << shift;
        }
        int obase = 0;
        const unsigned long long lt = (1ull << lane) - 1ull;
#pragma unroll
        for (int j = 0; j < 64; ++j) {
            if (j < nj) {
                const bool gt = key[j] > prefix, eq = key[j] == prefix;
                const unsigned long long me = __ballot(eq);
                const int erank = __builtin_popcountll(me & lt);
                const bool take = gt || (eq && erank < need);
                const unsigned long long ms = __ballot(take);
                if (take && !dry) sel[obase + __builtin_popcountll(ms & lt)] = j * 64 + lane;
                obase += __builtin_popcountll(ms);
                const int ne = __builtin_popcountll(me); need -= (ne < need ? ne : need);
            }
        }
    }
}

#ifdef NAIVEMASK
template <bool DUAL, class Epi>
__device__ __forceinline__ void naive_gemm(float* lds, const bf16* A, int lda, const float* W, const float* W2, int ldw, const float* kscale,
                                           int Mrows, int N, int K, const Epi& epi, int vb, int nb) {
    float* As = lds;
    float* Ws = lds + 16 * 132;
    float* Ws2 = lds + 32 * 132;
    const int tid = threadIdx.x, tx = tid & 31, ty = tid >> 5;
    const int ntn = (N + 127) / 128, ntm = Mrows / 128;
    for (int tile = vb; tile < ntm * ntn; tile += nb) {
        const int tm = tile / ntn, tn = tile % ntn;
        const int row0 = tm * 128, col0 = tn * 128;
        float acc[8][4], acc2[8][4];
#pragma unroll
        for (int i = 0; i < 8; ++i)
#pragma unroll
            for (int j = 0; j < 4; ++j) { acc[i][j] = 0.f; acc2[i][j] = 0.f; }
        for (int k0 = 0; k0 < K; k0 += 16) {
            {
                const int r = tid >> 2, k4 = (tid & 3) * 4;
                const u32x2 raw = *(const u32x2*)(A + (size_t)(row0 + r) * lda + k0 + k4);
                As[(k4 + 0) * 132 + r] = __uint_as_float(raw.x << 16);
                As[(k4 + 1) * 132 + r] = __uint_as_float(raw.x & 0xffff0000u);
                As[(k4 + 2) * 132 + r] = __uint_as_float(raw.y << 16);
                As[(k4 + 3) * 132 + r] = __uint_as_float(raw.y & 0xffff0000u);
            }
            {
                const int k = tid >> 5, c4 = (tid & 31) * 4;
                f32x4 w = {0.f, 0.f, 0.f, 0.f}, w2 = {0.f, 0.f, 0.f, 0.f};
                if (col0 + c4 < N) {
                    w = *(const f32x4*)(W + (size_t)(k0 + k) * ldw + col0 + c4);
                    if (DUAL) w2 = *(const f32x4*)(W2 + (size_t)(k0 + k) * ldw + col0 + c4);
                    if (kscale) { const float s = kscale[k0 + k]; w = w * s; w2 = w2 * s; }
                }
                *(f32x4*)(Ws + k * 132 + c4) = w;
                if (DUAL) *(f32x4*)(Ws2 + k * 132 + c4) = w2;
            }
            __syncthreads();
#pragma unroll
            for (int k = 0; k < 16; ++k) {
                const f32x4 a0 = *(const f32x4*)(As + k * 132 + ty * 8), a1 = *(const f32x4*)(As + k * 132 + ty * 8 + 4);
                const f32x4 w = *(const f32x4*)(Ws + k * 132 + tx * 4);
                const float a[8] = {a0.x, a0.y, a0.z, a0.w, a1.x, a1.y, a1.z, a1.w};
#pragma unroll
                for (int i = 0; i < 8; ++i) { acc[i][0] += a[i] * w.x; acc[i][1] += a[i] * w.y; acc[i][2] += a[i] * w.z; acc[i][3] += a[i] * w.w; }
                if (DUAL) {
                    const f32x4 w2 = *(const f32x4*)(Ws2 + k * 132 + tx * 4);
#pragma unroll
                    for (int i = 0; i < 8; ++i) { acc2[i][0] += a[i] * w2.x; acc2[i][1] += a[i] * w2.y; acc2[i][2] += a[i] * w2.z; acc2[i][3] += a[i] * w2.w; }
                }
            }
            __syncthreads();
        }
#pragma unroll
        for (int i = 0; i < 8; ++i)
#pragma unroll
            for (int j = 0; j < 4; ++j) { const int r = row0 + ty * 8 + i, c = col0 + tx * 4 + j; if (c < N) epi(r, c, acc[i][j], acc2[i][j]); }
    }
}

struct EpiProj {
    bf16 *U, *V, *Q, *QI, *KI, *GA, *GB; float *CKR, *WI; int coff;
    __device__ __forceinline__ void operator()(int r, int c, float v, float) const {
        c += coff;
        if (c < 2048) U[(size_t)r * 2048 + c] = f2bf(gelu_tanh(v));
        else if (c < 4096) V[(size_t)r * 2048 + c - 2048] = f2bf(gelu_tanh(v));
        else if (c < 6144) Q[(size_t)r * 2048 + c - 4096] = f2bf(v);
        else if (c < 6656) CKR[(size_t)r * 512 + c - 6144] = v;
        else if (c < 7680) QI[(size_t)r * 1024 + c - 6656] = f2bf(v);
        else if (c < 7744) KI[(size_t)r * 64 + c - 7680] = f2bf(v);
        else if (c < 7760) WI[(size_t)r * 16 + c - 7744] = v;
        else if (c < 9808) GA[(size_t)r * 2048 + c - 7760] = f2bf(sigmoidf(v));
        else GB[(size_t)r * 2048 + c - 9808] = f2bf(sigmoidf(v));
    }
};
struct EpiGateA {
    bf16* GA;
    __device__ __forceinline__ void operator()(int r, int c, float v, float) const { const size_t i = (size_t)r * 2048 + c; GA[i] = f2bf(bf2f(GA[i]) * v); }
};
struct EpiGateB {
    bf16* TMP; const bf16* GB;
    __device__ __forceinline__ void operator()(int r, int c, float v, float) const { const size_t i = (size_t)r * 2048 + c; TMP[i] = f2bf(bf2f(TMP[i]) + bf2f(GB[i]) * v); }
};
struct EpiRes {
    const float* X; float* H; bf16* HB;
    __device__ __forceinline__ void operator()(int r, int c, float v, float) const { const size_t i = (size_t)r * 2048 + c; const float h = X[i] + v; H[i] = h; HB[i] = f2bf(h); }
};
struct EpiSwiglu {
    const float* HST; bf16* FFo;
    __device__ __forceinline__ void operator()(int r, int c, float g, float u) const {
        float ss = 0.f;
        for (int j = 0; j < 32; ++j) ss += HST[(size_t)r * 32 + j];
        const float rs = rsqrtf(ss * (1.f / D) + EPS);
        const float gg = g * rs, uu = u * rs;
        FFo[(size_t)r * FF + c] = f2bf(gg * sigmoidf(gg) * uu);
    }
};
struct EpiRes2 {
    float* H;
    __device__ __forceinline__ void operator()(int r, int c, float v, float) const { const size_t i = (size_t)r * 2048 + c; H[i] = H[i] + v; }
};

__device__ __forceinline__ void rows_vst(const bf16* V, float* VST, int gw, int ngw, int lane) {
    for (int m = gw; m < M; m += ngw) {
        const int j = lane >> 1, hf = lane & 1;
        const u32x4* p = (const u32x4*)(V + (size_t)m * D + j * 64 + hf * 32);
        float s = 0.f, q = 0.f;
#pragma unroll
        for (int i = 0; i < 4; ++i) { const u32x4 w = p[i]; const unsigned ww[4] = {w.x, w.y, w.z, w.w};
#pragma unroll
            for (int e = 0; e < 4; ++e) { const float a = __uint_as_float(ww[e] << 16), b = __uint_as_float(ww[e] & 0xffff0000u); s += a + b; q += a * a + b * b; } }
        s += __shfl_xor(s, 1); q += __shfl_xor(q, 1);
        if (hf == 0) { VST[((size_t)m * 32 + j) * 2] = s; VST[((size_t)m * 32 + j) * 2 + 1] = q; }
    }
}
__device__ __forceinline__ void rows_hst(const float* H, float* HST, int gw, int ngw, int lane) {
    for (int m = gw; m < M; m += ngw) {
        const int j = lane >> 1, hf = lane & 1;
        const f32x4* p = (const f32x4*)(H + (size_t)m * D + j * 64 + hf * 32);
        float q = 0.f;
#pragma unroll
        for (int i = 0; i < 8; ++i) { const f32x4 w = p[i]; q += w.x * w.x + w.y * w.y + w.z * w.z + w.w * w.w; }
        q += __shfl_xor(q, 1);
        if (hf == 0) HST[(size_t)m * 32 + j] = q;
    }
}
__device__ __forceinline__ void naive_qlat(float* lds, const bf16* Q, const float* w_uk, bf16* QL, int vb, int nb) {
    float* qs = lds;
    const int tid = threadIdx.x;
    for (int unit = vb; unit < (M / 32) * NH; unit += nb) {
        const int h = unit % NH, t0 = (unit / NH) * 32;
        __syncthreads();
        for (int i = tid; i < 32 * 128; i += NTHREADS) qs[i] = bf2f(Q[(size_t)(t0 + (i >> 7)) * D + h * 128 + (i & 127)]);
        __syncthreads();
        float acc[32];
#pragma unroll
        for (int i = 0; i < 32; ++i) acc[i] = 0.f;
        const f32x4* wr = (const f32x4*)(w_uk + (size_t)tid * 2048 + h * 128);
        for (int d4 = 0; d4 < 32; ++d4) {
            const f32x4 w = wr[d4];
#pragma unroll
            for (int i = 0; i < 32; ++i) { const f32x4 q = *(const f32x4*)(qs + i * 128 + d4 * 4); acc[i] += w.x * q.x + w.y * q.y + w.z * q.z + w.w * q.w; }
        }
#pragma unroll
        for (int i = 0; i < 32; ++i) QL[((size_t)(t0 + i) * NH + h) * CL + tid] = f2bf(acc[i]);
    }
}
__device__ __forceinline__ void naive_yb(float* lds, const bf16* OL, const float* w_uv, bf16* YB, int vb, int nb) {
    float* os = lds;
    const int tid = threadIdx.x, d = tid & 127, tq = tid >> 7;
    for (int unit = vb; unit < (M / 32) * NH; unit += nb) {
        const int h = unit % NH, t0 = (unit / NH) * 32;
        __syncthreads();
        for (int i = tid; i < 32 * 512; i += NTHREADS) os[i] = bf2f(OL[((size_t)(t0 + (i >> 9)) * NH + h) * CL + (i & 511)]);
        __syncthreads();
        float acc[8];
#pragma unroll
        for (int i = 0; i < 8; ++i) acc[i] = 0.f;
        for (int c = 0; c < CL; ++c) {
            const float w = w_uv[(size_t)c * 2048 + h * 128 + d];
#pragma unroll
            for (int i = 0; i < 8; ++i) acc[i] += w * os[(tq * 8 + i) * 512 + c];
        }
#pragma unroll
        for (int i = 0; i < 8; ++i) YB[(size_t)(t0 + tq * 8 + i) * D + h * 128 + d] = f2bf(acc[i]);
    }
}

#endif
#ifdef DBG_CHECK
__device__ __forceinline__ void dbg_scores(float* lds, const bf16* QI, const bf16* KI, const float* WI, const float* SC, unsigned* res, int vb, int nb) {
    float* qs = lds;
    float* ws = lds + 1024;
    const int tid = threadIdx.x;
    float dmax = 0.f, rmax = 0.f;
    for (int ii = vb; ii < 256; ii += nb) { const int t = ii * 32 + 17;
        const int b = t / SEQ, pos = t % SEQ, nadm = ((pos >> 6) + 1) * 64;
        __syncthreads();
        for (int i = tid; i < 1024; i += NTHREADS) qs[i] = bf2f(QI[(size_t)t * 1024 + i]);
        if (tid < 16) ws[tid] = WI[(size_t)t * 16 + tid] * 0.25f;
        __syncthreads();
        const float* out = SC + sc_off(b, pos);
        for (int s = tid; s < nadm; s += NTHREADS) {
            float k[64];
            const u32x4* kp = (const u32x4*)(KI + (size_t)(b * SEQ + s) * 64);
#pragma unroll
            for (int i = 0; i < 8; ++i) { const u32x4 w = kp[i]; const unsigned ww[4] = {w.x, w.y, w.z, w.w};
#pragma unroll
                for (int e = 0; e < 4; ++e) { k[i * 8 + e * 2] = __uint_as_float(ww[e] << 16); k[i * 8 + e * 2 + 1] = __uint_as_float(ww[e] & 0xffff0000u); } }
            float sc = 0.f;
            for (int h = 0; h < 16; ++h) {
                float l = 0.f;
#pragma unroll
                for (int d = 0; d < 64; ++d) l += qs[h * 64 + d] * k[d];
                sc += ws[h] * fmaxf(l * 0.125f, 0.f);
            }
            dmax = fmaxf(dmax, fabsf(out[s] - sc)); rmax = fmaxf(rmax, fabsf(sc));
        }
    }
    atomicMax(res + 0, __float_as_uint(dmax)); atomicMax(res + 1, __float_as_uint(rmax));
}
__device__ __forceinline__ void dbg_attn(float* lds, bf16* QS, const bf16* QLfast, const bf16* CN, const int* SEL, unsigned* res, int vb, int nb) {
    float* qs = lds;
    float* att = lds + 16 * 512;
    int* sl = (int*)(att + 16 * 256);
    const int tid = threadIdx.x, lane = tid & 63, wid = tid >> 6;
    float dmax = 0.f, rmax = 0.f;
    for (int ii = vb; ii < 256; ii += nb) { const int t = ii * 32 + 17; bf16* QL = QS + (size_t)ii * 8192 - (size_t)t * 8192;
        const int b = t / SEQ, pos = t % SEQ, nadm = ((pos >> 6) + 1) * 64, nsel = nadm < TOPK ? nadm : TOPK;
        __syncthreads();
        for (int i = tid; i < 16 * 512; i += NTHREADS) qs[i] = bf2f(QL[(size_t)t * 8192 + i]);
        if (tid < 256) sl[tid] = (tid < nsel) ? SEL[(size_t)t * TOPK + tid] : 0;
        __syncthreads();
        {
            const int k = tid & 255, hh = tid >> 8;
            float a[8];
#pragma unroll
            for (int i = 0; i < 8; ++i) a[i] = 0.f;
            if (k < nsel) {
                const u32x4* cp = (const u32x4*)(CN + (size_t)(b * SEQ + sl[k]) * CL);
                for (int c8 = 0; c8 < 64; ++c8) {
                    const u32x4 w = cp[c8]; float cv[8];
                    cv[0] = __uint_as_float(w.x << 16); cv[1] = __uint_as_float(w.x & 0xffff0000u); cv[2] = __uint_as_float(w.y << 16); cv[3] = __uint_as_float(w.y & 0xffff0000u);
                    cv[4] = __uint_as_float(w.z << 16); cv[5] = __uint_as_float(w.z & 0xffff0000u); cv[6] = __uint_as_float(w.w << 16); cv[7] = __uint_as_float(w.w & 0xffff0000u);
#pragma unroll
                    for (int i = 0; i < 8; ++i) { const float* qh = qs + (hh * 8 + i) * 512 + c8 * 8;
                        const f32x4 q0 = *(const f32x4*)qh, q1 = *(const f32x4*)(qh + 4);
                        a[i] += q0.x * cv[0] + q0.y * cv[1] + q0.z * cv[2] + q0.w * cv[3] + q1.x * cv[4] + q1.y * cv[5] + q1.z * cv[6] + q1.w * cv[7]; }
                }
            }
#pragma unroll
            for (int i = 0; i < 8; ++i) att[(hh * 8 + i) * 256 + k] = (k < nsel) ? a[i] * 0.08838834764831845f : -INFINITY;
        }
        __syncthreads();
        {
#pragma unroll
            for (int hi = 0; hi < 2; ++hi) { float* row = att + (wid * 2 + hi) * 256;
                float v[4]; float mx = -INFINITY;
#pragma unroll
                for (int i = 0; i < 4; ++i) { v[i] = row[lane + 64 * i]; mx = fmaxf(mx, v[i]); }
                mx = wave_max(mx); float s = 0.f;
#pragma unroll
                for (int i = 0; i < 4; ++i) { v[i] = __expf(v[i] - mx); s += v[i]; }
                s = wave_sum(s); const float inv = 1.f / s;
#pragma unroll
                for (int i = 0; i < 4; ++i) row[lane + 64 * i] = v[i] * inv; }
        }
        __syncthreads();
        {
            float o[16];
#pragma unroll
            for (int i = 0; i < 16; ++i) o[i] = 0.f;
            for (int k = 0; k < nsel; ++k) {
                const float cv = bf2f(CN[(size_t)(b * SEQ + sl[k]) * CL + tid]);
#pragma unroll
                for (int h = 0; h < 16; ++h) o[h] += att[h * 256 + k] * cv;
            }
#pragma unroll
            for (int h = 0; h < 16; ++h) { const float f = bf2f(QLfast[(size_t)t * 8192 + h * 512 + tid]); dmax = fmaxf(dmax, fabsf(f - o[h])); rmax = fmaxf(rmax, fabsf(o[h])); }
        }
    }
    atomicMax(res + 2, __float_as_uint(dmax)); atomicMax(res + 3, __float_as_uint(rmax));
}
#endif
#define XB_TMO      128
#define XB_XCNT(j)  (256  + 64 * (j))
#define XB_XSUB(j)  (1280 + 64 * (j))
#define XB_XGEN(j)  (2304 + 64 * (j))
#define XB_TOP      3328
#define XB_TOPGEN   3392
#define XCD_BAR_WORDS 3456
#define XB_SPIN_CAP (1u << 18)

__device__ __forceinline__ unsigned xb_ld(unsigned* p)              { return __hip_atomic_load(p, __ATOMIC_RELAXED, __HIP_MEMORY_SCOPE_AGENT); }
__device__ __forceinline__ unsigned xb_add(unsigned* p, unsigned v) { return __hip_atomic_fetch_add(p, v, __ATOMIC_RELAXED, __HIP_MEMORY_SCOPE_AGENT); }
__device__ __forceinline__ unsigned xb_xcc_id() { return (unsigned)__builtin_amdgcn_s_getreg((3 << 11) | 20) & 0xFu; }
#define XB_SPIN(cond, bar) do { unsigned _sp = 0; while (cond) { __builtin_amdgcn_s_sleep(1); \
    if ((++_sp & 255u) == 0u) { if (xb_ld(&(bar)[XB_TMO])) break; if (_sp > XB_SPIN_CAP) { atomicAdd(&(bar)[XB_TMO], 1u); break; } } } } while (0)

struct XcdBarrier {
    unsigned* bar; unsigned x;
    volatile LAS unsigned* st;
};

__device__ __forceinline__ XcdBarrier xcd_barrier_post(unsigned* bar, volatile LAS unsigned* st) {
    XcdBarrier b; b.bar = bar; b.x = xb_xcc_id(); b.st = st;
    if (threadIdx.x == 0) (void)xb_add(&bar[XB_XCNT(b.x)], 1u);
    return b;
}
__device__ __forceinline__ void xcd_barrier_complete(unsigned* bar, unsigned x, unsigned& nloc, unsigned& nx) {
    const unsigned G = gridDim.x * gridDim.y * gridDim.z;
    unsigned sum, cnt, mine, sp = 0u;
    for (;;) {
        sum = 0u; cnt = 0u; mine = 0u;
#pragma unroll
        for (unsigned j = 0; j < 16; ++j) { const unsigned c = xb_ld(&bar[XB_XCNT(j)]); sum += c; cnt += (c > 0u) ? 1u : 0u; mine = (j == x) ? c : mine; }
        if (sum == G) break;
        __builtin_amdgcn_s_sleep(1);
        if ((++sp & 255u) == 0u) { if (xb_ld(&bar[XB_TMO])) break; if (sp > XB_SPIN_CAP) { atomicAdd(&bar[XB_TMO], 1u); break; } }
    }
    nloc = mine > 0u ? mine : 1u; nx = cnt > 0u ? cnt : 1u;
}

__device__ __forceinline__ void xcd_barrier(const XcdBarrier& b) {
    asm volatile("s_waitcnt vmcnt(0)" ::: "memory");
    __syncthreads();
    if (threadIdx.x == 0) {
        unsigned* bar = b.bar;
        __builtin_amdgcn_s_waitcnt(0);
        unsigned nloc = b.st[0], nx = b.st[1];
        if (nloc == 0u) { xcd_barrier_complete(bar, b.x, nloc, nx); b.st[0] = nloc; b.st[1] = nx; }
        const unsigned old = xb_add(&bar[XB_XSUB(b.x)], 1u);
        const unsigned gen = old / nloc;
        if (old + 1u == (gen + 1u) * nloc) {
            __builtin_amdgcn_fence(__ATOMIC_RELEASE, "agent");
            asm volatile("s_waitcnt vmcnt(0)" ::: "memory");
            const unsigned og = xb_add(&bar[XB_TOP], 1u);
            const unsigned tg = og / nx;
            if (og + 1u == (tg + 1u) * nx) xb_add(&bar[XB_TOPGEN], 1u);
            else XB_SPIN(xb_ld(&bar[XB_TOPGEN]) == tg, bar);
            __builtin_amdgcn_fence(__ATOMIC_ACQUIRE, "agent");
            xb_add(&bar[XB_XGEN(b.x)], 1u);
            asm volatile("s_waitcnt vmcnt(0)" ::: "memory");
        } else {
            XB_SPIN(xb_ld(&bar[XB_XGEN(b.x)]) == gen, bar);
            __builtin_amdgcn_fence(__ATOMIC_ACQUIRE, "agent");
            asm volatile("s_waitcnt vmcnt(0)" ::: "memory");
        }
    }
    __syncthreads();
}

#define LDS_WAIT() asm volatile("s_waitcnt lgkmcnt(0)" ::: "memory")
#define VM_WAIT() asm volatile("s_waitcnt vmcnt(0)" ::: "memory")
template <class ColMap>
__device__ __forceinline__ void transpose_item(const float* W, int ldw, int ks0, bf16* WT, int ldd, int kd0, int n0, const ColMap& cm, const float* kscale, LAS float* scr, int lane) {
    const int sc = cm(n0 + (lane & 31));
#pragma unroll 8
    for (int i = 0; i < 32; ++i) { const int kk = 2 * i + (lane >> 5); float v = 0.f;
        if (sc >= 0) { v = W[(size_t)(ks0 + kk) * ldw + sc]; if (kscale) v *= kscale[ks0 + kk]; }
        scr[kk * 33 + (lane & 31)] = v; }
    LDS_WAIT(); asm volatile("" ::: "memory");
    const int c = lane & 7;
#pragma unroll
    for (int j = 0; j < 4; ++j) { const int n = (lane >> 3) + 8 * j; const LAS float* s = scr + (8 * c) * 33 + n;
        u32x4 o; o.x = pk2(s[0 * 33], s[1 * 33]); o.y = pk2(s[2 * 33], s[3 * 33]); o.z = pk2(s[4 * 33], s[5 * 33]); o.w = pk2(s[6 * 33], s[7 * 33]);
        *(u32x4*)(WT + (size_t)(n0 + n) * ldd + kd0 + 8 * c) = o; }
    LDS_WAIT(); asm volatile("" ::: "memory");
}
struct CmIdent { __device__ __forceinline__ int operator()(int n) const { return n; } };
struct CmWin { __device__ __forceinline__ int operator()(int n) const { return n < 7760 ? n : (n < 7936 ? -1 : n - 176); } };
struct CmGU { __device__ __forceinline__ int operator()(int n) const { return (n >> 8) * 128 + (n & 127); } };

__device__ __forceinline__ void p0_prologue(LAS unsigned char* lds, const float* x, const float* norm1_g, const float* w_in, const float* w_uk, const float* w_uv,
                                            const float* w_oa, const float* w_ob, const float* w_out, bf16* XN, bf16* WIN, bf16* WUK, bf16* WUV, bf16* WOA, bf16* WOB, bf16* WOUT,
                                            int gw, int ngw, int wave, int lane) {
    LAS float* scr = (LAS float*)(lds + wave * 16384);
    constexpr int I_IN = 32 * (NINP / 32), I_SQ = 32 * 64, I_UV = 16 * 64;
    constexpr int NITEMS = I_IN + 3 * I_SQ + I_UV;
    for (int it = gw; it < NITEMS; it += ngw) {
        int r = it;
        if (r < I_IN) { const int nb = r % (NINP / 32), kb = r / (NINP / 32); transpose_item(w_in, NIN, kb * 64, WIN, D, kb * 64, nb * 32, CmWin(), nullptr, scr, lane); continue; } r -= I_IN;
        if (r < I_SQ) { transpose_item(w_oa, D, (r / 64) * 64, WOA, D, (r / 64) * 64, (r % 64) * 32, CmIdent(), nullptr, scr, lane); continue; } r -= I_SQ;
        if (r < I_SQ) { transpose_item(w_ob, D, (r / 64) * 64, WOB, D, (r / 64) * 64, (r % 64) * 32, CmIdent(), nullptr, scr, lane); continue; } r -= I_SQ;
        if (r < I_SQ) { transpose_item(w_out, D, (r / 64) * 64, WOUT, D, (r / 64) * 64, (r % 64) * 32, CmIdent(), nullptr, scr, lane); continue; } r -= I_SQ;
        {
            const int nb = r % 64, kb = r / 64, h = nb >> 2; const bool data = (kb >> 3) == (h & 1);
            if (data) transpose_item(w_uv, D, (kb & 7) * 64, WUV, 1024, kb * 64, nb * 32, CmIdent(), nullptr, scr, lane);
            else { const int c = lane & 7;
#pragma unroll
                for (int j = 0; j < 4; ++j) { const int n = (lane >> 3) + 8 * j; *(u32x4*)(WUV + (size_t)(nb * 32 + n) * 1024 + kb * 64 + 8 * c) = (u32x4){0u, 0u, 0u, 0u}; } }
        }
    }
    for (int i = gw * 64 + lane; i < 16 * 512 * 16; i += ngw * 64) { const int d8 = i & 15, c = (i >> 4) & 511, h = i >> 13;
        const f32x4* s = (const f32x4*)(w_uk + (size_t)c * 2048 + h * 128 + d8 * 8); const f32x4 a = s[0], b = s[1];
        u32x4 o; o.x = pk2(a[0], a[1]); o.y = pk2(a[2], a[3]); o.z = pk2(b[0], b[1]); o.w = pk2(b[2], b[3]);
        *(u32x4*)(WUK + ((size_t)h * 512 + c) * 128 + d8 * 8) = o; }
    rows_xn(x, norm1_g, XN, gw, ngw, lane);
}
__device__ __forceinline__ void p_convert_ffn(LAS unsigned char* lds, const float* w_fg, const float* w_fu, const float* w_fd, const float* norm2_g, bf16* WGU, bf16* WD, int gw, int ngw, int wave, int lane) {
    LAS float* scr = (LAS float*)(lds + wave * 16384);
    constexpr int I_GU = 32 * (11264 / 32), I_D = 88 * 64;
    for (int it = gw; it < I_GU + I_D; it += ngw) {
        int r = it;
        if (r < I_GU) { const int nb = r % 352, kb = r / 352; const bool up = ((nb * 32) & 128) != 0;
            transpose_item(up ? w_fu : w_fg, FF, kb * 64, WGU, D, kb * 64, nb * 32, CmGU(), norm2_g, scr, lane); continue; } r -= I_GU;
        transpose_item(w_fd, D, (r / 64) * 64, WD, FF, (r / 64) * 64, (r % 64) * 32, CmIdent(), nullptr, scr, lane);
    }
}

#ifndef REPEAT_MASK
#define REPEAT_MASK 0
#endif
__device__ __forceinline__ int opaque_one() { int x = 1; asm volatile("" : "+s"(x)); return x; }
#define REP(k) for (int rep_ = 0, repn_ = (((REPEAT_MASK >> (k)) & 1) ? 1 + opaque_one() : 1); rep_ < repn_; ++rep_)

#define P_X ((const float*)ka->in[0])
#define P_NORM1 ((const float*)ka->in[1])
#define P_WIN_F ((const float*)ka->in[2])
#define P_LNG ((const float*)ka->in[3])
#define P_LNB ((const float*)ka->in[4])
#define P_WS_F ((const float*)ka->in[5])
#define P_BS_F ((const float*)ka->in[6])
#define P_KVG ((const float*)ka->in[7])
#define P_WUK_F ((const float*)ka->in[8])
#define P_WUV_F ((const float*)ka->in[9])
#define P_WOA_F ((const float*)ka->in[10])
#define P_WOB_F ((const float*)ka->in[11])
#define P_WOUT_F ((const float*)ka->in[12])
#define P_NORM2 ((const float*)ka->in[13])
#define P_WFG ((const float*)ka->in[14])
#define P_WFU ((const float*)ka->in[15])
#define P_WFD ((const float*)ka->in[16])
#define P_FING ((const float*)ka->in[17])
#define B16(off) ((bf16*)(ws + (off)))
#define F32(off) ((float*)(ws + (off)))
constexpr int CW_BAR = 4096;
struct Args { const float* in[18]; float* out; unsigned char* ws; int ph_lo, ph_hi, use_bar, pad; };
constexpr int N_PHASES = 12;

template <int ONLY> __global__ void __launch_bounds__(NTHREADS, 2) mk_fwd(Args a) {
    extern __shared__ __attribute__((aligned(16))) unsigned char lds_g[];
    LAS unsigned char* lds = (LAS unsigned char*)lds_g;
    float* ldsf = (float*)lds_g;
    const int tid = threadIdx.x, lane = tid & 63, wave = __builtin_amdgcn_readfirstlane(tid >> 6);
    const int G = gridDim.x, vb = blockIdx.x;
    const int gw = vb * NWAVES + wave, ngw = G * NWAVES;
    const __attribute__((address_space(4))) Args* ka = (const __attribute__((address_space(4))) Args*)__builtin_amdgcn_kernarg_segment_ptr();
    unsigned char* const ws = a.ws;
    for (int u = tid; u < (LDS_BYTES - LDSCTL_OFF) / 4; u += NTHREADS) ((LAS unsigned*)(lds + LDSCTL_OFF))[u] = 0u;
    __syncthreads();
    XcdBarrier bar; bar.bar = (unsigned*)(ws + WS_CTL) + CW_BAR; bar.x = 0; bar.st = nullptr;
    if (a.use_bar) bar = xcd_barrier_post((unsigned*)(ws + WS_CTL) + CW_BAR, (volatile LAS unsigned*)(lds + MISC_OFF) + 8);
    const int lo = a.ph_lo, hi = a.ph_hi;
#ifndef SKIPMASK
#define SKIPMASK 0
#endif
#define IN(k) (!((SKIPMASK >> (k)) & 1) && (ONLY < 0 || ONLY == (k)) && lo <= (k) && (k) < hi)
#ifdef DBG_TIME
#define STAMP(i) do { if (vb == 0 && tid == 0) ((unsigned long long*)(ws + WS_CTL + 32768))[i] = __builtin_amdgcn_s_memrealtime(); } while (0)
#define SEAM(k) do { STAMP(2 * (k) + 1); if (IN(k) && IN((k) + 1)) xcd_barrier(bar); STAMP(2 * (k) + 2); } while (0)
#else
#define STAMP(i) do { } while (0)
#ifdef DBG_BAR2
#define SEAM(k) do { if (IN(k) && IN((k) + 1)) { xcd_barrier(bar); xcd_barrier(bar); } } while (0)
#else
#define SEAM(k) do { if (IN(k) && IN((k) + 1)) xcd_barrier(bar); } while (0)
#endif
#endif

    STAMP(0);
    if (IN(0)) REP(0) { p0_prologue(lds, P_X, P_NORM1, P_WIN_F, P_WUK_F, P_WUV_F, P_WOA_F, P_WOB_F, P_WOUT_F, B16(WS_XN), B16(WS_WIN), B16(WS_WUK), B16(WS_WUV), B16(WS_WOA), B16(WS_WOB), B16(WS_WOUT), gw, ngw, wave, lane); }
    SEAM(0);
#if defined(NAIVEMASK) && (NAIVEMASK & (1 << 1))
    if (IN(1)) { EpiProj e{B16(WS_U), B16(WS_V), B16(WS_Q), B16(WS_QI), B16(WS_KI), B16(WS_GA), B16(WS_GB), F32(WS_CKR), F32(WS_WI), 0}; naive_gemm<false>(ldsf, B16(WS_XN), D, P_WIN_F, nullptr, NIN, nullptr, M, NIN, D, e, vb, G); }
#else
    if (IN(1)) REP(1) { pg8::Gemm g{B16(WS_XN), B16(WS_WIN), D, D, D}; pg8::StaticOrder S; S.init(M, NINP, G, vb);
        pg8::EpiProjF E{ws};
        pg8::gemm_phase<pg8::EpiProjF, pg8::StaticOrder, true, true>(lds, g, S, E); }
#endif
    SEAM(1);
#if defined(NAIVEMASK)
    if (ONLY == 101) { rows_vst(B16(WS_V), F32(WS_VST), gw, ngw, lane); }
    if (ONLY == 102) { rows_hst(ka->out, F32(WS_HST), gw, ngw, lane); }
#endif
    if (IN(2)) { REP(11) rows_cn(F32(WS_CKR), P_KVG, B16(WS_CN), gw, ngw, lane); REP(12) fast_gating(lds, B16(WS_U), B16(WS_V), F32(WS_VST), P_LNG, P_LNB, P_WS_F, P_BS_F, vb, G, wave, lane, rep_ + 1 < repn_); REP(2) fast_scores2(lds, B16(WS_QI), B16(WS_KI), F32(WS_WI), F32(WS_SC), vb, G, wave, lane); __syncthreads(); }
    SEAM(2);
#ifdef DBG_CHECK
    if (IN(3)) { dbg_scores(ldsf, B16(WS_QI), B16(WS_KI), F32(WS_WI), F32(WS_SC), (unsigned*)(ws + WS_CTL) + 3000, vb, G); __syncthreads(); }
#endif
#if defined(NAIVEMASK) && (NAIVEMASK & (1 << 3))
    if (IN(3)) { EpiGateA e{B16(WS_GA)}; naive_gemm<false>(ldsf, B16(WS_U), D, P_WOA_F, nullptr, D, nullptr, M, D, D, e, vb, G); topk_rows(F32(WS_SC), (int*)(ws + WS_SEL), gw, ngw, lane); }
#else
    if (IN(3)) { pg8::Gemm g{B16(WS_U), B16(WS_WOA), D, D, D}; pg8::StaticOrder S; S.init(M, D, G, vb);
        for (int rep_ = ((REPEAT_MASK >> 13) & 1) ? 0 : 1; rep_ < 2; ++rep_) { pg8::EpiGateAF E{B16(WS_GA), rep_ == 0}; pg8::gemm_phase<pg8::EpiGateAF, pg8::StaticOrder, true, true>(lds, g, S, E); }
        topk_rows2(lds, F32(WS_SC), (int*)(ws + WS_SEL), gw, ngw, wave, lane); }
#endif
    SEAM(3);
#if defined(NAIVEMASK) && (NAIVEMASK & (1 << 4))
    if (IN(4)) { naive_qlat(ldsf, B16(WS_Q), P_WUK_F, B16(WS_QL), vb, G); }
#else
    if (IN(4)) REP(4) { int kq = 128; asm volatile("" : "+s"(kq)); pg8::Gemm g{B16(WS_Q), B16(WS_WUK), D, 128, kq}; pg8::HeadOrderQ S{G, vb}; pg8::EpiQlatF E{B16(WS_QL)};
        pg8::gemm_phase<pg8::EpiQlatF, pg8::HeadOrderQ, true, true>(lds, g, S, E); }
#endif
    SEAM(4);
#ifdef DBG_CHECK
    if (IN(5)) { for (int ii = vb; ii < 256; ii += G) { const u32x4* src = (const u32x4*)(B16(WS_QL) + (size_t)(ii * 32 + 17) * 8192); u32x4* dst = (u32x4*)(ws + 326 * MiB) + (size_t)ii * 1024; for (int e = tid; e < 1024; e += NTHREADS) dst[e] = src[e]; } xcd_barrier(bar); }
#endif
    if (IN(5)) { REP(5) attn_wave(lds, B16(WS_QL), B16(WS_CN), (const int*)(ws + WS_SEL), vb, G, wave, lane, rep_ + 1 < repn_); __syncthreads(); }
    SEAM(5);
#ifdef DBG_CHECK
    if (IN(6)) { dbg_attn(ldsf, (bf16*)(ws + 326 * MiB), B16(WS_QL), B16(WS_CN), (const int*)(ws + WS_SEL), (unsigned*)(ws + WS_CTL) + 3000, vb, G); __syncthreads(); }
#endif
#if defined(NAIVEMASK) && (NAIVEMASK & (1 << 6))
    if (IN(6)) { naive_yb(ldsf, B16(WS_QL), P_WUV_F, B16(WS_Q), vb, G); }
#else
    if (IN(6)) REP(6) { pg8::Gemm g{B16(WS_QL), B16(WS_WUV), 8192, 1024, 1024}; pg8::PairOrderYB S{G, vb}; pg8::EpiPlainF E{B16(WS_Q), D};
        pg8::gemm_phase<pg8::EpiPlainF, pg8::PairOrderYB, true, true>(lds, g, S, E); }
#endif
    SEAM(6);
#if defined(NAIVEMASK) && (NAIVEMASK & (1 << 7))
    if (IN(7)) { EpiGateB e{B16(WS_GA), B16(WS_GB)}; naive_gemm<false>(ldsf, B16(WS_Q), D, P_WOB_F, nullptr, D, nullptr, M, D, D, e, vb, G); p_convert_ffn(lds, P_WFG, P_WFU, P_WFD, P_NORM2, B16(WS_WGU), B16(WS_WD), gw, ngw, wave, lane); }
#else
    if (IN(7)) { pg8::Gemm g{B16(WS_Q), B16(WS_WOB), D, D, D}; pg8::StaticOrder S; S.init(M, D, G, vb); for (int rep_ = ((REPEAT_MASK >> 14) & 1) ? 0 : 1; rep_ < 2; ++rep_) { pg8::EpiGateBF E{B16(WS_GA), B16(WS_GB), rep_ == 0}; pg8::gemm_phase<pg8::EpiGateBF, pg8::StaticOrder, true, true>(lds, g, S, E); }
        REP(15) p_convert_ffn(lds, P_WFG, P_WFU, P_WFD, P_NORM2, B16(WS_WGU), B16(WS_WD), gw, ngw, wave, lane); }
#endif
    SEAM(7);
#if defined(NAIVEMASK) && (NAIVEMASK & (1 << 8))
    if (IN(8)) { EpiRes e{P_X, ka->out, B16(WS_HB)}; naive_gemm<false>(ldsf, B16(WS_GA), D, P_WOUT_F, nullptr, D, nullptr, M, D, D, e, vb, G); }
#else
    if (IN(8)) REP(8) { pg8::Gemm g{B16(WS_GA), B16(WS_WOUT), D, D, D}; pg8::StaticOrder S; S.init(M, D, G, vb); pg8::EpiResF E{P_X, ka->out, B16(WS_HB), F32(WS_HST)};
        pg8::gemm_phase<pg8::EpiResF, pg8::StaticOrder, true, true>(lds, g, S, E); }
#endif
    SEAM(8);
#if defined(NAIVEMASK) && (NAIVEMASK & (1 << 9))
    if (IN(9)) { EpiSwiglu e{F32(WS_HST), B16(WS_FF)}; naive_gemm<true>(ldsf, B16(WS_HB), D, P_WFG, P_WFU, FF, P_NORM2, M, FF, D, e, vb, G); }
#else
    if (IN(9)) REP(9) { pg8::Gemm g{B16(WS_HB), B16(WS_WGU), D, D, D}; pg8::StaticOrder S; S.init(M, 11264, G, vb); pg8::EpiSwigluF E{F32(WS_HST), B16(WS_FF)};
        pg8::gemm_phase<pg8::EpiSwigluF, pg8::StaticOrder, true, true>(lds, g, S, E); }
#endif
    SEAM(9);
#if defined(NAIVEMASK) && (NAIVEMASK & (1 << 10))
    if (IN(10)) { EpiRes2 e{ka->out}; naive_gemm<false>(ldsf, B16(WS_FF), FF, P_WFD, nullptr, D, nullptr, M, D, FF, e, vb, G); }
#else
    if (IN(10)) { pg8::Gemm g{B16(WS_FF), B16(WS_WD), FF, FF, FF}; pg8::StaticOrder S; S.init(M, D, G, vb); for (int rep_ = ((REPEAT_MASK >> 10) & 1) ? 0 : 1; rep_ < 2; ++rep_) { pg8::EpiRes2F E{ka->out, rep_ == 0}; pg8::gemm_phase<pg8::EpiRes2F, pg8::StaticOrder, true, true>(lds, g, S, E); } }
#endif
    SEAM(10);
    if (IN(11)) REP(7) rows_final(ka->out, P_FING, gw, ngw, lane, rep_ + 1 < repn_);
#ifdef DBG_TIME
    if (IN(11)) { STAMP(23); xcd_barrier(bar); if (vb == 0) { const unsigned long long* ts = (const unsigned long long*)(ws + WS_CTL + 32768);
            float total = (float)(ts[23] - ts[0]) * 0.01f; float barsum = 0.f; for (int k = 0; k < 11; ++k) barsum += (float)(ts[2 * k + 2] - ts[2 * k + 1]) * 0.01f;
            float ph[12]; for (int k = 0; k < 12; ++k) ph[k] = (float)(ts[2 * k + 1] - ts[2 * k]) * 0.01f;
            float W[12]; for (int k = 0; k < 11; ++k) W[k] = (float)(ts[2 * k + 2] - ts[2 * k]) * 0.01f / total; W[11] = (float)(ts[23] - ts[22]) * 0.01f / total;
            const float fa = DBG_A, fb = DBG_B;
            const float A = 100.f + 10.f * floorf(fa * 50.f); (void)fb;
            __syncthreads(); if (tid == 0) ka->out[0] = A; } }
#endif
#ifdef DBG_CHECK
    if (IN(11)) { xcd_barrier(bar); if (vb == 0 && tid == 0) { const unsigned* res = (const unsigned*)(ws + WS_CTL) + 3000; const float d = __uint_as_float(res[DBG_CHECK * 2]), r = __uint_as_float(res[DBG_CHECK * 2 + 1]); ka->out[0] = 1.0e6f * d / r + 100.f; } }
#endif
#undef IN
#undef SEAM
}

#ifndef MK_N_LAUNCHES
#define MK_N_LAUNCHES 1
#endif

template <int P> static void launch_one(int grid, Args a, hipStream_t stream) {
    static bool attr = false;
    if (!attr) { (void)hipFuncSetAttribute((const void*)mk_fwd<P>, hipFuncAttributeMaxDynamicSharedMemorySize, LDS_BYTES); attr = true; }
    a.ph_lo = (P < 0 || P > 99) ? 0 : P; a.ph_hi = (P < 0) ? N_PHASES : ((P > 99) ? 0 : P + 1); a.use_bar = (P < 0) ? 1 : 0;
    hipLaunchKernelGGL(mk_fwd<P>, dim3(grid), dim3(NTHREADS), LDS_BYTES, stream, a);
}
extern "C" void kernel_launch(void* const* d_in, const int* in_sizes, int n_in, void* d_out, int out_size, void* d_ws, size_t ws_size, hipStream_t stream) {
    static int grid = 0;
    if (grid == 0) {
        if (n_in != 18 || out_size != M * D || ws_size < WS_END) { fprintf(stderr, "kernel_launch: unexpected shapes n_in %d out %d ws %zu\n", n_in, out_size, ws_size); grid = -1; return; }
        int dev = 0, cus = 0;
        (void)hipGetDevice(&dev); (void)hipDeviceGetAttribute(&cus, hipDeviceAttributeMultiprocessorCount, dev);
        grid = cus > 0 ? cus : 256;
    }
    if (grid < 0) return;
    (void)hipMemsetAsync((char*)d_ws + WS_CTL, 0, CTL_ZERO_BYTES, stream);
    Args a{};
    for (int i = 0; i < 18; ++i) a.in[i] = (const float*)d_in[i];
    a.out = (float*)d_out; a.ws = (unsigned char*)d_ws;
#if MK_N_LAUNCHES == 1
    launch_one<-1>(grid, a, stream);
#else
    launch_one<0>(grid, a, stream); launch_one<1>(grid, a, stream);
#if defined(NAIVEMASK) && (NAIVEMASK & 2)
    launch_one<101>(grid, a, stream);
#endif
    launch_one<2>(grid, a, stream); launch_one<3>(grid, a, stream); launch_one<4>(grid, a, stream); launch_one<5>(grid, a, stream);
    launch_one<6>(grid, a, stream); launch_one<7>(grid, a, stream); launch_one<8>(grid, a, stream);
#if defined(NAIVEMASK) && (NAIVEMASK & (1 << 8))
    launch_one<102>(grid, a, stream);
#endif
    launch_one<9>(grid, a, stream); launch_one<10>(grid, a, stream); launch_one<11>(grid, a, stream);
#endif
}
```

```cpp
#include <hip/hip_runtime.h>
#include <cstdio>
#include <cstdint>

#define DBG_A W[5]
#define DBG_B W[2]
constexpr int BATCH = 2, SEQ = 4096, D = 2048, M = BATCH * SEQ, NIN = 11856, FF = 5632;
constexpr int CL = 512, NH = 16, HD = 128, IH = 16, IDM = 64, TOPK = 256, CHUNK = 64;
constexpr int NINP = 12032;
constexpr float EPS = 1e-6f;
constexpr int NTHREADS = 512, NWAVES = 8;

#define LAS __attribute__((address_space(3)))
#define GAS __attribute__((address_space(1)))
typedef unsigned short bf16;
typedef float f32x4 __attribute__((ext_vector_type(4)));
typedef float f32x2 __attribute__((ext_vector_type(2)));
typedef unsigned u32x4 __attribute__((ext_vector_type(4)));
typedef unsigned u32x2 __attribute__((ext_vector_type(2)));

__device__ __forceinline__ float bf2f(bf16 v) { return __uint_as_float(((unsigned)v) << 16); }
__device__ __forceinline__ bf16 f2bf(float f) { unsigned u = __float_as_uint(f); return (bf16)((u + 0x7fffu + ((u >> 16) & 1u)) >> 16); }
__device__ __forceinline__ unsigned pk2(float lo, float hi) { return (unsigned)f2bf(lo) | ((unsigned)f2bf(hi) << 16); }
__device__ __forceinline__ float bflo(unsigned w) { return __uint_as_float(w << 16); }
__device__ __forceinline__ float bfhi(unsigned w) { return __uint_as_float(w & 0xffff0000u); }
__device__ __forceinline__ float wave_sum(float v) {
#pragma unroll
    for (int o = 1; o < 64; o <<= 1) v += __shfl_xor(v, o);
    return v;
}
__device__ __forceinline__ float wave_max(float v) {
#pragma unroll
    for (int o = 1; o < 64; o <<= 1) v = fmaxf(v, __shfl_xor(v, o));
    return v;
}
__device__ __forceinline__ float gelu_tanh(float x) {
    const float u2 = 1.5957691216057308f * (x + 0.044715f * x * x * x);
    return x * __builtin_amdgcn_rcpf(1.f + __expf(-u2));
}
__device__ __forceinline__ float sigmoidf(float x) { return __builtin_amdgcn_rcpf(1.f + __expf(-x)); }

constexpr size_t MiB = 1u << 20;
constexpr size_t WS_CTL = 0, CTL_ZERO_BYTES = 64 * 1024;
constexpr size_t WS_VST = 1 * MiB;
constexpr size_t WS_HST = 3 * MiB;
constexpr size_t WS_WI = 4 * MiB;
constexpr size_t WS_KI = 5 * MiB;
constexpr size_t WS_SEL = 6 * MiB;
constexpr size_t WS_CN = 14 * MiB;
constexpr size_t WS_CKR = 22 * MiB;
constexpr size_t WS_QI = 38 * MiB;
constexpr size_t WS_WUK = 54 * MiB;
constexpr size_t WS_WUV = 56 * MiB;
constexpr size_t WS_WOA = 60 * MiB;
constexpr size_t WS_WOB = 68 * MiB;
constexpr size_t WS_WOUT = 76 * MiB;
constexpr size_t WS_WIN = 86 * MiB;
constexpr size_t WS_XN = 133 * MiB;
constexpr size_t WS_SC = 101 * MiB;
constexpr size_t WS_QL = 102 * MiB;
constexpr size_t WS_U = 166 * MiB;
constexpr size_t WS_V = 198 * MiB;
constexpr size_t WS_Q = 230 * MiB;
constexpr size_t WS_GA = 262 * MiB;
constexpr size_t WS_GB = 294 * MiB;
constexpr size_t WS_WGU = 86 * MiB;
constexpr size_t WS_WD = 130 * MiB;
constexpr size_t WS_HB = 152 * MiB;
constexpr size_t WS_FF = 230 * MiB;
constexpr size_t WS_END = 326 * MiB;

constexpr int RING_BYTES = 131072;
constexpr int LDS_BYTES = 163840;
constexpr int LDSCTL_OFF = LDS_BYTES - 512, MISC_OFF = LDSCTL_OFF + 320;
constexpr size_t SC_PER_BATCH = 8519680;

__device__ __forceinline__ size_t sc_off(int b, int pos) {
    const int c = pos >> 6, r = pos & 63;
    return (size_t)b * SC_PER_BATCH + (size_t)2048 * c * (c + 1) + (size_t)r * 64 * (c + 1);
}
namespace pg8 {
#define PG8_LAS __attribute__((address_space(3)))
typedef unsigned short bf16_t;
typedef short bf16x8 __attribute__((ext_vector_type(8)));
typedef float f32x4 __attribute__((ext_vector_type(4)));
typedef unsigned u32x4 __attribute__((ext_vector_type(4)));
constexpr int BM = 256, BK = 64, HALF = 128, HTB = HALF * BK * 2  , STAGE_BYTES = 8 * HTB, NXCD = 8, WGM = 8;

__host__ __device__ __forceinline__ int lds_byte(int r, int c) { const int st = (r >> 4) * 2 + (c >> 5), rr = r & 15, cc = c & 31, ob = rr * 64 + cc * 2; return st * 1024 + (ob ^ (((ob >> 9) & 1) << 5)); }
__host__ __device__ __forceinline__ void stage_rc(int b, int& R, int& C) { const int st = b / 1024, sb = b % 1024, swz = sb ^ (((sb >> 9) & 1) << 5); R = (st >> 1) * 16 + swz / 64; C = (st & 1) * 32 + (swz % 64) / 2; }
__host__ __device__ __forceinline__ int perm32(int rho) { const int n = rho >> 4, i = rho & 15; return 8 * (i >> 2) + 4 * n + (i & 3); }

struct Unit { int pm, pn, h; };
struct Gemm { const bf16_t* A; const bf16_t* Bt; int lda, ldb, K; };

struct StaticOrder {
    int nM, nN, nwg, G, c;
    __host__ __device__ void init(int M_, int N_, int G_, int c_) { nM = M_ / BM; nN = N_ / BM; nwg = nM * nN; G = G_; c = c_; }
    __host__ __device__ bool next(int i, Unit& u) const {
        const long L = (long)i * G + c; if (L >= nwg) return false;
        int wgid = (int)L; { const int q = nwg / NXCD, r = nwg % NXCD, xcd = wgid % NXCD, off = wgid / NXCD; wgid = (xcd < r ? xcd * (q + 1) : r * (q + 1) + (xcd - r) * q) + off; }
        const int nig = WGM * nN, gid = wgid / nig, fm = gid * WGM, gsz = (nM - fm) < WGM ? (nM - fm) : WGM;
        u.pm = fm + ((wgid % nig) % gsz); u.pn = (wgid % nig) / gsz; u.h = 0; return true;
    }
    __device__ __forceinline__ void ptrs(const Unit& u, const Gemm& g, const char*& a, const char*& b) const {
        a = (const char*)g.A + (size_t)u.pm * BM * g.lda * 2; b = (const char*)g.Bt + (size_t)u.pn * BM * g.ldb * 2; }
    __device__ __forceinline__ void a_ready(const Unit&) const {}
    __device__ __forceinline__ void done(const Unit&) const {}
};
struct HeadOrderQ {
    int G, c;
    __device__ bool next(int i, Unit& u) const { const int L = i * G + c; if (L >= 1024) return false; u.h = L >> 6; u.pn = (L >> 5) & 1; u.pm = L & 31; return true; }
    __device__ __forceinline__ void ptrs(const Unit& u, const Gemm& g, const char*& a, const char*& b) const {
        a = (const char*)g.A + ((size_t)u.pm * BM * g.lda + u.h * 128) * 2; b = (const char*)g.Bt + (size_t)(u.h * 512 + u.pn * BM) * g.ldb * 2; }
    __device__ __forceinline__ void a_ready(const Unit&) const {}
    __device__ __forceinline__ void done(const Unit&) const {}
};
struct PairOrderYB {
    int G, c;
    __device__ bool next(int i, Unit& u) const { const int L = i * G + c; if (L >= 256) return false; u.h = 0; u.pn = L >> 5; u.pm = L & 31; return true; }
    __device__ __forceinline__ void ptrs(const Unit& u, const Gemm& g, const char*& a, const char*& b) const {
        a = (const char*)g.A + ((size_t)u.pm * BM * g.lda + u.pn * 1024) * 2; b = (const char*)g.Bt + (size_t)(u.pn * BM) * g.ldb * 2; }
    __device__ __forceinline__ void a_ready(const Unit&) const {}
    __device__ __forceinline__ void done(const Unit&) const {}
};

typedef __bf16 bf16x2_t __attribute__((ext_vector_type(2)));
typedef float f32x2c __attribute__((ext_vector_type(2)));
__device__ __forceinline__ unsigned cvt_pk_bf16(float lo, float hi) { const f32x2c v = {lo, hi}; const bf16x2_t b = __builtin_convertvector(v, bf16x2_t); return __builtin_bit_cast(unsigned, b); }
__device__ __forceinline__ u32x4 pack8(const f32x4 v0, const f32x4 v1) { u32x4 w; w.x = cvt_pk_bf16(v0[0], v0[1]); w.y = cvt_pk_bf16(v0[2], v0[3]); w.z = cvt_pk_bf16(v1[0], v1[1]); w.w = cvt_pk_bf16(v1[2], v1[3]); return w; }
__device__ __forceinline__ float gelu1(float x) { const float u2 = 1.5957691216057308f * (x + 0.044715f * x * x * x); return x * __builtin_amdgcn_rcpf(1.f + __expf(-u2)); }
__device__ __forceinline__ float sigm1(float x) { return __builtin_amdgcn_rcpf(1.f + __expf(-x)); }
template <int ACT> __device__ __forceinline__ f32x4 act4(f32x4 v) {
    if (ACT == 1) { v[0] = gelu1(v[0]); v[1] = gelu1(v[1]); v[2] = gelu1(v[2]); v[3] = gelu1(v[3]); }
    if (ACT == 2) { v[0] = sigm1(v[0]); v[1] = sigm1(v[1]); v[2] = sigm1(v[2]); v[3] = sigm1(v[3]); }
    return v;
}
template <int ACT> __device__ __forceinline__ void store_tile_bf16(const f32x4 (&acc)[2][2][4][2], bf16_t* base, int ld, int row0) {
#pragma unroll
    for (int ai = 0; ai < 2; ++ai)
#pragma unroll
        for (int m = 0; m < 4; ++m) { bf16_t* rowp = base + (size_t)(row0 + ai * HALF + m * 16) * ld;
#pragma unroll
            for (int bj = 0; bj < 2; ++bj) *(u32x4*)(rowp + bj * HALF) = pack8(act4<ACT>(acc[ai][bj][m][0]), act4<ACT>(acc[ai][bj][m][1])); }
}

struct EpiProjF {
    static constexpr bool PERM = true, AFTER_DRAIN = false;
    unsigned char* ws;
    __device__ __forceinline__ void operator()(const f32x4 (&acc)[2][2][4][2], const Unit& u, int wr, int wc, int fr, int fq) const {
        const int pn = u.pn, row0 = u.pm * BM + wr * 64 + fr, c8 = wc * 32 + 8 * fq;
        if (pn < 8) store_tile_bf16<1>(acc, (bf16_t*)(ws + WS_U) + pn * 256 + c8, 2048, row0);
        else if (pn < 16) {
            bf16_t* base = (bf16_t*)(ws + WS_V) + (pn - 8) * 256 + c8; float* VST = (float*)(ws + WS_VST);
#pragma unroll
            for (int ai = 0; ai < 2; ++ai)
#pragma unroll
                for (int m = 0; m < 4; ++m) { const int row = row0 + ai * HALF + m * 16; float s = 0.f, q = 0.f;
#pragma unroll
                    for (int bj = 0; bj < 2; ++bj) { const f32x4 v0 = act4<1>(acc[ai][bj][m][0]), v1 = act4<1>(acc[ai][bj][m][1]);
                        s += (v0[0] + v0[1]) + (v0[2] + v0[3]) + (v1[0] + v1[1]) + (v1[2] + v1[3]);
                        q += (v0[0] * v0[0] + v0[1] * v0[1]) + (v0[2] * v0[2] + v0[3] * v0[3]) + (v1[0] * v1[0] + v1[1] * v1[1]) + (v1[2] * v1[2] + v1[3] * v1[3]);
                        *(u32x4*)(base + (size_t)row * 2048 + bj * HALF) = pack8(v0, v1); }
                    s += __shfl_xor(s, 16); s += __shfl_xor(s, 32); q += __shfl_xor(q, 16); q += __shfl_xor(q, 32);
                    if (fq == 0) *(f32x2*)(VST + ((size_t)row * 32 + (pn - 8) * 4 + wc) * 2) = (f32x2){s, q};
                    asm volatile("" ::: "memory"); }
        }
        else if (pn < 24) store_tile_bf16<0>(acc, (bf16_t*)(ws + WS_Q) + (pn - 16) * 256 + c8, 2048, row0);
        else if (pn < 26) {
            float* base = (float*)(ws + WS_CKR) + (pn - 24) * 256 + c8;
#pragma unroll
            for (int ai = 0; ai < 2; ++ai)
#pragma unroll
                for (int m = 0; m < 4; ++m) { float* rowp = base + (size_t)(row0 + ai * HALF + m * 16) * 512;
#pragma unroll
                    for (int bj = 0; bj < 2; ++bj) { *(f32x4*)(rowp + bj * HALF) = acc[ai][bj][m][0]; *(f32x4*)(rowp + bj * HALF + 4) = acc[ai][bj][m][1]; } }
        }
        else if (pn < 30) store_tile_bf16<0>(acc, (bf16_t*)(ws + WS_QI) + (pn - 26) * 256 + c8, 1024, row0);
        else if (pn == 30) {
            bf16_t* KI = (bf16_t*)(ws + WS_KI); float* WI = (float*)(ws + WS_WI);
#pragma unroll
            for (int ai = 0; ai < 2; ++ai)
#pragma unroll
                for (int m = 0; m < 4; ++m) { const size_t row = row0 + ai * HALF + m * 16;
                    if (c8 < 64) *(u32x4*)(KI + row * 64 + c8) = pack8(acc[ai][0][m][0], acc[ai][0][m][1]);
                    else if (c8 < 80) { *(f32x4*)(WI + row * 16 + (c8 - 64)) = acc[ai][0][m][0]; *(f32x4*)(WI + row * 16 + (c8 - 64) + 4) = acc[ai][0][m][1]; } }
        }
        else store_tile_bf16<2>(acc, (bf16_t*)(ws + WS_GA) + (size_t)(pn >= 39 ? (WS_GB - WS_GA) / 2 : 0) + ((pn - 31) & 7) * 256 + c8, 2048, row0);
    }
};
struct EpiQlatF {
    static constexpr bool PERM = true, AFTER_DRAIN = false;
    bf16_t* QL;
    __device__ __forceinline__ void operator()(const f32x4 (&acc)[2][2][4][2], const Unit& u, int wr, int wc, int fr, int fq) const {
        store_tile_bf16<0>(acc, QL + u.h * 512 + u.pn * 256 + wc * 32 + 8 * fq, 8192, u.pm * BM + wr * 64 + fr); }
};
struct EpiPlainF {
    static constexpr bool PERM = true, AFTER_DRAIN = false;
    bf16_t* O; int ld;
    __device__ __forceinline__ void operator()(const f32x4 (&acc)[2][2][4][2], const Unit& u, int wr, int wc, int fr, int fq) const {
        store_tile_bf16<0>(acc, O + u.pn * 256 + wc * 32 + 8 * fq, ld, u.pm * BM + wr * 64 + fr); }
};
__device__ __forceinline__ float blo(unsigned w) { return __uint_as_float(w << 16); }
__device__ __forceinline__ float bhi(unsigned w) { return __uint_as_float(w & 0xffff0000u); }
struct EpiGateAF {
    static constexpr bool PERM = true, AFTER_DRAIN = false;
    bf16_t* GA; bool dry;
    __device__ __forceinline__ void operator()(const f32x4 (&acc)[2][2][4][2], const Unit& u, int wr, int wc, int fr, int fq) const {
        bf16_t* base = GA + u.pn * 256 + wc * 32 + 8 * fq; const int row0 = u.pm * BM + wr * 64 + fr;
#pragma unroll
        for (int ai = 0; ai < 2; ++ai)
#pragma unroll
            for (int m = 0; m < 4; ++m) { bf16_t* rowp = base + (size_t)(row0 + ai * HALF + m * 16) * 2048;
#pragma unroll
                for (int bj = 0; bj < 2; ++bj) { const u32x4 g = *(const u32x4*)(rowp + bj * HALF); const f32x4 v0 = acc[ai][bj][m][0], v1 = acc[ai][bj][m][1];
                    const f32x4 o0 = {blo(g.x) * v0[0], bhi(g.x) * v0[1], blo(g.y) * v0[2], bhi(g.y) * v0[3]}, o1 = {blo(g.z) * v1[0], bhi(g.z) * v1[1], blo(g.w) * v1[2], bhi(g.w) * v1[3]};
                    if (!dry) *(u32x4*)(rowp + bj * HALF) = pack8(o0, o1); } }
    }
};
struct EpiGateBF {
    static constexpr bool PERM = true, AFTER_DRAIN = false;
    bf16_t* TMP; const bf16_t* GB; bool dry;
    __device__ __forceinline__ void operator()(const f32x4 (&acc)[2][2][4][2], const Unit& u, int wr, int wc, int fr, int fq) const {
        const int coff = u.pn * 256 + wc * 32 + 8 * fq, row0 = u.pm * BM + wr * 64 + fr;
#pragma unroll
        for (int ai = 0; ai < 2; ++ai)
#pragma unroll
            for (int m = 0; m < 4; ++m) { const size_t ro = (size_t)(row0 + ai * HALF + m * 16) * 2048 + coff;
#pragma unroll
                for (int bj = 0; bj < 2; ++bj) { const u32x4 g = *(const u32x4*)(GB + ro + bj * HALF), t = *(const u32x4*)(TMP + ro + bj * HALF); const f32x4 v0 = acc[ai][bj][m][0], v1 = acc[ai][bj][m][1];
                    const f32x4 o0 = {blo(t.x) + blo(g.x) * v0[0], bhi(t.x) + bhi(g.x) * v0[1], blo(t.y) + blo(g.y) * v0[2], bhi(t.y) + bhi(g.y) * v0[3]};
                    const f32x4 o1 = {blo(t.z) + blo(g.z) * v1[0], bhi(t.z) + bhi(g.z) * v1[1], blo(t.w) + blo(g.w) * v1[2], bhi(t.w) + bhi(g.w) * v1[3]};
                    if (!dry) *(u32x4*)(TMP + ro + bj * HALF) = pack8(o0, o1); } }
    }
};
struct EpiResF {
    static constexpr bool PERM = true, AFTER_DRAIN = false;
    const float* X; float* H; bf16_t* HB; float* HST;
    __device__ __forceinline__ void operator()(const f32x4 (&acc)[2][2][4][2], const Unit& u, int wr, int wc, int fr, int fq) const {
        const int coff = u.pn * 256 + wc * 32 + 8 * fq, row0 = u.pm * BM + wr * 64 + fr;
#pragma unroll
        for (int ai = 0; ai < 2; ++ai)
#pragma unroll
            for (int m = 0; m < 4; ++m) { const int row = row0 + ai * HALF + m * 16; const size_t ro = (size_t)row * 2048 + coff; float q = 0.f;
#pragma unroll
                for (int bj = 0; bj < 2; ++bj) { const f32x4 x0 = *(const f32x4*)(X + ro + bj * HALF), x1 = *(const f32x4*)(X + ro + bj * HALF + 4);
                    const f32x4 h0 = x0 + acc[ai][bj][m][0], h1 = x1 + acc[ai][bj][m][1];
                    *(f32x4*)(H + ro + bj * HALF) = h0; *(f32x4*)(H + ro + bj * HALF + 4) = h1; *(u32x4*)(HB + ro + bj * HALF) = pack8(h0, h1);
                    q += (h0[0] * h0[0] + h0[1] * h0[1]) + (h0[2] * h0[2] + h0[3] * h0[3]) + (h1[0] * h1[0] + h1[1] * h1[1]) + (h1[2] * h1[2] + h1[3] * h1[3]); }
                q += __shfl_xor(q, 16); q += __shfl_xor(q, 32);
                if (fq == 0) HST[(size_t)row * 32 + u.pn * 4 + wc] = q; }
    }
};
struct EpiSwigluF {
    static constexpr bool PERM = true, AFTER_DRAIN = false;
    const float* HST; bf16_t* FFo;
    __device__ __forceinline__ void operator()(const f32x4 (&acc)[2][2][4][2], const Unit& u, int wr, int wc, int fr, int fq) const {
        const int coff = u.pn * 128 + wc * 32 + 8 * fq, row0 = u.pm * BM + wr * 64 + fr;
#pragma unroll
        for (int ai = 0; ai < 2; ++ai)
#pragma unroll
            for (int m = 0; m < 4; ++m) { const int row = row0 + ai * HALF + m * 16; const f32x4* hp = (const f32x4*)(HST + (size_t)row * 32);
                f32x4 sv = hp[0];
#pragma unroll
                for (int j = 1; j < 8; ++j) sv = sv + hp[j];
                const float rs = rsqrtf(((sv[0] + sv[1]) + (sv[2] + sv[3])) * (1.f / 2048.f) + 1e-6f);
                f32x4 o0, o1;
#pragma unroll
                for (int e = 0; e < 4; ++e) { const float g0 = acc[ai][0][m][0][e] * rs, u0 = acc[ai][1][m][0][e] * rs, g1 = acc[ai][0][m][1][e] * rs, u1 = acc[ai][1][m][1][e] * rs;
                    o0[e] = g0 * sigm1(g0) * u0; o1[e] = g1 * sigm1(g1) * u1; }
                *(u32x4*)(FFo + (size_t)row * 5632 + coff) = pack8(o0, o1); }
    }
};
struct EpiRes2F {
    static constexpr bool PERM = true, AFTER_DRAIN = false;
    float* H; bool dry;
    __device__ __forceinline__ void operator()(const f32x4 (&acc)[2][2][4][2], const Unit& u, int wr, int wc, int fr, int fq) const {
        const int coff = u.pn * 256 + wc * 32 + 8 * fq, row0 = u.pm * BM + wr * 64 + fr;
#pragma unroll
        for (int ai = 0; ai < 2; ++ai)
#pragma unroll
            for (int m = 0; m < 4; ++m) { float* rp = H + (size_t)(row0 + ai * HALF + m * 16) * 2048 + coff;
#pragma unroll
                for (int bj = 0; bj < 2; ++bj) { const f32x4 h0 = *(const f32x4*)(rp + bj * HALF) + acc[ai][bj][m][0], h1 = *(const f32x4*)(rp + bj * HALF + 4) + acc[ai][bj][m][1];
                    if (!dry) { *(f32x4*)(rp + bj * HALF) = h0; *(f32x4*)(rp + bj * HALF + 4) = h1; } } }
    }
};

template <class Epi, class Sched, bool ALIGN_EPI = true, bool SP2 = true>
__device__ __forceinline__ void gemm_phase(PG8_LAS unsigned char* lds, const Gemm g, const Sched& S, const Epi& E) {
    const int tid = threadIdx.x, wid = __builtin_amdgcn_readfirstlane(tid >> 6), lane = tid & 63, wr = wid >> 2, wc = wid & 3, fr = lane & 15, fq = lane >> 4;
    const int K = g.K, nt = K / BK;
    unsigned voffA[2], voffB[2];
#pragma unroll
    for (int i = 0; i < 2; ++i) { int R, C; stage_rc(tid * 16 + i * 8192, R, C); const int Rb = Epi::PERM ? ((R & ~31) + perm32(R & 31)) : R;
        voffA[i] = (unsigned)(R * g.lda + C) * 2u; voffB[i] = (unsigned)(Rb * g.ldb + C) * 2u; }
    const size_t kstep = (size_t)(BK * 2);
    const size_t hsA = (size_t)HALF * g.lda * 2, hsB = (size_t)HALF * g.ldb * 2;
    const unsigned ldsw = (unsigned)wid * 1024u;
    const int aoff = lds_byte(wr * 64 + fr, fq * 8), boff = lds_byte(wc * 32 + fr, fq * 8);
#define PG8_SA(b, h) (((b) * 2 + (h)) * HTB)
#define PG8_SB(b, h) ((4 + (b) * 2 + (h)) * HTB)
#define PG8_STAGE(bufoff, gbase, voff) do { _Pragma("unroll") for (int _i = 0; _i < 2; ++_i) \
        __builtin_amdgcn_global_load_lds((const unsigned*)((const char*)(gbase) + (voff)[_i]), (PG8_LAS unsigned*)(lds + (bufoff) + ldsw + _i * 8192), 16, 0, 0); } while (0)
#define PG8_LDA(dst, b, h) do { _Pragma("unroll") for (int m = 0; m < 4; ++m) _Pragma("unroll") for (int k = 0; k < 2; ++k) dst[m][k] = *(const PG8_LAS bf16x8*)(lds + PG8_SA(b, h) + aoff + m * 2048 + k * 1024); } while (0)
#define PG8_LDB(dst, b, h) do { _Pragma("unroll") for (int n = 0; n < 2; ++n) _Pragma("unroll") for (int k = 0; k < 2; ++k) dst[n][k] = *(const PG8_LAS bf16x8*)(lds + PG8_SB(b, h) + boff + n * 2048 + k * 1024); } while (0)
#define PG8_MMA(ai, bj, At, Bt) do { __builtin_amdgcn_s_setprio(1); _Pragma("unroll") for (int m = 0; m < 4; ++m) _Pragma("unroll") for (int n = 0; n < 2; ++n) _Pragma("unroll") for (int k = 0; k < 2; ++k) \
        acc[ai][bj][m][n] = __builtin_amdgcn_mfma_f32_16x16x32_bf16(Bt[n][k], At[m][k], acc[ai][bj][m][n], 0, 0, 0); __builtin_amdgcn_s_setprio(0); } while (0)
#define PG8_WAIT_V(n) asm volatile("s_waitcnt vmcnt(" #n ")" ::: "memory")
#define PG8_WAIT_L(n) asm volatile("s_waitcnt lgkmcnt(" #n ")" ::: "memory")
#define PG8_BAR __builtin_amdgcn_s_barrier()
#define PG8_SCHED __builtin_amdgcn_sched_barrier(0)
    Unit cur, nxt; int ui = 0;
    if (!S.next(0, cur)) return;
    f32x4 acc[2][2][4][2];
#pragma unroll
    for (int a = 0; a < 2; ++a)
#pragma unroll
        for (int b = 0; b < 2; ++b)
#pragma unroll
            for (int m = 0; m < 4; ++m)
#pragma unroll
                for (int n = 0; n < 2; ++n) acc[a][b][m][n] = (f32x4){0.f, 0.f, 0.f, 0.f};
    bf16x8 At[4][2], B0[2][2], B1[2][2];
    const char* cA; const char* cB; S.ptrs(cur, g, cA, cB);
    S.a_ready(cur);
    if constexpr (SP2) {
        PG8_STAGE(PG8_SB(0, 0), cB, voffB); PG8_STAGE(PG8_SB(0, 1), cB + hsB, voffB); PG8_STAGE(PG8_SA(0, 0), cA, voffA); PG8_STAGE(PG8_SA(0, 1), cA + hsA, voffA);
        if (wr == 1) PG8_BAR;
        PG8_WAIT_V(2); PG8_BAR;
        PG8_STAGE(PG8_SB(1, 0), cB + kstep, voffB); PG8_STAGE(PG8_SA(1, 0), cA + kstep, voffA); PG8_STAGE(PG8_SB(1, 1), cB + hsB + kstep, voffB);
        PG8_WAIT_V(6); PG8_BAR;
    } else {
        PG8_STAGE(PG8_SB(0, 0), cB, voffB); PG8_STAGE(PG8_SA(0, 0), cA, voffA); PG8_STAGE(PG8_SB(0, 1), cB + hsB, voffB); PG8_STAGE(PG8_SA(0, 1), cA + hsA, voffA);
        if (wr == 1) PG8_BAR;
        PG8_WAIT_V(4); PG8_BAR;
        PG8_STAGE(PG8_SB(1, 0), cB + kstep, voffB); PG8_STAGE(PG8_SA(1, 0), cA + kstep, voffA); PG8_STAGE(PG8_SB(1, 1), cB + hsB + kstep, voffB);
        PG8_WAIT_V(6); PG8_BAR;
    }
    for (;;) {
        const bool has_next = S.next(ui + 1, nxt);
        const char* nA = cA; const char* nB = cB; if (has_next) S.ptrs(nxt, g, nA, nB);
        for (int t = 0; t < nt; t += 2) {
            const bool last = (t == nt - 2);
            const char* a1 = cA + (size_t)(t + 1) * kstep;
            const char* a2 = last ? nA : cA + (size_t)(t + 2) * kstep; const char* b2 = last ? nB : cB + (size_t)(t + 2) * kstep;
            const char* a3 = a2 + kstep; const char* b3 = b2 + kstep;
            if (last && has_next) S.a_ready(nxt);
            if constexpr (SP2) {
            PG8_LDB(B0, 0, 0); PG8_LDB(B1, 0, 1); PG8_SCHED; PG8_LDA(At, 0, 0); PG8_STAGE(PG8_SA(1, 1), a1 + hsA, voffA);
            PG8_WAIT_V(8); PG8_WAIT_L(0); PG8_BAR; PG8_MMA(0, 0, At, B0); PG8_MMA(0, 1, At, B1); PG8_BAR; PG8_SCHED;
            PG8_LDA(At, 0, 1); PG8_STAGE(PG8_SB(0, 0), b2, voffB); PG8_STAGE(PG8_SB(0, 1), b2 + hsB, voffB); PG8_STAGE(PG8_SA(0, 0), a2, voffA);
            PG8_WAIT_V(8); PG8_WAIT_L(0); PG8_BAR; PG8_MMA(1, 0, At, B0); PG8_MMA(1, 1, At, B1); PG8_BAR; PG8_SCHED;
            PG8_LDB(B0, 1, 0); PG8_LDB(B1, 1, 1); PG8_SCHED; PG8_LDA(At, 1, 0); PG8_STAGE(PG8_SA(0, 1), a2 + hsA, voffA);
            PG8_WAIT_V(8); PG8_WAIT_L(0); PG8_BAR; PG8_MMA(0, 0, At, B0); PG8_MMA(0, 1, At, B1); PG8_BAR; PG8_SCHED;
            PG8_LDA(At, 1, 1); PG8_STAGE(PG8_SB(1, 0), b3, voffB); PG8_STAGE(PG8_SB(1, 1), b3 + hsB, voffB); PG8_STAGE(PG8_SA(1, 0), a3, voffA);
            PG8_WAIT_V(8); PG8_WAIT_L(0); PG8_BAR; PG8_MMA(1, 0, At, B0); PG8_MMA(1, 1, At, B1); PG8_BAR; PG8_SCHED;
            } else {
            PG8_LDB(B0, 0, 0); PG8_SCHED; PG8_LDA(At, 0, 0); PG8_STAGE(PG8_SA(1, 1), a1 + hsA, voffA);
            PG8_WAIT_L(8); PG8_BAR; PG8_WAIT_L(0); PG8_MMA(0, 0, At, B0); PG8_BAR; PG8_SCHED;
            PG8_LDB(B1, 0, 1); PG8_STAGE(PG8_SB(0, 0), b2, voffB);
            PG8_BAR; PG8_WAIT_L(0); PG8_MMA(0, 1, At, B1); PG8_BAR;
            PG8_LDA(At, 0, 1); PG8_STAGE(PG8_SA(0, 0), a2, voffA);
            PG8_BAR; PG8_WAIT_L(0); PG8_MMA(1, 0, At, B0); PG8_BAR; PG8_SCHED;
            PG8_STAGE(PG8_SB(0, 1), b2 + hsB, voffB);
            PG8_WAIT_V(6); PG8_BAR; PG8_MMA(1, 1, At, B1); PG8_BAR;
            PG8_LDB(B0, 1, 0); PG8_SCHED; PG8_LDA(At, 1, 0); PG8_STAGE(PG8_SA(0, 1), a2 + hsA, voffA);
            PG8_WAIT_L(8); PG8_BAR; PG8_WAIT_L(0); PG8_MMA(0, 0, At, B0); PG8_BAR; PG8_SCHED;
            PG8_LDB(B1, 1, 1); PG8_STAGE(PG8_SB(1, 0), b3, voffB);
            PG8_BAR; PG8_WAIT_L(0); PG8_MMA(0, 1, At, B1); PG8_BAR;
            PG8_LDA(At, 1, 1); PG8_STAGE(PG8_SA(1, 0), a3, voffA);
            PG8_BAR; PG8_WAIT_L(0); PG8_MMA(1, 0, At, B0); PG8_BAR; PG8_SCHED;
            PG8_STAGE(PG8_SB(1, 1), b3 + hsB, voffB);
            PG8_WAIT_V(6); PG8_BAR; PG8_MMA(1, 1, At, B1); PG8_BAR;
            }
        }
        if constexpr (ALIGN_EPI) { if (wr == 0) PG8_BAR; }
        if constexpr (!Epi::AFTER_DRAIN) { E(acc, cur, wr, wc, fr, fq); S.done(cur); }
        if (!has_next) break;
#pragma unroll
        for (int a = 0; a < 2; ++a)
#pragma unroll
            for (int b = 0; b < 2; ++b)
#pragma unroll
                for (int m = 0; m < 4; ++m)
#pragma unroll
                    for (int n = 0; n < 2; ++n) acc[a][b][m][n] = (f32x4){0.f, 0.f, 0.f, 0.f};
        cur = nxt; cA = nA; cB = nB; ++ui;
        if constexpr (ALIGN_EPI) { if (wr == 1) PG8_BAR; }
    }
    PG8_WAIT_V(0);
    if constexpr (!ALIGN_EPI) { if (wr == 0) PG8_BAR; }
    PG8_BAR;
    if constexpr (Epi::AFTER_DRAIN) { E.fused(acc, cur, wr, wc, fr, fq, lds, wid, lane); S.done(cur); }
#undef PG8_SA
#undef PG8_SB
#undef PG8_STAGE
#undef PG8_LDA
#undef PG8_LDB
#undef PG8_MMA
#undef PG8_WAIT_V
#undef PG8_WAIT_L
#undef PG8_BAR
#undef PG8_SCHED
}
}

__device__ __forceinline__ void rows_xn(const float* x, const float* g, bf16* XN, int gw, int ngw, int lane) {
    for (int m = gw; m < M; m += ngw) {
        const f32x4* xr = (const f32x4*)(x + (size_t)m * D) + lane;
        f32x4 v[8]; float s = 0.f;
#pragma unroll
        for (int j = 0; j < 8; ++j) { v[j] = xr[64 * j]; s += v[j].x * v[j].x + v[j].y * v[j].y + v[j].z * v[j].z + v[j].w * v[j].w; }
        const float rs = rsqrtf(wave_sum(s) * (1.f / D) + EPS);
        u32x2* o = (u32x2*)(XN + (size_t)m * D) + lane;
#pragma unroll
        for (int j = 0; j < 8; ++j) {
            const f32x4 gg = ((const f32x4*)g)[lane + 64 * j];
            u32x2 w; w.x = (unsigned)f2bf(v[j].x * rs * gg.x) | ((unsigned)f2bf(v[j].y * rs * gg.y) << 16);
            w.y = (unsigned)f2bf(v[j].z * rs * gg.z) | ((unsigned)f2bf(v[j].w * rs * gg.w) << 16);
            o[64 * j] = w;
        }
    }
}
__device__ __forceinline__ void rows_cn(const float* CKR, const float* g, bf16* CN, int gw, int ngw, int lane) {
    for (int m = gw; m < M; m += ngw) {
        const f32x4* xr = (const f32x4*)(CKR + (size_t)m * CL) + lane;
        f32x4 v[2]; float s = 0.f;
#pragma unroll
        for (int j = 0; j < 2; ++j) { v[j] = xr[64 * j]; s += v[j].x * v[j].x + v[j].y * v[j].y + v[j].z * v[j].z + v[j].w * v[j].w; }
        const float rs = rsqrtf(wave_sum(s) * (1.f / CL) + EPS);
        u32x2* o = (u32x2*)(CN + (size_t)m * CL) + lane;
#pragma unroll
        for (int j = 0; j < 2; ++j) {
            const f32x4 gg = ((const f32x4*)g)[lane + 64 * j];
            u32x2 w; w.x = (unsigned)f2bf(v[j].x * rs * gg.x) | ((unsigned)f2bf(v[j].y * rs * gg.y) << 16);
            w.y = (unsigned)f2bf(v[j].z * rs * gg.z) | ((unsigned)f2bf(v[j].w * rs * gg.w) << 16);
            o[64 * j] = w;
        }
    }
}
__device__ __forceinline__ void rows_final(float* H, const float* g, int gw, int ngw, int lane, bool dry = false) {
    for (int m = gw; m < M; m += ngw) {
        f32x4* xr = (f32x4*)(H + (size_t)m * D) + lane;
        f32x4 v[8]; float s = 0.f;
#pragma unroll
        for (int j = 0; j < 8; ++j) { v[j] = xr[64 * j]; s += v[j].x * v[j].x + v[j].y * v[j].y + v[j].z * v[j].z + v[j].w * v[j].w; }
        const float rs = rsqrtf(wave_sum(s) * (1.f / D) + EPS);
#pragma unroll
        for (int j = 0; j < 8; ++j) { const f32x4 gg = ((const f32x4*)g)[lane + 64 * j]; if (!dry) xr[64 * j] = v[j] * rs * gg; }
    }
}

__device__ __forceinline__ void naive_gating(float* lds, bf16* U, const bf16* V, const float* VST, const float* ln_g, const float* ln_b,
                                             const float* w_s, const float* b_s, int vb, int nb) {
    float* Wt = lds; float* vn = lds + 128 * 128; float* mr = vn + 128 * 64;
    const int tid = threadIdx.x;
    for (int unit = vb; unit < 2 * 32 * 8 * 4; unit += nb) {
        const int cq = unit & 3, g = (unit >> 2) & 7, n = (unit >> 5) & 31, b = unit >> 10;
        const int row0 = b * SEQ + n * 128, ch0 = g * 256 + cq * 64;
        __syncthreads();
        if (tid < 128) {
            float s = 0.f, q = 0.f;
            for (int j = 0; j < 32; ++j) { s += VST[((size_t)(row0 + tid) * 32 + j) * 2]; q += VST[((size_t)(row0 + tid) * 32 + j) * 2 + 1]; }
            const float mean = s * (1.f / D); const float var = q * (1.f / D) - mean * mean;
            mr[tid * 2] = mean; mr[tid * 2 + 1] = rsqrtf(fmaxf(var, 0.f) + EPS);
        }
        for (int i = tid; i < 128 * 128; i += NTHREADS) { const int p = i >> 7, q = i & 127; Wt[q * 128 + p] = ((q >> 6) <= (p >> 6)) ? w_s[(size_t)g * 16384 + p * 128 + q] : 0.f; }
        __syncthreads();
        for (int i = tid; i < 128 * 64; i += NTHREADS) { const int q = i >> 6, c = i & 63;
            vn[i] = (bf2f(V[(size_t)(row0 + q) * D + ch0 + c]) - mr[q * 2]) * mr[q * 2 + 1] * ln_g[ch0 + c] + ln_b[ch0 + c]; }
        __syncthreads();
        const int c = tid & 63, pg = tid >> 6;
        float acc[16];
#pragma unroll
        for (int i = 0; i < 16; ++i) acc[i] = 0.f;
        for (int q = 0; q < 128; ++q) {
            const float x = vn[q * 64 + c];
#pragma unroll
            for (int i4 = 0; i4 < 4; ++i4) { const f32x4 w = *(const f32x4*)(Wt + q * 128 + pg * 16 + i4 * 4);
                acc[i4 * 4 + 0] += w.x * x; acc[i4 * 4 + 1] += w.y * x; acc[i4 * 4 + 2] += w.z * x; acc[i4 * 4 + 3] += w.w * x; }
        }
#pragma unroll
        for (int i = 0; i < 16; ++i) { const int p = pg * 16 + i; const size_t idx = (size_t)(row0 + p) * D + ch0 + c;
            U[idx] = f2bf(bf2f(U[idx]) * (acc[i] + b_s[g * 128 + p])); }
    }
}

__device__ __forceinline__ void naive_scores(float* lds, const bf16* QI, const bf16* KI, const float* WI, float* SC, int vb, int nb) {
    float* qs = lds;
    float* ws = lds + 1024;
    const int tid = threadIdx.x;
    for (int t = vb; t < M; t += nb) {
        const int b = t / SEQ, pos = t % SEQ, nadm = ((pos >> 6) + 1) * 64;
        __syncthreads();
        for (int i = tid; i < 1024; i += NTHREADS) qs[i] = bf2f(QI[(size_t)t * 1024 + i]);
        if (tid < 16) ws[tid] = WI[(size_t)t * 16 + tid] * 0.25f;
        __syncthreads();
        float* out = SC + sc_off(b, pos);
        for (int s = tid; s < nadm; s += NTHREADS) {
            float k[64];
            const u32x4* kp = (const u32x4*)(KI + (size_t)(b * SEQ + s) * 64);
#pragma unroll
            for (int i = 0; i < 8; ++i) { const u32x4 w = kp[i]; const unsigned ww[4] = {w.x, w.y, w.z, w.w};
#pragma unroll
                for (int e = 0; e < 4; ++e) { k[i * 8 + e * 2] = __uint_as_float(ww[e] << 16); k[i * 8 + e * 2 + 1] = __uint_as_float(ww[e] & 0xffff0000u); } }
            float sc = 0.f;
            for (int h = 0; h < 16; ++h) {
                float l = 0.f;
#pragma unroll
                for (int d = 0; d < 64; ++d) l += qs[h * 64 + d] * k[d];
                sc += ws[h] * fmaxf(l * 0.125f, 0.f);
            }
            out[s] = sc;
        }
    }
}

__device__ __forceinline__ unsigned fkey(float f) { const unsigned u = __float_as_uint(f + 0.0f); return (u & 0x80000000u) ? ~u : (u | 0x80000000u); }
__device__ __forceinline__ void topk_rows(const float* SC, int* SEL, int gw, int ngw, int lane, bool dry = false) {
    for (int t = gw; t < M; t += ngw) {
        const int b = t / SEQ, pos = t % SEQ, nadm = ((pos >> 6) + 1) * 64;
        int* sel = SEL + (size_t)t * TOPK;
        if (nadm <= TOPK) { for (int i = lane; i < nadm; i += 64) sel[i] = i; continue; }
        const float* sc = SC + sc_off(b, pos);
        const int nj = nadm >> 6;
        unsigned key[64];
#pragma unroll
        for (int j = 0; j < 64; ++j) key[j] = (j < nj) ? fkey(sc[j * 64 + lane]) : 0u;
        unsigned prefix = 0u;
        for (int bit = 31; bit >= 0; --bit) {
            const unsigned cand = prefix | (1u << bit);
            int cnt = 0;
#pragma unroll
            for (int j4 = 0; j4 < 16; ++j4) {
                if (j4 * 4 < nj) {
#pragma unroll
                    for (int jj = 0; jj < 4; ++jj) cnt += __builtin_popcountll(__ballot(key[j4 * 4 + jj] >= cand));
                }
            }
            if (cnt >= TOPK) prefix = cand;
        }
        int cgt = 0;
#pragma unroll
        for (int j4 = 0; j4 < 16; ++j4) {
            if (j4 * 4 < nj) {
#pragma unroll
                for (int jj = 0; jj < 4; ++jj) cgt += __builtin_popcountll(__ballot(key[j4 * 4 + jj] > prefix));
            }
        }
        int need = TOPK - cgt, obase = 0;
        const unsigned long long lt = (1ull << lane) - 1ull;
#pragma unroll
        for (int j = 0; j < 64; ++j) {
            if (j < nj) {
                const bool gt = key[j] > prefix, eq = key[j] == prefix;
                const unsigned long long me = __ballot(eq);
                const int erank = __builtin_popcountll(me & lt);
                const bool take = gt || (eq && erank < need);
                const unsigned long long ms = __ballot(take);
                if (take && !dry) sel[obase + __builtin_popcountll(ms & lt)] = j * 64 + lane;
                obase += __builtin_popcountll(ms);
                const int ne = __builtin_popcountll(me); need -= (ne < need ? ne : need);
            }
        }
    }
}

__device__ __forceinline__ void naive_attn(float* lds, bf16* QL, const bf16* CN, const int* SEL, int vb, int nb) {
    float* qs = lds;
    float* att = lds + 16 * 512;
    int* sl = (int*)(att + 16 * 256);
    const int tid = threadIdx.x, lane = tid & 63, wid = tid >> 6;
    for (int t = vb; t < M; t += nb) {
        const int b = t / SEQ, pos = t % SEQ, nadm = ((pos >> 6) + 1) * 64, nsel = nadm < TOPK ? nadm : TOPK;
        __syncthreads();
        for (int i = tid; i < 16 * 512; i += NTHREADS) qs[i] = bf2f(QL[(size_t)t * 8192 + i]);
        if (tid < 256) sl[tid] = (tid < nsel) ? SEL[(size_t)t * TOPK + tid] : 0;
        __syncthreads();
        {
            const int k = tid & 255, hh = tid >> 8;
            float a[8];
#pragma unroll
            for (int i = 0; i < 8; ++i) a[i] = 0.f;
            if (k < nsel) {
                const u32x4* cp = (const u32x4*)(CN + (size_t)(b * SEQ + sl[k]) * CL);
                for (int c8 = 0; c8 < 64; ++c8) {
                    const u32x4 w = cp[c8]; float cv[8];
                    cv[0] = __uint_as_float(w.x << 16); cv[1] = __uint_as_float(w.x & 0xffff0000u); cv[2] = __uint_as_float(w.y << 16); cv[3] = __uint_as_float(w.y & 0xffff0000u);
                    cv[4] = __uint_as_float(w.z << 16); cv[5] = __uint_as_float(w.z & 0xffff0000u); cv[6] = __uint_as_float(w.w << 16); cv[7] = __uint_as_float(w.w & 0xffff0000u);
#pragma unroll
                    for (int i = 0; i < 8; ++i) { const float* qh = qs + (hh * 8 + i) * 512 + c8 * 8;
                        const f32x4 q0 = *(const f32x4*)qh, q1 = *(const f32x4*)(qh + 4);
                        a[i] += q0.x * cv[0] + q0.y * cv[1] + q0.z * cv[2] + q0.w * cv[3] + q1.x * cv[4] + q1.y * cv[5] + q1.z * cv[6] + q1.w * cv[7]; }
                }
            }
#pragma unroll
            for (int i = 0; i < 8; ++i) att[(hh * 8 + i) * 256 + k] = (k < nsel) ? a[i] * 0.08838834764831845f : -INFINITY;
        }
        __syncthreads();
        {
#pragma unroll
            for (int hi = 0; hi < 2; ++hi) { float* row = att + (wid * 2 + hi) * 256;
                float v[4]; float mx = -INFINITY;
#pragma unroll
                for (int i = 0; i < 4; ++i) { v[i] = row[lane + 64 * i]; mx = fmaxf(mx, v[i]); }
                mx = wave_max(mx); float s = 0.f;
#pragma unroll
                for (int i = 0; i < 4; ++i) { v[i] = __expf(v[i] - mx); s += v[i]; }
                s = wave_sum(s); const float inv = 1.f / s;
#pragma unroll
                for (int i = 0; i < 4; ++i) row[lane + 64 * i] = v[i] * inv; }
        }
        __syncthreads();
        {
            float o[16];
#pragma unroll
            for (int i = 0; i < 16; ++i) o[i] = 0.f;
            for (int k = 0; k < nsel; ++k) {
                const float cv = bf2f(CN[(size_t)(b * SEQ + sl[k]) * CL + tid]);
#pragma unroll
                for (int h = 0; h < 16; ++h) o[h] += att[h * 256 + k] * cv;
            }
#pragma unroll
            for (int h = 0; h < 16; ++h) QL[(size_t)t * 8192 + h * 512 + tid] = f2bf(o[h]);
        }
    }
}


typedef short bf16x8v __attribute__((ext_vector_type(8)));
typedef float f32x16 __attribute__((ext_vector_type(16)));
typedef short v4i16_t __attribute__((ext_vector_type(4)));
__device__ __forceinline__ void fast_scores(const bf16* QI, const bf16* KI, const float* WI, float* SC, int vb, int nb, int wave, int lane) {
    const int r = lane & 31, hi = lane >> 5;
    const int arow_tok = (r >> 2) & 1, arow_head = (r & 3) + 4 * (r >> 3);
    constexpr int NUNITS = 1152;
    for (int u = vb; u < NUNITS; u += nb) {
        int c = 63, rem = u >> 1; const int b = u & 1;
        for (;;) { const int n = 2 * ((c + 8) >> 3); if (rem < n) break; rem -= n; --c; }
        const int hf = rem & 1, sg = rem >> 1;
        const int pos0 = c * 64 + hf * 32 + wave * 4, t0 = b * SEQ + pos0;
        const int k_lo = sg * 512, k_hi = (k_lo + 512 < (c + 1) * 64) ? k_lo + 512 : (c + 1) * 64;
        bf16x8v af[2][4]; float wsc[2][16]; float* outp[2];
#pragma unroll
        for (int p = 0; p < 2; ++p) {
#pragma unroll
            for (int ks = 0; ks < 4; ++ks) af[p][ks] = *(const bf16x8v*)(QI + (size_t)(t0 + 2 * p + arow_tok) * 1024 + arow_head * 64 + ks * 16 + 8 * hi);
            const f32x4* wp = (const f32x4*)(WI + (size_t)(t0 + 2 * p + hi) * 16);
#pragma unroll
            for (int j = 0; j < 4; ++j) { const f32x4 w = wp[j]; wsc[p][4 * j] = w[0] * 0.03125f; wsc[p][4 * j + 1] = w[1] * 0.03125f; wsc[p][4 * j + 2] = w[2] * 0.03125f; wsc[p][4 * j + 3] = w[3] * 0.03125f; }
            outp[p] = SC + sc_off(b, pos0 + 2 * p + hi) + r;
        }
        const bf16* kbase = KI + (size_t)(b * SEQ + r) * 64 + 8 * hi;
        bf16x8v bfr[4], bnx[4];
#pragma unroll
        for (int ks = 0; ks < 4; ++ks) bfr[ks] = *(const bf16x8v*)(kbase + (size_t)k_lo * 64 + ks * 16);
        for (int k0 = k_lo; k0 < k_hi; k0 += 32) {
            const int kn = (k0 + 32 < k_hi) ? k0 + 32 : k0;
#pragma unroll
            for (int ks = 0; ks < 4; ++ks) bnx[ks] = *(const bf16x8v*)(kbase + (size_t)kn * 64 + ks * 16);
#pragma unroll
            for (int p = 0; p < 2; ++p) {
                f32x16 acc = {0.f, 0.f, 0.f, 0.f, 0.f, 0.f, 0.f, 0.f, 0.f, 0.f, 0.f, 0.f, 0.f, 0.f, 0.f, 0.f};
#pragma unroll
                for (int ks = 0; ks < 4; ++ks) acc = __builtin_amdgcn_mfma_f32_32x32x16_bf16(af[p][ks], bfr[ks], acc, 0, 0, 0);
                float s = 0.f;
#pragma unroll
                for (int h = 0; h < 16; ++h) s += fmaxf(acc[h], 0.f) * wsc[p][h];
                outp[p][k0] = s;
            }
#pragma unroll
            for (int ks = 0; ks < 4; ++ks) bfr[ks] = bnx[ks];
        }
    }
}

constexpr int AT_ROWB = 1040;
constexpr int AT_CB = 64 * AT_ROWB;
constexpr int AT_SP = 2 * AT_CB;
constexpr int AT_PB = AT_SP + 2 * 16 * 68 * 4;
constexpr int AT_AL = AT_PB + 16 * 72 * 2;
constexpr int AT_END = AT_AL + 128;
__device__ __forceinline__ int at_nsel(int t) { const int nadm = (((t & (SEQ - 1)) >> 6) + 1) * 64; return nadm < TOPK ? nadm : TOPK; }
__device__ __forceinline__ void at_gather(LAS unsigned char* buf, const bf16* CN, const int* SEL, int t, int ch, int wave, int lane) {
    const int nsel = at_nsel(t), bbase = (t >> 12) * SEQ;
    int idx = 0; { const int i = ch * 64 + wave * 8 + (lane & 7); if (i < nsel) idx = SEL[(size_t)t * TOPK + i]; }
#pragma unroll
    for (int i = 0; i < 8; ++i) { const int row = __builtin_amdgcn_readlane(idx, i);
        __builtin_amdgcn_global_load_lds((const unsigned*)(CN + (size_t)(bbase + row) * CL + lane * 8), (LAS unsigned*)(buf + (wave * 8 + i) * AT_ROWB), 16, 0, 0); }
}
__device__ __forceinline__ void fast_attn(LAS unsigned char* lds, bf16* QL, const bf16* CN, const int* SEL, int vb, int nb, int wave, int lane, bool dostore = true) {
    const int g = lane >> 4, l15 = lane & 15, kt = wave & 3, kh = wave >> 2;
    LAS float* Sp = (LAS float*)(lds + AT_SP); LAS bf16* Pb = (LAS bf16*)(lds + AT_PB); LAS float* AL = (LAS float*)(lds + AT_AL);
    const int tbase = ((vb & 7) >> 2) * SEQ + ((vb & 3) * 32 + (vb >> 3)); int ti = 0;
    const bool remap = (nb == 256);
    int tok = remap ? tbase : vb, ch = 0, cur = 0;
    if (tok >= M) return;
    at_gather(lds, CN, SEL, tok, 0, wave, lane);
    bf16x8v qf[8];
    float m_run[2] = {-INFINITY, -INFINITY}, l_run[2] = {0.f, 0.f};
    f32x4 oacc[4];
    while (tok < M) {
        const int nsel = at_nsel(tok), nch = (nsel + 63) >> 6;
        int ntok = tok, nc = ch + 1; if (nc >= nch) { nc = 0; if (remap) { ++ti; ntok = (ti < 32) ? tbase + ti * 128 : M; } else ntok = tok + nb; }
        LAS unsigned char* buf = lds + cur * AT_CB;
        if (ch == 0) {
#pragma unroll
            for (int ks = 0; ks < 8; ++ks) qf[ks] = *(const bf16x8v*)(QL + (size_t)tok * 8192 + l15 * 512 + kh * 256 + ks * 32 + 8 * g);
            m_run[0] = -INFINITY; m_run[1] = -INFINITY; l_run[0] = 0.f; l_run[1] = 0.f;
#pragma unroll
            for (int n = 0; n < 4; ++n) oacc[n] = (f32x4){0.f, 0.f, 0.f, 0.f};
        }
        asm volatile("s_waitcnt vmcnt(0) lgkmcnt(0)" ::: "memory"); __builtin_amdgcn_s_barrier(); asm volatile("" ::: "memory");
        if (ntok < M) at_gather(lds + (cur ^ 1) * AT_CB, CN, SEL, ntok, nc, wave, lane);
        {   f32x4 sacc = {0.f, 0.f, 0.f, 0.f};
            const LAS unsigned char* cb = buf + (kt * 16 + l15) * AT_ROWB + (kh * 256 + 8 * g) * 2;
#pragma unroll
            for (int ks = 0; ks < 8; ++ks) { const bf16x8v cf = *(const LAS bf16x8v*)(cb + ks * 64); sacc = __builtin_amdgcn_mfma_f32_16x16x32_bf16(cf, qf[ks], sacc, 0, 0, 0); }
            *(LAS f32x4*)(Sp + (kh * 16 + l15) * 68 + kt * 16 + 4 * g) = sacc;
        }
        asm volatile("s_waitcnt lgkmcnt(0)" ::: "memory"); __builtin_amdgcn_s_barrier(); asm volatile("" ::: "memory");
#pragma unroll
        for (int hh = 0; hh < 2; ++hh) { const int h = 2 * wave + hh;
            float s = (Sp[h * 68 + lane] + Sp[(16 + h) * 68 + lane]) * 0.12751743074602468f;
            if (ch * 64 + lane >= nsel) s = -INFINITY;
            const float mn = fmaxf(m_run[hh], wave_max(s));
            const float alpha = __builtin_amdgcn_exp2f(m_run[hh] - mn), p = __builtin_amdgcn_exp2f(s - mn);
            l_run[hh] = l_run[hh] * alpha + wave_sum(p); m_run[hh] = mn;
            Pb[h * 72 + lane] = f2bf(p);
            if (lane == 0) AL[h] = alpha; }
        asm volatile("s_waitcnt lgkmcnt(0)" ::: "memory"); __builtin_amdgcn_s_barrier(); asm volatile("" ::: "memory");
        {   const float al = AL[l15];
#pragma unroll
            for (int n = 0; n < 4; ++n) oacc[n] = oacc[n] * al;
            bf16x8v pf[2];
#pragma unroll
            for (int ks = 0; ks < 2; ++ks) pf[ks] = *(const LAS bf16x8v*)((const LAS unsigned char*)Pb + l15 * 144 + (32 * ks + 8 * g) * 2);
            const LAS unsigned char* tb = buf + (8 * g + (l15 >> 2)) * AT_ROWB + (64 * wave + 4 * (l15 & 3)) * 2;
#pragma unroll
            for (int n = 0; n < 4; ++n)
#pragma unroll
                for (int ks = 0; ks < 2; ++ks) {
                    const v4i16_t t0 = __builtin_amdgcn_ds_read_tr16_b64_v4i16((LAS v4i16_t*)(tb + (32 * ks) * AT_ROWB + n * 32));
                    const v4i16_t t1 = __builtin_amdgcn_ds_read_tr16_b64_v4i16((LAS v4i16_t*)(tb + (32 * ks + 4) * AT_ROWB + n * 32));
                    const bf16x8v cf = {t0[0], t0[1], t0[2], t0[3], t1[0], t1[1], t1[2], t1[3]};
                    oacc[n] = __builtin_amdgcn_mfma_f32_16x16x32_bf16(cf, pf[ks], oacc[n], 0, 0, 0);
                }
        }
        if (nc == 0) {
            if (lane == 0) { AL[16 + 2 * wave] = 1.f / l_run[0]; AL[16 + 2 * wave + 1] = 1.f / l_run[1]; }
            asm volatile("s_waitcnt lgkmcnt(0)" ::: "memory"); __builtin_amdgcn_s_barrier(); asm volatile("" ::: "memory");
            const float li = AL[16 + l15];
            bf16* op = QL + (size_t)tok * 8192 + l15 * 512 + 64 * wave + 4 * g;
#pragma unroll
            for (int n = 0; n < 4; ++n) if (dostore) { const f32x4 o = oacc[n] * li; u32x2 w; w.x = pk2(o[0], o[1]); w.y = pk2(o[2], o[3]); *(u32x2*)(op + 16 * n) = w; }
        }
        tok = ntok; ch = nc; cur ^= 1;
    }
    asm volatile("s_waitcnt vmcnt(0) lgkmcnt(0)" ::: "memory"); __builtin_amdgcn_s_barrier();
}

constexpr int GT_ROWB = 528;
__device__ __forceinline__ void fast_gating(LAS unsigned char* lds, bf16* U, const bf16* V, const float* VST, const float* ln_g, const float* ln_b,
                                            const float* w_s, const float* b_s, int vb, int nb, int wave, int lane, bool dry = false) {
    LAS float* MR = (LAS float*)(lds + 128 * GT_ROWB);
    const int tid = threadIdx.x, g = lane >> 4, l15 = lane & 15, ph = wave >> 2, cq = wave & 3;
    for (int unit = vb; unit < 512; unit += nb) {
        const int gi = unit & 7, n = (unit >> 3) & 31, b = unit >> 8;
        const int row0 = b * SEQ + n * 128, ch0 = gi * 256;
        asm volatile("s_waitcnt lgkmcnt(0)" ::: "memory"); __builtin_amdgcn_s_barrier(); asm volatile("" ::: "memory");
        if (tid < 128) {
            const f32x4* vp = (const f32x4*)(VST + (size_t)(row0 + tid) * 64); float s = 0.f, q = 0.f;
#pragma unroll
            for (int j = 0; j < 16; ++j) { const f32x4 v = vp[j]; s += v[0] + v[2]; q += v[1] + v[3]; }
            const float mean = s * (1.f / D), var = q * (1.f / D) - mean * mean;
            MR[tid * 2] = mean; MR[tid * 2 + 1] = rsqrtf(fmaxf(var, 0.f) + EPS);
        }
        bf16x8v wf[4][4];
        const int nks = ph ? 4 : 2;
#pragma unroll
        for (int pt = 0; pt < 4; ++pt)
#pragma unroll
            for (int ks = 0; ks < 4; ++ks) { if (ks < nks) { const f32x4* wp = (const f32x4*)(w_s + (size_t)gi * 16384 + (ph * 64 + pt * 16 + l15) * 128 + ks * 32 + 8 * g); const f32x4 a = wp[0], c = wp[1];
                    const unsigned w0 = pk2(a[0], a[1]), w1 = pk2(a[2], a[3]), w2 = pk2(c[0], c[1]), w3 = pk2(c[2], c[3]);
                    wf[pt][ks] = __builtin_bit_cast(bf16x8v, (u32x4){w0, w1, w2, w3}); } else wf[pt][ks] = (bf16x8v){0, 0, 0, 0, 0, 0, 0, 0}; }
        asm volatile("s_waitcnt lgkmcnt(0)" ::: "memory"); __builtin_amdgcn_s_barrier(); asm volatile("" ::: "memory");
        {
            const int c8 = tid & 31; float lg[8], lb[8];
            { const f32x4* gp = (const f32x4*)(ln_g + ch0 + c8 * 8); const f32x4* bp = (const f32x4*)(ln_b + ch0 + c8 * 8); const f32x4 g0 = gp[0], g1 = gp[1], b0 = bp[0], b1 = bp[1];
              lg[0] = g0[0]; lg[1] = g0[1]; lg[2] = g0[2]; lg[3] = g0[3]; lg[4] = g1[0]; lg[5] = g1[1]; lg[6] = g1[2]; lg[7] = g1[3];
              lb[0] = b0[0]; lb[1] = b0[1]; lb[2] = b0[2]; lb[3] = b0[3]; lb[4] = b1[0]; lb[5] = b1[1]; lb[6] = b1[2]; lb[7] = b1[3]; }
#pragma unroll
            for (int i = 0; i < 8; ++i) { const int q = (tid >> 5) + 16 * i;
                const u32x4 raw = *(const u32x4*)(V + (size_t)(row0 + q) * D + ch0 + c8 * 8); const float mean = MR[q * 2], rs = MR[q * 2 + 1];
                const unsigned ww[4] = {raw.x, raw.y, raw.z, raw.w}; u32x4 o; unsigned oo[4];
#pragma unroll
                for (int e = 0; e < 4; ++e) oo[e] = pk2((bflo(ww[e]) - mean) * rs * lg[2 * e] + lb[2 * e], (bfhi(ww[e]) - mean) * rs * lg[2 * e + 1] + lb[2 * e + 1]);
                o.x = oo[0]; o.y = oo[1]; o.z = oo[2]; o.w = oo[3];
                *(LAS u32x4*)(lds + q * GT_ROWB + c8 * 16) = o; }
        }
        asm volatile("s_waitcnt lgkmcnt(0)" ::: "memory"); __builtin_amdgcn_s_barrier(); asm volatile("" ::: "memory");
        f32x4 acc[4][4];
#pragma unroll
        for (int ct = 0; ct < 4; ++ct)
#pragma unroll
            for (int pt = 0; pt < 4; ++pt) acc[ct][pt] = (f32x4){0.f, 0.f, 0.f, 0.f};
        const LAS unsigned char* tb = lds + (8 * g + (l15 >> 2)) * GT_ROWB + (cq * 64 + 4 * (l15 & 3)) * 2;
#pragma unroll
        for (int ks = 0; ks < 4; ++ks) { if (ks < nks) {
#pragma unroll
            for (int ct = 0; ct < 4; ++ct) {
                const v4i16_t t0 = __builtin_amdgcn_ds_read_tr16_b64_v4i16((LAS v4i16_t*)(tb + (32 * ks) * GT_ROWB + ct * 32));
                const v4i16_t t1 = __builtin_amdgcn_ds_read_tr16_b64_v4i16((LAS v4i16_t*)(tb + (32 * ks + 4) * GT_ROWB + ct * 32));
                const bf16x8v cf = {t0[0], t0[1], t0[2], t0[3], t1[0], t1[1], t1[2], t1[3]};
#pragma unroll
                for (int pt = 0; pt < 4; ++pt) acc[ct][pt] = __builtin_amdgcn_mfma_f32_16x16x32_bf16(cf, wf[pt][ks], acc[ct][pt], 0, 0, 0);
            } } }
#pragma unroll
        for (int pt = 0; pt < 4; ++pt) { const int p = ph * 64 + pt * 16 + l15; const float bs = b_s[gi * 128 + p];
#pragma unroll
            for (int ct = 0; ct < 4; ++ct) { bf16* up = U + (size_t)(row0 + p) * D + ch0 + cq * 64 + ct * 16 + 4 * g; const u32x2 uu = *(const u32x2*)up; const f32x4 a = acc[ct][pt];
                u32x2 o; o.x = pk2(bflo(uu.x) * (a[0] + bs), bfhi(uu.x) * (a[1] + bs)); o.y = pk2(bflo(uu.y) * (a[2] + bs), bfhi(uu.y) * (a[3] + bs)); if (!dry) *(u32x2*)up = o; } }
    }
    asm volatile("s_waitcnt lgkmcnt(0)" ::: "memory"); __builtin_amdgcn_s_barrier(); asm volatile("" ::: "memory");
}

typedef short bf16x4v __attribute__((ext_vector_type(4)));
constexpr int A2_ROWB = 1056;
constexpr int A2_WB = 16 * A2_ROWB;
__device__ __forceinline__ void attn_wave(LAS unsigned char* lds, bf16* QL, const bf16* CN, const int* SEL, int vb, int nb, int wave, int lane, bool dry = false) {
    const int g = lane >> 4, l15 = lane & 15;
    LAS unsigned char* buf = lds + wave * A2_WB;
    int tlist0, tstep, ntok;
    if (nb == 256) { const int bsel = (vb & 7) >> 2, w = (((vb & 3) * 32 + (vb >> 3)) * 8 + wave); tlist0 = bsel * SEQ + w; tstep = 1024; ntok = 4; }
    else { tlist0 = vb * 8 + wave; tstep = nb * 8; ntok = (M - tlist0 + tstep - 1) / tstep; }
    const LAS unsigned char* cb = buf + l15 * A2_ROWB + 8 * g * 2;
    const LAS unsigned char* tb = buf + (4 * g + (l15 >> 2)) * A2_ROWB + 4 * (l15 & 3) * 2;
    for (int it = 0; it < ntok; ++it) {
        const int tok = tlist0 + it * tstep;
        const int nadm = (((tok & (SEQ - 1)) >> 6) + 1) * 64, nsel = nadm < TOPK ? nadm : TOPK, nch = nsel >> 4, bbase = (tok >> 12) * SEQ;
        bf16x8v qf[16];
#pragma unroll
        for (int ks = 0; ks < 16; ++ks) qf[ks] = *(const bf16x8v*)(QL + (size_t)tok * 8192 + l15 * 512 + ks * 32 + 8 * g);
        f32x4 oacc[32];
#pragma unroll
        for (int n = 0; n < 32; ++n) oacc[n] = (f32x4){0.f, 0.f, 0.f, 0.f};
        float m_run = -INFINITY, l_run = 0.f;
        for (int ch = 0; ch < nch; ++ch) {
            const int idx = SEL[(size_t)tok * TOPK + ch * 16 + l15];
            asm volatile("s_waitcnt lgkmcnt(0)" ::: "memory");
#pragma unroll
            for (int i = 0; i < 16; ++i) { const int row = __builtin_amdgcn_readlane(idx, i);
                __builtin_amdgcn_global_load_lds((const unsigned*)(CN + (size_t)(bbase + row) * CL + lane * 8), (LAS unsigned*)(buf + i * A2_ROWB), 16, 0, 0); }
            asm volatile("s_waitcnt vmcnt(0)" ::: "memory");
            f32x4 s = {0.f, 0.f, 0.f, 0.f};
#pragma unroll
            for (int ks = 0; ks < 16; ++ks) { const bf16x8v cf = *(const LAS bf16x8v*)(cb + ks * 64); s = __builtin_amdgcn_mfma_f32_16x16x32_bf16(cf, qf[ks], s, 0, 0, 0); }
            s = s * 0.12751743074602468f;
            float mx = fmaxf(fmaxf(s[0], s[1]), fmaxf(s[2], s[3]));
            mx = fmaxf(mx, __shfl_xor(mx, 16)); mx = fmaxf(mx, __shfl_xor(mx, 32));
            const float mn = fmaxf(m_run, mx), alpha = __builtin_amdgcn_exp2f(m_run - mn);
            const float p0 = __builtin_amdgcn_exp2f(s[0] - mn), p1 = __builtin_amdgcn_exp2f(s[1] - mn), p2 = __builtin_amdgcn_exp2f(s[2] - mn), p3 = __builtin_amdgcn_exp2f(s[3] - mn);
            float ps = (p0 + p1) + (p2 + p3); ps += __shfl_xor(ps, 16); ps += __shfl_xor(ps, 32);
            l_run = l_run * alpha + ps; m_run = mn;
            const unsigned pw0 = pk2(p0, p1), pw1 = pk2(p2, p3);
            const bf16x4v pf = __builtin_bit_cast(bf16x4v, (u32x2){pw0, pw1});
#pragma unroll
            for (int n = 0; n < 32; ++n) {
                const v4i16_t t = __builtin_amdgcn_ds_read_tr16_b64_v4i16((LAS v4i16_t*)(tb + n * 32));
                oacc[n] = __builtin_amdgcn_mfma_f32_16x16x16bf16_1k(__builtin_bit_cast(bf16x4v, t), pf, oacc[n] * alpha, 0, 0, 0);
            }
        }
        const float li = 1.f / l_run;
        bf16* op = QL + (size_t)tok * 8192 + l15 * 512 + 4 * g;
#pragma unroll
        for (int n = 0; n < 32; ++n) { const f32x4 o = oacc[n] * li; u32x2 w; w.x = pk2(o[0], o[1]); w.y = pk2(o[2], o[3]); if (!dry) *(u32x2*)(op + 16 * n) = w; }
    }
    asm volatile("s_waitcnt vmcnt(0) lgkmcnt(0)" ::: "memory");
}

__device__ __forceinline__ void sc_decode(int u, int& b, int& c, int& hf, int& sg) {
    c = 63; int rem = u >> 1; b = u & 1;
    for (;;) { const int n = 2 * ((c + 8) >> 3); if (rem < n) break; rem -= n; --c; }
    hf = rem & 1; sg = rem >> 1;
}
__device__ __forceinline__ void sc_stage(LAS unsigned char* buf, const bf16* KI, int u, int wave, int lane) {
    int b, c, hf, sg; sc_decode(u, b, c, hf, sg);
    const int k_lo = sg * 512, k_hi = (k_lo + 512 < (c + 1) * 64) ? k_lo + 512 : (c + 1) * 64, nrd = (k_hi - k_lo) >> 6;
    const int row = wave * 8 + (lane >> 3), sl = lane & 7;
    const bf16* src = KI + (size_t)(b * SEQ + k_lo + row) * 64 + ((sl ^ ((row >> 1) & 7)) * 8);
    for (int rd = 0; rd < nrd; ++rd)
        __builtin_amdgcn_global_load_lds((const unsigned*)(src + (size_t)rd * 64 * 64), (LAS unsigned*)(buf + rd * 8192 + wave * 1024), 16, 0, 0);
}
__device__ __forceinline__ void fast_scores2(LAS unsigned char* lds, const bf16* QI, const bf16* KI, const float* WI, float* SC, int vb, int nb, int wave, int lane) {
    const int r = lane & 31, hi = lane >> 5;
    const int arow_tok = (r >> 2) & 1, arow_head = (r & 3) + 4 * (r >> 3);
    constexpr int NUNITS = 1152;
    int boff[4];
#pragma unroll
    for (int ks = 0; ks < 4; ++ks) boff[ks] = r * 128 + (((2 * ks + hi) ^ ((r >> 1) & 7)) * 16);
    if (vb < NUNITS) sc_stage(lds, KI, vb, wave, lane);
    int cur = 0;
    for (int u = vb; u < NUNITS; u += nb, cur ^= 1) {
        int b, c, hf, sg; sc_decode(u, b, c, hf, sg);
        const int pos0 = c * 64 + hf * 32 + wave * 4, t0 = b * SEQ + pos0;
        const int k_lo = sg * 512, k_hi = (k_lo + 512 < (c + 1) * 64) ? k_lo + 512 : (c + 1) * 64;
        bf16x8v af[2][4]; float wsc[2][16]; float* outp[2];
#pragma unroll
        for (int p = 0; p < 2; ++p) {
#pragma unroll
            for (int ks = 0; ks < 4; ++ks) af[p][ks] = *(const bf16x8v*)(QI + (size_t)(t0 + 2 * p + arow_tok) * 1024 + arow_head * 64 + ks * 16 + 8 * hi);
            const f32x4* wp = (const f32x4*)(WI + (size_t)(t0 + 2 * p + hi) * 16);
#pragma unroll
            for (int j = 0; j < 4; ++j) { const f32x4 w = wp[j]; wsc[p][4 * j] = w[0] * 0.03125f; wsc[p][4 * j + 1] = w[1] * 0.03125f; wsc[p][4 * j + 2] = w[2] * 0.03125f; wsc[p][4 * j + 3] = w[3] * 0.03125f; }
            outp[p] = SC + sc_off(b, pos0 + 2 * p + hi) + r + k_lo;
        }
        asm volatile("s_waitcnt vmcnt(0) lgkmcnt(0)" ::: "memory"); __builtin_amdgcn_s_barrier(); asm volatile("" ::: "memory");
        if (u + nb < NUNITS) sc_stage(lds + (cur ^ 1) * 65536, KI, u + nb, wave, lane);
        const LAS unsigned char* kb = lds + cur * 65536;
        const int ntile = (k_hi - k_lo) >> 5;
        for (int tl = 0; tl < ntile; ++tl) {
            bf16x8v bfr[4];
#pragma unroll
            for (int ks = 0; ks < 4; ++ks) bfr[ks] = *(const LAS bf16x8v*)(kb + tl * 4096 + boff[ks]);
#pragma unroll
            for (int p = 0; p < 2; ++p) {
                f32x16 acc = {0.f, 0.f, 0.f, 0.f, 0.f, 0.f, 0.f, 0.f, 0.f, 0.f, 0.f, 0.f, 0.f, 0.f, 0.f, 0.f};
#pragma unroll
                for (int ks = 0; ks < 4; ++ks) acc = __builtin_amdgcn_mfma_f32_32x32x16_bf16(af[p][ks], bfr[ks], acc, 0, 0, 0);
                float s = 0.f;
#pragma unroll
                for (int h = 0; h < 16; ++h) s += fmaxf(acc[h], 0.f) * wsc[p][h];
                outp[p][tl * 32] = s;
            }
        }
    }
    asm volatile("s_waitcnt vmcnt(0) lgkmcnt(0)" ::: "memory"); __builtin_amdgcn_s_barrier(); asm volatile("" ::: "memory");
}

constexpr int TK_WB = 4 * 260 * 4;
__device__ __forceinline__ void topk_rows2(LAS unsigned char* lds, const float* SC, int* SEL, int gw, int ngw, int wave, int lane, bool dry = false) {
    LAS unsigned* hist = (LAS unsigned*)(lds + wave * TK_WB);
    LAS unsigned* myh = hist + (lane & 3) * 260;
    for (int t = gw; t < M; t += ngw) {
        const int b = t / SEQ, pos = t % SEQ, nadm = ((pos >> 6) + 1) * 64;
        int* sel = SEL + (size_t)t * TOPK;
        if (nadm <= TOPK) { for (int i = lane; i < nadm; i += 64) sel[i] = i; continue; }
        const float* sc = SC + sc_off(b, pos);
        const int nj = nadm >> 6;
        unsigned key[64];
#pragma unroll
        for (int j = 0; j < 64; ++j) key[j] = (j < nj) ? fkey(sc[j * 64 + lane]) : 0u;
        unsigned prefix = 0u; int need = TOPK;
#pragma unroll 1
        for (int pass = 0; pass < 4; ++pass) {
            const int shift = 24 - 8 * pass;
            asm volatile("s_waitcnt lgkmcnt(0)" ::: "memory");
#pragma unroll
            for (int k = 0; k < 16; ++k) hist[lane + 64 * k] = 0u;
            if (lane < 16) hist[1024 + lane] = 0u;
            asm volatile("s_waitcnt lgkmcnt(0)" ::: "memory");
            const unsigned pmask = (pass == 0) ? 0u : (0xffffffffu << (shift + 8));
#pragma unroll
            for (int j4 = 0; j4 < 16; ++j4) {
                if (j4 * 4 < nj) {
#pragma unroll
                    for (int jj = 0; jj < 4; ++jj) { const unsigned kk = key[j4 * 4 + jj];
                        if (((kk ^ prefix) & pmask) == 0u) __hip_atomic_fetch_add(myh + ((kk >> shift) & 255u), 1u, __ATOMIC_RELAXED, __HIP_MEMORY_SCOPE_WORKGROUP); }
                }
            }
            asm volatile("s_waitcnt lgkmcnt(0)" ::: "memory");
            u32x4 c = *(const LAS u32x4*)(hist + 4 * lane);
#pragma unroll
            for (int cp = 1; cp < 4; ++cp) { const u32x4 d = *(const LAS u32x4*)(hist + cp * 260 + 4 * lane); c = c + d; }
            const int s = (int)(c.x + c.y + c.z + c.w);
            int S = s;
#pragma unroll
            for (int o = 1; o < 64; o <<= 1) { const int v = __shfl_down(S, o); if (lane + o < 64) S += v; }
            const int E = S - s;
            const bool cross = (E < need) && (S >= need);
            const unsigned long long bm = __ballot(cross);
            const int Lc = __builtin_ctzll(bm);
            int acc = E, dig = 0, nn = need;
            { bool done = false; const int cc[4] = {(int)c.x, (int)c.y, (int)c.z, (int)c.w};
#pragma unroll
              for (int i = 3; i >= 0; --i) { if (!done) { if (acc + cc[i] >= need) { dig = 4 * lane + i; nn = need - acc; done = true; } else acc += cc[i]; } } }
            const int digit = __builtin_amdgcn_readlane(dig, Lc); need = __builtin_amdgcn_readlane(nn, Lc);
            prefix |= (unsigned)digit << shift;
        }
        int obase = 0;
        const unsigned long long lt = (1ull << lane) - 1ull;
#pragma unroll
        for (int j = 0; j < 64; ++j) {
            if (j < nj) {
                const bool gt = key[j] > prefix, eq = key[j] == prefix;
                const unsigned long long me = __ballot(eq);
                const int erank = __builtin_popcountll(me & lt);
                const bool take = gt || (eq && erank < need);
                const unsigned long long ms = __ballot(take);
                if (take && !dry) sel[obase + __builtin_popcountll(ms & lt)] = j * 64 + lane;
                obase += __builtin_popcountll(ms);
                const int ne = __builtin_popcountll(me); need -= (ne < need ? ne : need);
            }
        }
    }
}

constexpr int TK5_HW = 4096 + 64 * 4;
constexpr int TK5_TRASH = TK5_HW;
constexpr int TK5_LIST = TK5_HW + 64;
constexpr int TK5_WB = (TK5_LIST + 320) * 4;
__device__ __forceinline__ int tk_row_sum(int v) {
    v += __builtin_amdgcn_update_dpp(0, v, 0xB1, 0xf, 0xf, true);
    v += __builtin_amdgcn_update_dpp(0, v, 0x4E, 0xf, 0xf, true);
    v += __builtin_amdgcn_update_dpp(0, v, 0x141, 0xf, 0xf, true);
    v += __builtin_amdgcn_update_dpp(0, v, 0x140, 0xf, 0xf, true);
    return __builtin_amdgcn_readlane(v, 0) + __builtin_amdgcn_readlane(v, 16) + __builtin_amdgcn_readlane(v, 32) + __builtin_amdgcn_readlane(v, 48);
}
__device__ __forceinline__ unsigned tk_row_max(unsigned v) {
    unsigned t;
    t = (unsigned)__builtin_amdgcn_update_dpp(0, (int)v, 0xB1, 0xf, 0xf, true); v = v > t ? v : t;
    t = (unsigned)__builtin_amdgcn_update_dpp(0, (int)v, 0x4E, 0xf, 0xf, true); v = v > t ? v : t;
    t = (unsigned)__builtin_amdgcn_update_dpp(0, (int)v, 0x141, 0xf, 0xf, true); v = v > t ? v : t;
    t = (unsigned)__builtin_amdgcn_update_dpp(0, (int)v, 0x140, 0xf, 0xf, true); v = v > t ? v : t;
    const unsigned a = (unsigned)__builtin_amdgcn_readlane((int)v, 0), b = (unsigned)__builtin_amdgcn_readlane((int)v, 16), c = (unsigned)__builtin_amdgcn_readlane((int)v, 32), d = (unsigned)__builtin_amdgcn_readlane((int)v, 48);
    const unsigned ab = a > b ? a : b, cd = c > d ? c : d; return ab > cd ? ab : cd;
}
__device__ __forceinline__ void topk_rows5(LAS unsigned char* lds, const float* SC, int* SEL, int gw, int wave, int lane) {
    LAS unsigned* hist = (LAS unsigned*)(lds + wave * TK5_WB);
    LAS int* list = (LAS int*)(hist + TK5_LIST);
    const unsigned hbase = (unsigned)(size_t)hist, trash = hbase + (TK5_TRASH + lane) * 4u;
    const unsigned long long lt = (1ull << lane) - 1ull;
    for (int it = 0; it < 4; ++it) {
        const int b = it >> 1, pos = (it & 1) ? (SEQ - 1 - gw) : gw, t = b * SEQ + pos, nadm = ((pos >> 6) + 1) * 64;
        int* sel = SEL + (size_t)t * TOPK;
        if (nadm <= TOPK) { for (int i = lane; i < nadm; i += 64) sel[i] = i; continue; }
        const float* sc = SC + sc_off(b, pos);
        const int nj = nadm >> 6;
        unsigned key[64];
#pragma unroll
        for (int j = 0; j < 64; ++j) key[j] = (j < nj) ? fkey(sc[j * 64 + lane]) : 0u;
#define TK_COUNT_GE(cand, out) do { int c0_ = 0, c1_ = 0; _Pragma("unroll") for (int j4 = 0; j4 < 16; ++j4) { if (j4 * 4 < nj) { c0_ += (key[j4 * 4] >= (cand)); c1_ += (key[j4 * 4 + 1] >= (cand)); c0_ += (key[j4 * 4 + 2] >= (cand)); c1_ += (key[j4 * 4 + 3] >= (cand)); } } out = tk_row_sum(c0_ + c1_); } while (0)
        unsigned km = 0u;
#pragma unroll
        for (int j4 = 0; j4 < 16; ++j4) { if (j4 * 4 < nj) { const unsigned m0 = key[j4 * 4] > key[j4 * 4 + 1] ? key[j4 * 4] : key[j4 * 4 + 1], m1 = key[j4 * 4 + 2] > key[j4 * 4 + 3] ? key[j4 * 4 + 2] : key[j4 * 4 + 3]; const unsigned m2 = m0 > m1 ? m0 : m1; km = km > m2 ? km : m2; } }
        int chi = 0; unsigned prefix = 0u;
        {   int lo = 0, hi = (int)(tk_row_max(km) >> 24), probes = 0;
#pragma unroll 1
            while (lo < hi) { const int mid = (probes < 2) ? hi : ((lo + hi + 1) >> 1); ++probes;
                int cnt; TK_COUNT_GE((unsigned)mid << 24, cnt);
                if (cnt >= TOPK) lo = mid; else { hi = mid - 1; chi = cnt; } }
            prefix = (unsigned)lo << 24;
        }
        int need = TOPK - chi;
#pragma unroll 1
        for (int pass = 0; pass < 2; ++pass) {
            const int shift = 12 - 12 * pass;
            asm volatile("s_waitcnt lgkmcnt(0)" ::: "memory");
#pragma unroll
            for (int k = 0; k < 17; ++k) *(LAS u32x4*)(hist + (k * 64 + lane) * 4) = (u32x4){0u, 0u, 0u, 0u};
            asm volatile("s_waitcnt lgkmcnt(0)" ::: "memory");
#pragma unroll
            for (int j4 = 0; j4 < 16; ++j4) {
                if (j4 * 4 < nj) {
#pragma unroll
                    for (int jj = 0; jj < 4; ++jj) { const unsigned kk = key[j4 * 4 + jj];
                        const unsigned mism = (kk ^ prefix) >> (shift + 12), d = (kk >> shift) & 4095u;
                        const unsigned addr = hbase + (d << 2) + ((d >> 6) << 4);
                        __hip_atomic_fetch_add((LAS unsigned*)(mism == 0u ? addr : trash), 1u, __ATOMIC_RELAXED, __HIP_MEMORY_SCOPE_WORKGROUP); }
                }
            }
            asm volatile("s_waitcnt lgkmcnt(0)" ::: "memory");
            u32x4 c[16]; int g[16]; int s_ = 0;
#pragma unroll
            for (int i = 0; i < 16; ++i) { c[i] = *(const LAS u32x4*)(hist + 68 * lane + 4 * i); g[i] = (int)(c[i].x + c[i].y + c[i].z + c[i].w); s_ += g[i]; }
            int S = s_;
#pragma unroll
            for (int o = 1; o < 64; o <<= 1) { const int v = __shfl_down(S, o); if (lane + o < 64) S += v; }
            const int E = S - s_;
            const bool cross = (E < need) && (S >= need);
            const int Lc = __builtin_ctzll(__ballot(cross));
            int acc = E, dig = 0, nn = need; bool done = false;
#pragma unroll
            for (int i = 15; i >= 0; --i) {
                if (!done) {
                    if (acc + g[i] >= need) {
                        const int cc[4] = {(int)c[i].x, (int)c[i].y, (int)c[i].z, (int)c[i].w};
#pragma unroll
                        for (int e = 3; e >= 0; --e) { if (!done) { if (acc + cc[e] >= need) { dig = 64 * lane + 4 * i + e; nn = need - acc; done = true; } else acc += cc[e]; } }
                    } else acc += g[i];
                }
            }
            const int digit = __builtin_amdgcn_readlane(dig, Lc); need = __builtin_amdgcn_readlane(nn, Lc);
            prefix |= (unsigned)digit << shift;
        }
        int cge = 0, ceq = 0;
#pragma unroll
        for (int j4 = 0; j4 < 16; ++j4) { if (j4 * 4 < nj) {
#pragma unroll
            for (int jj = 0; jj < 4; ++jj) { cge += (key[j4 * 4 + jj] >= prefix); ceq += (key[j4 * 4 + jj] == prefix); } } }
        const int ties = tk_row_sum(ceq);
        if (ties == need) {
            int inc = cge;
#pragma unroll
            for (int o = 1; o < 64; o <<= 1) { const int v = __shfl_up(inc, o); if (lane >= o) inc += v; }
            int kpos = inc - cge;
            asm volatile("s_waitcnt lgkmcnt(0)" ::: "memory");
#pragma unroll
            for (int j4 = 0; j4 < 16; ++j4) { if (j4 * 4 < nj) {
#pragma unroll
                for (int jj = 0; jj < 4; ++jj) { const int j = j4 * 4 + jj; const bool take = key[j] >= prefix; list[take ? kpos : (256 + lane)] = j * 64 + lane; kpos += take ? 1 : 0; } } }
            asm volatile("s_waitcnt lgkmcnt(0)" ::: "memory");
            *(u32x4*)(sel + 4 * lane) = *(const LAS u32x4*)(list + 4 * lane);
        } else {
            int obase = 0;
#pragma unroll 1
            for (int j = 0; j < nj; ++j) {
                unsigned kk = 0u;
#pragma unroll
                for (int q = 0; q < 64; ++q) kk = (q == j) ? key[q] : kk;
                const bool gt = kk > prefix, eq = kk == prefix;
                const unsigned long long me = __ballot(eq);
                const int erank = __builtin_popcountll(me & lt);
                const bool take = gt || (eq && erank < need);
                const unsigned long long ms = __ballot(take);
                if (take) sel[obase + __builtin_popcountll(ms & lt)] = j * 64 + lane;
                obase += __builtin_popcountll(ms);
                const int ne = __builtin_popcountll(me); need -= (ne < need ? ne : need);
            }
        }
#undef TK_COUNT_GE
    }
}

#ifdef NAIVEMASK
template <bool DUAL, class Epi>
__device__ __forceinline__ void naive_gemm(float* lds, const bf16* A, int lda, const float* W, const float* W2, int ldw, const float* kscale,
                                           int Mrows, int N, int K, const Epi& epi, int vb, int nb) {
    float* As = lds;
    float* Ws = lds + 16 * 132;
    float* Ws2 = lds + 32 * 132;
    const int tid = threadIdx.x, tx = tid & 31, ty = tid >> 5;
    const int ntn = (N + 127) / 128, ntm = Mrows / 128;
    for (int tile = vb; tile < ntm * ntn; tile += nb) {
        const int tm = tile / ntn, tn = tile % ntn;
        const int row0 = tm * 128, col0 = tn * 128;
        float acc[8][4], acc2[8][4];
#pragma unroll
        for (int i = 0; i < 8; ++i)
#pragma unroll
            for (int j = 0; j < 4; ++j) { acc[i][j] = 0.f; acc2[i][j] = 0.f; }
        for (int k0 = 0; k0 < K; k0 += 16) {
            {
                const int r = tid >> 2, k4 = (tid & 3) * 4;
                const u32x2 raw = *(const u32x2*)(A + (size_t)(row0 + r) * lda + k0 + k4);
                As[(k4 + 0) * 132 + r] = __uint_as_float(raw.x << 16);
                As[(k4 + 1) * 132 + r] = __uint_as_float(raw.x & 0xffff0000u);
                As[(k4 + 2) * 132 + r] = __uint_as_float(raw.y << 16);
                As[(k4 + 3) * 132 + r] = __uint_as_float(raw.y & 0xffff0000u);
            }
            {
                const int k = tid >> 5, c4 = (tid & 31) * 4;
                f32x4 w = {0.f, 0.f, 0.f, 0.f}, w2 = {0.f, 0.f, 0.f, 0.f};
                if (col0 + c4 < N) {
                    w = *(const f32x4*)(W + (size_t)(k0 + k) * ldw + col0 + c4);
                    if (DUAL) w2 = *(const f32x4*)(W2 + (size_t)(k0 + k) * ldw + col0 + c4);
                    if (kscale) { const float s = kscale[k0 + k]; w = w * s; w2 = w2 * s; }
                }
                *(f32x4*)(Ws + k * 132 + c4) = w;
                if (DUAL) *(f32x4*)(Ws2 + k * 132 + c4) = w2;
            }
            __syncthreads();
#pragma unroll
            for (int k = 0; k < 16; ++k) {
                const f32x4 a0 = *(const f32x4*)(As + k * 132 + ty * 8), a1 = *(const f32x4*)(As + k * 132 + ty * 8 + 4);
                const f32x4 w = *(const f32x4*)(Ws + k * 132 + tx * 4);
                const float a[8] = {a0.x, a0.y, a0.z, a0.w, a1.x, a1.y, a1.z, a1.w};
#pragma unroll
                for (int i = 0; i < 8; ++i) { acc[i][0] += a[i] * w.x; acc[i][1] += a[i] * w.y; acc[i][2] += a[i] * w.z; acc[i][3] += a[i] * w.w; }
                if (DUAL) {
                    const f32x4 w2 = *(const f32x4*)(Ws2 + k * 132 + tx * 4);
#pragma unroll
                    for (int i = 0; i < 8; ++i) { acc2[i][0] += a[i] * w2.x; acc2[i][1] += a[i] * w2.y; acc2[i][2] += a[i] * w2.z; acc2[i][3] += a[i] * w2.w; }
                }
            }
            __syncthreads();
        }
#pragma unroll
        for (int i = 0; i < 8; ++i)
#pragma unroll
            for (int j = 0; j < 4; ++j) { const int r = row0 + ty * 8 + i, c = col0 + tx * 4 + j; if (c < N) epi(r, c, acc[i][j], acc2[i][j]); }
    }
}

struct EpiProj {
    bf16 *U, *V, *Q, *QI, *KI, *GA, *GB; float *CKR, *WI; int coff;
    __device__ __forceinline__ void operator()(int r, int c, float v, float) const {
        c += coff;
        if (c < 2048) U[(size_t)r * 2048 + c] = f2bf(gelu_tanh(v));
        else if (c < 4096) V[(size_t)r * 2048 + c - 2048] = f2bf(gelu_tanh(v));
        else if (c < 6144) Q[(size_t)r * 2048 + c - 4096] = f2bf(v);
        else if (c < 6656) CKR[(size_t)r * 512 + c - 6144] = v;
        else if (c < 7680) QI[(size_t)r * 1024 + c - 6656] = f2bf(v);
        else if (c < 7744) KI[(size_t)r * 64 + c - 7680] = f2bf(v);
        else if (c < 7760) WI[(size_t)r * 16 + c - 7744] = v;
        else if (c < 9808) GA[(size_t)r * 2048 + c - 7760] = f2bf(sigmoidf(v));
        else GB[(size_t)r * 2048 + c - 9808] = f2bf(sigmoidf(v));
    }
};
struct EpiGateA {
    bf16* GA;
    __device__ __forceinline__ void operator()(int r, int c, float v, float) const { const size_t i = (size_t)r * 2048 + c; GA[i] = f2bf(bf2f(GA[i]) * v); }
};
struct EpiGateB {
    bf16* TMP; const bf16* GB;
    __device__ __forceinline__ void operator()(int r, int c, float v, float) const { const size_t i = (size_t)r * 2048 + c; TMP[i] = f2bf(bf2f(TMP[i]) + bf2f(GB[i]) * v); }
};
struct EpiRes {
    const float* X; float* H; bf16* HB;
    __device__ __forceinline__ void operator()(int r, int c, float v, float) const { const size_t i = (size_t)r * 2048 + c; const float h = X[i] + v; H[i] = h; HB[i] = f2bf(h); }
};
struct EpiSwiglu {
    const float* HST; bf16* FFo;
    __device__ __forceinline__ void operator()(int r, int c, float g, float u) const {
        float ss = 0.f;
        for (int j = 0; j < 32; ++j) ss += HST[(size_t)r * 32 + j];
        const float rs = rsqrtf(ss * (1.f / D) + EPS);
        const float gg = g * rs, uu = u * rs;
        FFo[(size_t)r * FF + c] = f2bf(gg * sigmoidf(gg) * uu);
    }
};
struct EpiRes2 {
    float* H;
    __device__ __forceinline__ void operator()(int r, int c, float v, float) const { const size_t i = (size_t)r * 2048 + c; H[i] = H[i] + v; }
};

__device__ __forceinline__ void rows_vst(const bf16* V, float* VST, int gw, int ngw, int lane) {
    for (int m = gw; m < M; m += ngw) {
        const int j = lane >> 1, hf = lane & 1;
        const u32x4* p = (const u32x4*)(V + (size_t)m * D + j * 64 + hf * 32);
        float s = 0.f, q = 0.f;
#pragma unroll
        for (int i = 0; i < 4; ++i) { const u32x4 w = p[i]; const unsigned ww[4] = {w.x, w.y, w.z, w.w};
#pragma unroll
            for (int e = 0; e < 4; ++e) { const float a = __uint_as_float(ww[e] << 16), b = __uint_as_float(ww[e] & 0xffff0000u); s += a + b; q += a * a + b * b; } }
        s += __shfl_xor(s, 1); q += __shfl_xor(q, 1);
        if (hf == 0) { VST[((size_t)m * 32 + j) * 2] = s; VST[((size_t)m * 32 + j) * 2 + 1] = q; }
    }
}
__device__ __forceinline__ void rows_hst(const float* H, float* HST, int gw, int ngw, int lane) {
    for (int m = gw; m < M; m += ngw) {
        const int j = lane >> 1, hf = lane & 1;
        const f32x4* p = (const f32x4*)(H + (size_t)m * D + j * 64 + hf * 32);
        float q = 0.f;
#pragma unroll
        for (int i = 0; i < 8; ++i) { const f32x4 w = p[i]; q += w.x * w.x + w.y * w.y + w.z * w.z + w.w * w.w; }
        q += __shfl_xor(q, 1);
        if (hf == 0) HST[(size_t)m * 32 + j] = q;
    }
}
__device__ __forceinline__ void naive_qlat(float* lds, const bf16* Q, const float* w_uk, bf16* QL, int vb, int nb) {
    float* qs = lds;
    const int tid = threadIdx.x;
    for (int unit = vb; unit < (M / 32) * NH; unit += nb) {
        const int h = unit % NH, t0 = (unit / NH) * 32;
        __syncthreads();
        for (int i = tid; i < 32 * 128; i += NTHREADS) qs[i] = bf2f(Q[(size_t)(t0 + (i >> 7)) * D + h * 128 + (i & 127)]);
        __syncthreads();
        float acc[32];
#pragma unroll
        for (int i = 0; i < 32; ++i) acc[i] = 0.f;
        const f32x4* wr = (const f32x4*)(w_uk + (size_t)tid * 2048 + h * 128);
        for (int d4 = 0; d4 < 32; ++d4) {
            const f32x4 w = wr[d4];
#pragma unroll
            for (int i = 0; i < 32; ++i) { const f32x4 q = *(const f32x4*)(qs + i * 128 + d4 * 4); acc[i] += w.x * q.x + w.y * q.y + w.z * q.z + w.w * q.w; }
        }
#pragma unroll
        for (int i = 0; i < 32; ++i) QL[((size_t)(t0 + i) * NH + h) * CL + tid] = f2bf(acc[i]);
    }
}
__device__ __forceinline__ void naive_yb(float* lds, const bf16* OL, const float* w_uv, bf16* YB, int vb, int nb) {
    float* os = lds;
    const int tid = threadIdx.x, d = tid & 127, tq = tid >> 7;
    for (int unit = vb; unit < (M / 32) * NH; unit += nb) {
        const int h = unit % NH, t0 = (unit / NH) * 32;
        __syncthreads();
        for (int i = tid; i < 32 * 512; i += NTHREADS) os[i] = bf2f(OL[((size_t)(t0 + (i >> 9)) * NH + h) * CL + (i & 511)]);
        __syncthreads();
        float acc[8];
#pragma unroll
        for (int i = 0; i < 8; ++i) acc[i] = 0.f;
        for (int c = 0; c < CL; ++c) {
            const float w = w_uv[(size_t)c * 2048 + h * 128 + d];
#pragma unroll
            for (int i = 0; i < 8; ++i) acc[i] += w * os[(tq * 8 + i) * 512 + c];
        }
#pragma unroll
        for (int i = 0; i < 8; ++i) YB[(size_t)(t0 + tq * 8 + i) * D + h * 128 + d] = f2bf(acc[i]);
    }
}

#endif
#ifdef DBG_CHECK
__device__ __forceinline__ void dbg_scores(float* lds, const bf16* QI, const bf16* KI, const float* WI, const float* SC, unsigned* res, int vb, int nb) {
    float* qs = lds;
    float* ws = lds + 1024;
    const int tid = threadIdx.x;
    float dmax = 0.f, rmax = 0.f;
    for (int ii = vb; ii < 256; ii += nb) { const int t = ii * 32 + 17;
        const int b = t / SEQ, pos = t % SEQ, nadm = ((pos >> 6) + 1) * 64;
        __syncthreads();
        for (int i = tid; i < 1024; i += NTHREADS) qs[i] = bf2f(QI[(size_t)t * 1024 + i]);
        if (tid < 16) ws[tid] = WI[(size_t)t * 16 + tid] * 0.25f;
        __syncthreads();
        const float* out = SC + sc_off(b, pos);
        for (int s = tid; s < nadm; s += NTHREADS) {
            float k[64];
            const u32x4* kp = (const u32x4*)(KI + (size_t)(b * SEQ + s) * 64);
#pragma unroll
            for (int i = 0; i < 8; ++i) { const u32x4 w = kp[i]; const unsigned ww[4] = {w.x, w.y, w.z, w.w};
#pragma unroll
                for (int e = 0; e < 4; ++e) { k[i * 8 + e * 2] = __uint_as_float(ww[e] << 16); k[i * 8 + e * 2 + 1] = __uint_as_float(ww[e] & 0xffff0000u); } }
            float sc = 0.f;
            for (int h = 0; h < 16; ++h) {
                float l = 0.f;
#pragma unroll
                for (int d = 0; d < 64; ++d) l += qs[h * 64 + d] * k[d];
                sc += ws[h] * fmaxf(l * 0.125f, 0.f);
            }
            dmax = fmaxf(dmax, fabsf(out[s] - sc)); rmax = fmaxf(rmax, fabsf(sc));
        }
    }
    atomicMax(res + 0, __float_as_uint(dmax)); atomicMax(res + 1, __float_as_uint(rmax));
}
__device__ __forceinline__ void dbg_attn(float* lds, bf16* QS, const bf16* QLfast, const bf16* CN, const int* SEL, unsigned* res, int vb, int nb) {
    float* qs = lds;
    float* att = lds + 16 * 512;
    int* sl = (int*)(att + 16 * 256);
    const int tid = threadIdx.x, lane = tid & 63, wid = tid >> 6;
    float dmax = 0.f, rmax = 0.f;
    for (int ii = vb; ii < 256; ii += nb) { const int t = ii * 32 + 17; bf16* QL = QS + (size_t)ii * 8192 - (size_t)t * 8192;
        const int b = t / SEQ, pos = t % SEQ, nadm = ((pos >> 6) + 1) * 64, nsel = nadm < TOPK ? nadm : TOPK;
        __syncthreads();
        for (int i = tid; i < 16 * 512; i += NTHREADS) qs[i] = bf2f(QL[(size_t)t * 8192 + i]);
        if (tid < 256) sl[tid] = (tid < nsel) ? SEL[(size_t)t * TOPK + tid] : 0;
        __syncthreads();
        {
            const int k = tid & 255, hh = tid >> 8;
            float a[8];
#pragma unroll
            for (int i = 0; i < 8; ++i) a[i] = 0.f;
            if (k < nsel) {
                const u32x4* cp = (const u32x4*)(CN + (size_t)(b * SEQ + sl[k]) * CL);
                for (int c8 = 0; c8 < 64; ++c8) {
                    const u32x4 w = cp[c8]; float cv[8];
                    cv[0] = __uint_as_float(w.x << 16); cv[1] = __uint_as_float(w.x & 0xffff0000u); cv[2] = __uint_as_float(w.y << 16); cv[3] = __uint_as_float(w.y & 0xffff0000u);
                    cv[4] = __uint_as_float(w.z << 16); cv[5] = __uint_as_float(w.z & 0xffff0000u); cv[6] = __uint_as_float(w.w << 16); cv[7] = __uint_as_float(w.w & 0xffff0000u);
#pragma unroll
                    for (int i = 0; i < 8; ++i) { const float* qh = qs + (hh * 8 + i) * 512 + c8 * 8;
                        const f32x4 q0 = *(const f32x4*)qh, q1 = *(const f32x4*)(qh + 4);
                        a[i] += q0.x * cv[0] + q0.y * cv[1] + q0.z * cv[2] + q0.w * cv[3] + q1.x * cv[4] + q1.y * cv[5] + q1.z * cv[6] + q1.w * cv[7]; }
                }
            }
#pragma unroll
            for (int i = 0; i < 8; ++i) att[(hh * 8 + i) * 256 + k] = (k < nsel) ? a[i] * 0.08838834764831845f : -INFINITY;
        }
        __syncthreads();
        {
#pragma unroll
            for (int hi = 0; hi < 2; ++hi) { float* row = att + (wid * 2 + hi) * 256;
                float v[4]; float mx = -INFINITY;
#pragma unroll
                for (int i = 0; i < 4; ++i) { v[i] = row[lane + 64 * i]; mx = fmaxf(mx, v[i]); }
                mx = wave_max(mx); float s = 0.f;
#pragma unroll
                for (int i = 0; i < 4; ++i) { v[i] = __expf(v[i] - mx); s += v[i]; }
                s = wave_sum(s); const float inv = 1.f / s;
#pragma unroll
                for (int i = 0; i < 4; ++i) row[lane + 64 * i] = v[i] * inv; }
        }
        __syncthreads();
        {
            float o[16];
#pragma unroll
            for (int i = 0; i < 16; ++i) o[i] = 0.f;
            for (int k = 0; k < nsel; ++k) {
                const float cv = bf2f(CN[(size_t)(b * SEQ + sl[k]) * CL + tid]);
#pragma unroll
                for (int h = 0; h < 16; ++h) o[h] += att[h * 256 + k] * cv;
            }
#pragma unroll
            for (int h = 0; h < 16; ++h) { const float f = bf2f(QLfast[(size_t)t * 8192 + h * 512 + tid]); dmax = fmaxf(dmax, fabsf(f - o[h])); rmax = fmaxf(rmax, fabsf(o[h])); }
        }
    }
    atomicMax(res + 2, __float_as_uint(dmax)); atomicMax(res + 3, __float_as_uint(rmax));
}
#endif
#define XB_TMO      128
#define XB_XCNT(j)  (256  + 64 * (j))
#define XB_XSUB(j)  (1280 + 64 * (j))
#define XB_XGEN(j)  (2304 + 64 * (j))
#define XB_TOP      3328
#define XB_TOPGEN   3392
#define XCD_BAR_WORDS 3456
#define XB_SPIN_CAP (1u << 18)

__device__ __forceinline__ unsigned xb_ld(unsigned* p)              { return __hip_atomic_load(p, __ATOMIC_RELAXED, __HIP_MEMORY_SCOPE_AGENT); }
__device__ __forceinline__ unsigned xb_add(unsigned* p, unsigned v) { return __hip_atomic_fetch_add(p, v, __ATOMIC_RELAXED, __HIP_MEMORY_SCOPE_AGENT); }
__device__ __forceinline__ unsigned xb_xcc_id() { return (unsigned)__builtin_amdgcn_s_getreg((3 << 11) | 20) & 0xFu; }
#define XB_SPIN(cond, bar) do { unsigned _sp = 0; while (cond) { __builtin_amdgcn_s_sleep(1); \
    if ((++_sp & 255u) == 0u) { if (xb_ld(&(bar)[XB_TMO])) break; if (_sp > XB_SPIN_CAP) { atomicAdd(&(bar)[XB_TMO], 1u); break; } } } } while (0)

struct XcdBarrier {
    unsigned* bar; unsigned x;
    volatile LAS unsigned* st;
};

__device__ __forceinline__ XcdBarrier xcd_barrier_post(unsigned* bar, volatile LAS unsigned* st) {
    XcdBarrier b; b.bar = bar; b.x = xb_xcc_id(); b.st = st;
    if (threadIdx.x == 0) (void)xb_add(&bar[XB_XCNT(b.x)], 1u);
    return b;
}
__device__ __forceinline__ void xcd_barrier_complete(unsigned* bar, unsigned x, unsigned& nloc, unsigned& nx) {
    const unsigned G = gridDim.x * gridDim.y * gridDim.z;
    unsigned sum, cnt, mine, sp = 0u;
    for (;;) {
        sum = 0u; cnt = 0u; mine = 0u;
#pragma unroll
        for (unsigned j = 0; j < 16; ++j) { const unsigned c = xb_ld(&bar[XB_XCNT(j)]); sum += c; cnt += (c > 0u) ? 1u : 0u; mine = (j == x) ? c : mine; }
        if (sum == G) break;
        __builtin_amdgcn_s_sleep(1);
        if ((++sp & 255u) == 0u) { if (xb_ld(&bar[XB_TMO])) break; if (sp > XB_SPIN_CAP) { atomicAdd(&bar[XB_TMO], 1u); break; } }
    }
    nloc = mine > 0u ? mine : 1u; nx = cnt > 0u ? cnt : 1u;
}

__device__ __forceinline__ void xcd_barrier(const XcdBarrier& b) {
    asm volatile("s_waitcnt vmcnt(0)" ::: "memory");
    __syncthreads();
    if (threadIdx.x == 0) {
        unsigned* bar = b.bar;
        __builtin_amdgcn_s_waitcnt(0);
        unsigned nloc = b.st[0], nx = b.st[1];
        if (nloc == 0u) { xcd_barrier_complete(bar, b.x, nloc, nx); b.st[0] = nloc; b.st[1] = nx; }
        const unsigned old = xb_add(&bar[XB_XSUB(b.x)], 1u);
        const unsigned gen = old / nloc;
        if (old + 1u == (gen + 1u) * nloc) {
            __builtin_amdgcn_fence(__ATOMIC_RELEASE, "agent");
            asm volatile("s_waitcnt vmcnt(0)" ::: "memory");
            const unsigned og = xb_add(&bar[XB_TOP], 1u);
            const unsigned tg = og / nx;
            if (og + 1u == (tg + 1u) * nx) xb_add(&bar[XB_TOPGEN], 1u);
            else XB_SPIN(xb_ld(&bar[XB_TOPGEN]) == tg, bar);
            __builtin_amdgcn_fence(__ATOMIC_ACQUIRE, "agent");
            xb_add(&bar[XB_XGEN(b.x)], 1u);
            asm volatile("s_waitcnt vmcnt(0)" ::: "memory");
        } else {
            XB_SPIN(xb_ld(&bar[XB_XGEN(b.x)]) == gen, bar);
            __builtin_amdgcn_fence(__ATOMIC_ACQUIRE, "agent");
            asm volatile("s_waitcnt vmcnt(0)" ::: "memory");
        }
    }
    __syncthreads();
}

#define LDS_WAIT() asm volatile("s_waitcnt lgkmcnt(0)" ::: "memory")
#define VM_WAIT() asm volatile("s_waitcnt vmcnt(0)" ::: "memory")
template <class ColMap>
__device__ __forceinline__ void transpose_item(const float* W, int ldw, int ks0, bf16* WT, int ldd, int kd0, int n0, const ColMap& cm, const float* kscale, LAS float* scr, int lane) {
    const int sc = cm(n0 + (lane & 31));
#pragma unroll 8
    for (int i = 0; i < 32; ++i) { const int kk = 2 * i + (lane >> 5); float v = 0.f;
        if (sc >= 0) { v = W[(size_t)(ks0 + kk) * ldw + sc]; if (kscale) v *= kscale[ks0 + kk]; }
        scr[kk * 33 + (lane & 31)] = v; }
    LDS_WAIT(); asm volatile("" ::: "memory");
    const int c = lane & 7;
#pragma unroll
    for (int j = 0; j < 4; ++j) { const int n = (lane >> 3) + 8 * j; const LAS float* s = scr + (8 * c) * 33 + n;
        u32x4 o; o.x = pk2(s[0 * 33], s[1 * 33]); o.y = pk2(s[2 * 33], s[3 * 33]); o.z = pk2(s[4 * 33], s[5 * 33]); o.w = pk2(s[6 * 33], s[7 * 33]);
        *(u32x4*)(WT + (size_t)(n0 + n) * ldd + kd0 + 8 * c) = o; }
    LDS_WAIT(); asm volatile("" ::: "memory");
}
template <class ColMap>
__device__ __forceinline__ void transpose_item64(const float* W, int ldw, int ks0, bf16* WT, int ldd, int kd0, int n0, const ColMap& cm, const float* kscale, LAS float* scr, int lane) {
    const int n4 = lane & 15, kr = lane >> 4;
    const int sc = cm(n0 + 4 * n4);
    f32x4 v[16];
#pragma unroll
    for (int i = 0; i < 16; ++i) v[i] = (sc >= 0) ? *(const f32x4*)(W + (size_t)(ks0 + 4 * i + kr) * ldw + sc) : (f32x4){0.f, 0.f, 0.f, 0.f};
    if (kscale) {
#pragma unroll
        for (int i = 0; i < 16; ++i) v[i] = v[i] * kscale[ks0 + 4 * i + kr];
    }
#pragma unroll
    for (int i = 0; i < 16; ++i) { LAS float* p = scr + (4 * i + kr) * 65 + 4 * n4; p[0] = v[i][0]; p[1] = v[i][1]; p[2] = v[i][2]; p[3] = v[i][3]; }
    LDS_WAIT(); asm volatile("" ::: "memory");
    const int c = lane & 7;
#pragma unroll
    for (int r = 0; r < 8; ++r) { const int n = (lane >> 3) + 8 * r; const LAS float* s_ = scr + (8 * c) * 65 + n;
        u32x4 o; o.x = pk2(s_[0 * 65], s_[1 * 65]); o.y = pk2(s_[2 * 65], s_[3 * 65]); o.z = pk2(s_[4 * 65], s_[5 * 65]); o.w = pk2(s_[6 * 65], s_[7 * 65]);
        *(u32x4*)(WT + (size_t)(n0 + n) * ldd + kd0 + 8 * c) = o; }
    LDS_WAIT(); asm volatile("" ::: "memory");
}
struct CmIdent { __device__ __forceinline__ int operator()(int n) const { return n; } };
struct CmWin { __device__ __forceinline__ int operator()(int n) const { return n < 7760 ? n : (n < 7936 ? -1 : n - 176); } };
struct CmGU { __device__ __forceinline__ int operator()(int n) const { return (n >> 8) * 128 + (n & 127); } };

__device__ __forceinline__ void p0_prologue(LAS unsigned char* lds, const float* x, const float* norm1_g, const float* w_in, const float* w_uk, const float* w_uv,
                                            const float* w_oa, const float* w_ob, const float* w_out, bf16* XN, bf16* WIN, bf16* WUK, bf16* WUV, bf16* WOA, bf16* WOB, bf16* WOUT,
                                            int gw, int ngw, int wave, int lane) {
    LAS float* scr = (LAS float*)(lds + wave * 16640);
    constexpr int NB_IN = NINP / 64, I_IN = 32 * NB_IN, I_SQ = 32 * 32, I_UV = 16 * 32;
    constexpr int NITEMS = I_IN + 3 * I_SQ + I_UV;
    for (int it = gw; it < NITEMS; it += ngw) {
        int r = it;
        if (r < I_IN) { const int nb = r % NB_IN, kb = r / NB_IN; transpose_item64(w_in, NIN, kb * 64, WIN, D, kb * 64, nb * 64, CmWin(), nullptr, scr, lane); continue; } r -= I_IN;
        if (r < I_SQ) { transpose_item64(w_oa, D, (r / 32) * 64, WOA, D, (r / 32) * 64, (r % 32) * 64, CmIdent(), nullptr, scr, lane); continue; } r -= I_SQ;
        if (r < I_SQ) { transpose_item64(w_ob, D, (r / 32) * 64, WOB, D, (r / 32) * 64, (r % 32) * 64, CmIdent(), nullptr, scr, lane); continue; } r -= I_SQ;
        if (r < I_SQ) { transpose_item64(w_out, D, (r / 32) * 64, WOUT, D, (r / 32) * 64, (r % 32) * 64, CmIdent(), nullptr, scr, lane); continue; } r -= I_SQ;
        {
            const int nb = r % 32, kb = r / 32, h = nb >> 1; const bool data = (kb >> 3) == (h & 1);
            if (data) transpose_item64(w_uv, D, (kb & 7) * 64, WUV, 1024, kb * 64, nb * 64, CmIdent(), nullptr, scr, lane);
            else { const int c = lane & 7;
#pragma unroll
                for (int j = 0; j < 8; ++j) { const int n = (lane >> 3) + 8 * j; *(u32x4*)(WUV + (size_t)(nb * 64 + n) * 1024 + kb * 64 + 8 * c) = (u32x4){0u, 0u, 0u, 0u}; } }
        }
    }
    for (int i = gw * 64 + lane; i < 16 * 512 * 16; i += ngw * 64) { const int d8 = i & 15, c = (i >> 4) & 511, h = i >> 13;
        const f32x4* s = (const f32x4*)(w_uk + (size_t)c * 2048 + h * 128 + d8 * 8); const f32x4 a = s[0], b = s[1];
        u32x4 o; o.x = pk2(a[0], a[1]); o.y = pk2(a[2], a[3]); o.z = pk2(b[0], b[1]); o.w = pk2(b[2], b[3]);
        *(u32x4*)(WUK + ((size_t)h * 512 + c) * 128 + d8 * 8) = o; }
    rows_xn(x, norm1_g, XN, gw, ngw, lane);
}
__device__ __forceinline__ void p_convert_ffn(LAS unsigned char* lds, const float* w_fg, const float* w_fu, const float* w_fd, const float* norm2_g, bf16* WGU, bf16* WD, int gw, int ngw, int wave, int lane) {
    LAS float* scr = (LAS float*)(lds + wave * 16640);
    constexpr int I_GU = 32 * (11264 / 64), I_D = 88 * 32;
    for (int it = gw; it < I_GU + I_D; it += ngw) {
        int r = it;
        if (r < I_GU) { const int nb = r % 176, kb = r / 176; const bool up = ((nb * 64) & 128) != 0;
            transpose_item64(up ? w_fu : w_fg, FF, kb * 64, WGU, D, kb * 64, nb * 64, CmGU(), norm2_g, scr, lane); continue; } r -= I_GU;
        transpose_item64(w_fd, D, (r / 32) * 64, WD, FF, (r / 32) * 64, (r % 32) * 64, CmIdent(), nullptr, scr, lane);
    }
}

#ifndef REPEAT_MASK
#define REPEAT_MASK 0
#endif
__device__ __forceinline__ int opaque_one() { int x = 1; asm volatile("" : "+s"(x)); return x; }
#define REP(k) for (int rep_ = 0, repn_ = (((REPEAT_MASK >> (k)) & 1) ? 1 + opaque_one() : 1); rep_ < repn_; ++rep_)

#define P_X ((const float*)ka->in[0])
#define P_NORM1 ((const float*)ka->in[1])
#define P_WIN_F ((const float*)ka->in[2])
#define P_LNG ((const float*)ka->in[3])
#define P_LNB ((const float*)ka->in[4])
#define P_WS_F ((const float*)ka->in[5])
#define P_BS_F ((const float*)ka->in[6])
#define P_KVG ((const float*)ka->in[7])
#define P_WUK_F ((const float*)ka->in[8])
#define P_WUV_F ((const float*)ka->in[9])
#define P_WOA_F ((const float*)ka->in[10])
#define P_WOB_F ((const float*)ka->in[11])
#define P_WOUT_F ((const float*)ka->in[12])
#define P_NORM2 ((const float*)ka->in[13])
#define P_WFG ((const float*)ka->in[14])
#define P_WFU ((const float*)ka->in[15])
#define P_WFD ((const float*)ka->in[16])
#define P_FING ((const float*)ka->in[17])
#define B16(off) ((bf16*)(ws + (off)))
#define F32(off) ((float*)(ws + (off)))
constexpr int CW_BAR = 4096;
struct Args { const float* in[18]; float* out; unsigned char* ws; int ph_lo, ph_hi, use_bar, pad; };
constexpr int N_PHASES = 12;

template <int ONLY> __global__ void __launch_bounds__(NTHREADS, 2) mk_fwd(Args a) {
    extern __shared__ __attribute__((aligned(16))) unsigned char lds_g[];
    LAS unsigned char* lds = (LAS unsigned char*)lds_g;
    float* ldsf = (float*)lds_g;
    const int tid = threadIdx.x, lane = tid & 63, wave = __builtin_amdgcn_readfirstlane(tid >> 6);
    const int G = gridDim.x, vb = blockIdx.x;
    const int gw = vb * NWAVES + wave, ngw = G * NWAVES;
    const __attribute__((address_space(4))) Args* ka = (const __attribute__((address_space(4))) Args*)__builtin_amdgcn_kernarg_segment_ptr();
    unsigned char* const ws = a.ws;
    for (int u = tid; u < (LDS_BYTES - LDSCTL_OFF) / 4; u += NTHREADS) ((LAS unsigned*)(lds + LDSCTL_OFF))[u] = 0u;
    __syncthreads();
    XcdBarrier bar; bar.bar = (unsigned*)(ws + WS_CTL) + CW_BAR; bar.x = 0; bar.st = nullptr;
    if (a.use_bar) bar = xcd_barrier_post((unsigned*)(ws + WS_CTL) + CW_BAR, (volatile LAS unsigned*)(lds + MISC_OFF) + 8);
    const int lo = a.ph_lo, hi = a.ph_hi;
#ifndef SKIPMASK
#define SKIPMASK 0
#endif
#define IN(k) (!((SKIPMASK >> (k)) & 1) && (ONLY < 0 || ONLY == (k)) && lo <= (k) && (k) < hi)
#ifdef DBG_TIME
#define STAMP(i) do { if (vb == 0 && tid == 0) ((unsigned long long*)(ws + WS_CTL + 32768))[i] = __builtin_amdgcn_s_memrealtime(); } while (0)
#define SEAM(k) do { STAMP(2 * (k) + 1); if (IN(k) && IN((k) + 1)) xcd_barrier(bar); STAMP(2 * (k) + 2); } while (0)
#else
#define STAMP(i) do { } while (0)
#ifdef DBG_BAR2
#define SEAM(k) do { if (IN(k) && IN((k) + 1)) { xcd_barrier(bar); xcd_barrier(bar); } } while (0)
#else
#define SEAM(k) do { if (IN(k) && IN((k) + 1)) xcd_barrier(bar); } while (0)
#endif
#endif

    STAMP(0);
    if (IN(0)) REP(0) { p0_prologue(lds, P_X, P_NORM1, P_WIN_F, P_WUK_F, P_WUV_F, P_WOA_F, P_WOB_F, P_WOUT_F, B16(WS_XN), B16(WS_WIN), B16(WS_WUK), B16(WS_WUV), B16(WS_WOA), B16(WS_WOB), B16(WS_WOUT), gw, ngw, wave, lane); }
    SEAM(0);
#if defined(NAIVEMASK) && (NAIVEMASK & (1 << 1))
    if (IN(1)) { EpiProj e{B16(WS_U), B16(WS_V), B16(WS_Q), B16(WS_QI), B16(WS_KI), B16(WS_GA), B16(WS_GB), F32(WS_CKR), F32(WS_WI), 0}; naive_gemm<false>(ldsf, B16(WS_XN), D, P_WIN_F, nullptr, NIN, nullptr, M, NIN, D, e, vb, G); }
#else
    if (IN(1)) REP(1) { pg8::Gemm g{B16(WS_XN), B16(WS_WIN), D, D, D}; pg8::StaticOrder S; S.init(M, NINP, G, vb);
        pg8::EpiProjF E{ws};
        pg8::gemm_phase<pg8::EpiProjF, pg8::StaticOrder, true, true>(lds, g, S, E); }
#endif
    SEAM(1);
#if defined(NAIVEMASK)
    if (ONLY == 101) { rows_vst(B16(WS_V), F32(WS_VST), gw, ngw, lane); }
    if (ONLY == 102) { rows_hst(ka->out, F32(WS_HST), gw, ngw, lane); }
#endif
    if (IN(2)) { REP(11) rows_cn(F32(WS_CKR), P_KVG, B16(WS_CN), gw, ngw, lane); REP(12) fast_gating(lds, B16(WS_U), B16(WS_V), F32(WS_VST), P_LNG, P_LNB, P_WS_F, P_BS_F, vb, G, wave, lane, rep_ + 1 < repn_); REP(2) fast_scores2(lds, B16(WS_QI), B16(WS_KI), F32(WS_WI), F32(WS_SC), vb, G, wave, lane); __syncthreads(); }
    SEAM(2);
#ifdef DBG_CHECK
    if (IN(3)) { dbg_scores(ldsf, B16(WS_QI), B16(WS_KI), F32(WS_WI), F32(WS_SC), (unsigned*)(ws + WS_CTL) + 3000, vb, G); __syncthreads(); }
#endif
#if defined(NAIVEMASK) && (NAIVEMASK & (1 << 3))
    if (IN(3)) { EpiGateA e{B16(WS_GA)}; naive_gemm<false>(ldsf, B16(WS_U), D, P_WOA_F, nullptr, D, nullptr, M, D, D, e, vb, G); topk_rows(F32(WS_SC), (int*)(ws + WS_SEL), gw, ngw, lane); }
#else
    if (IN(3)) { pg8::Gemm g{B16(WS_U), B16(WS_WOA), D, D, D}; pg8::StaticOrder S; S.init(M, D, G, vb);
        for (int rep_ = ((REPEAT_MASK >> 13) & 1) ? 0 : 1; rep_ < 2; ++rep_) { pg8::EpiGateAF E{B16(WS_GA), rep_ == 0}; pg8::gemm_phase<pg8::EpiGateAF, pg8::StaticOrder, true, true>(lds, g, S, E); }
        if (G == 256) topk_rows5(lds, F32(WS_SC), (int*)(ws + WS_SEL), gw, wave, lane); else topk_rows2(lds, F32(WS_SC), (int*)(ws + WS_SEL), gw, ngw, wave, lane); }
#endif
    SEAM(3);
#if defined(NAIVEMASK) && (NAIVEMASK & (1 << 4))
    if (IN(4)) { naive_qlat(ldsf, B16(WS_Q), P_WUK_F, B16(WS_QL), vb, G); }
#else
    if (IN(4)) REP(4) { int kq = 128; asm volatile("" : "+s"(kq)); pg8::Gemm g{B16(WS_Q), B16(WS_WUK), D, 128, kq}; pg8::HeadOrderQ S{G, vb}; pg8::EpiQlatF E{B16(WS_QL)};
        pg8::gemm_phase<pg8::EpiQlatF, pg8::HeadOrderQ, true, true>(lds, g, S, E); }
#endif
    SEAM(4);
#ifdef DBG_CHECK
    if (IN(5)) { for (int ii = vb; ii < 256; ii += G) { const u32x4* src = (const u32x4*)(B16(WS_QL) + (size_t)(ii * 32 + 17) * 8192); u32x4* dst = (u32x4*)(ws + 326 * MiB) + (size_t)ii * 1024; for (int e = tid; e < 1024; e += NTHREADS) dst[e] = src[e]; } xcd_barrier(bar); }
#endif
    if (IN(5)) { REP(5) attn_wave(lds, B16(WS_QL), B16(WS_CN), (const int*)(ws + WS_SEL), vb, G, wave, lane, rep_ + 1 < repn_); __syncthreads(); }
    SEAM(5);
#ifdef DBG_CHECK
    if (IN(6)) { dbg_attn(ldsf, (bf16*)(ws + 326 * MiB), B16(WS_QL), B16(WS_CN), (const int*)(ws + WS_SEL), (unsigned*)(ws + WS_CTL) + 3000, vb, G); __syncthreads(); }
#endif
#if defined(NAIVEMASK) && (NAIVEMASK & (1 << 6))
    if (IN(6)) { naive_yb(ldsf, B16(WS_QL), P_WUV_F, B16(WS_Q), vb, G); }
#else
    if (IN(6)) REP(6) { pg8::Gemm g{B16(WS_QL), B16(WS_WUV), 8192, 1024, 1024}; pg8::PairOrderYB S{G, vb}; pg8::EpiPlainF E{B16(WS_Q), D};
        pg8::gemm_phase<pg8::EpiPlainF, pg8::PairOrderYB, true, true>(lds, g, S, E); }
#endif
    SEAM(6);
#if defined(NAIVEMASK) && (NAIVEMASK & (1 << 7))
    if (IN(7)) { EpiGateB e{B16(WS_GA), B16(WS_GB)}; naive_gemm<false>(ldsf, B16(WS_Q), D, P_WOB_F, nullptr, D, nullptr, M, D, D, e, vb, G); p_convert_ffn(lds, P_WFG, P_WFU, P_WFD, P_NORM2, B16(WS_WGU), B16(WS_WD), gw, ngw, wave, lane); }
#else
    if (IN(7)) { pg8::Gemm g{B16(WS_Q), B16(WS_WOB), D, D, D}; pg8::StaticOrder S; S.init(M, D, G, vb); for (int rep_ = ((REPEAT_MASK >> 14) & 1) ? 0 : 1; rep_ < 2; ++rep_) { pg8::EpiGateBF E{B16(WS_GA), B16(WS_GB), rep_ == 0}; pg8::gemm_phase<pg8::EpiGateBF, pg8::StaticOrder, true, true>(lds, g, S, E); }
        REP(15) p_convert_ffn(lds, P_WFG, P_WFU, P_WFD, P_NORM2, B16(WS_WGU), B16(WS_WD), gw, ngw, wave, lane); }
#endif
    SEAM(7);
#if defined(NAIVEMASK) && (NAIVEMASK & (1 << 8))
    if (IN(8)) { EpiRes e{P_X, ka->out, B16(WS_HB)}; naive_gemm<false>(ldsf, B16(WS_GA), D, P_WOUT_F, nullptr, D, nullptr, M, D, D, e, vb, G); }
#else
    if (IN(8)) REP(8) { pg8::Gemm g{B16(WS_GA), B16(WS_WOUT), D, D, D}; pg8::StaticOrder S; S.init(M, D, G, vb); pg8::EpiResF E{P_X, ka->out, B16(WS_HB), F32(WS_HST)};
        pg8::gemm_phase<pg8::EpiResF, pg8::StaticOrder, true, true>(lds, g, S, E); }
#endif
    SEAM(8);
#if defined(NAIVEMASK) && (NAIVEMASK & (1 << 9))
    if (IN(9)) { EpiSwiglu e{F32(WS_HST), B16(WS_FF)}; naive_gemm<true>(ldsf, B16(WS_HB), D, P_WFG, P_WFU, FF, P_NORM2, M, FF, D, e, vb, G); }
#else
    if (IN(9)) REP(9) { pg8::Gemm g{B16(WS_HB), B16(WS_WGU), D, D, D}; pg8::StaticOrder S; S.init(M, 11264, G, vb); pg8::EpiSwigluF E{F32(WS_HST), B16(WS_FF)};
        pg8::gemm_phase<pg8::EpiSwigluF, pg8::StaticOrder, true, true>(lds, g, S, E); }
#endif
    SEAM(9);
#if defined(NAIVEMASK) && (NAIVEMASK & (1 << 10))
    if (IN(10)) { EpiRes2 e{ka->out}; naive_gemm<false>(ldsf, B16(WS_FF), FF, P_WFD, nullptr, D, nullptr, M, D, FF, e, vb, G); }
#else
    if (IN(10)) { pg8::Gemm g{B16(WS_FF), B16(WS_WD), FF, FF, FF}; pg8::StaticOrder S; S.init(M, D, G, vb); for (int rep_ = ((REPEAT_MASK >> 10) & 1) ? 0 : 1; rep_ < 2; ++rep_) { pg8::EpiRes2F E{ka->out, rep_ == 0}; pg8::gemm_phase<pg8::EpiRes2F, pg8::StaticOrder, true, true>(lds, g, S, E); } }
#endif
    SEAM(10);
    if (IN(11)) REP(7) rows_final(ka->out, P_FING, gw, ngw, lane, rep_ + 1 < repn_);
#ifdef DBG_TIME
    if (IN(11)) { STAMP(23); xcd_barrier(bar); if (vb == 0) { const unsigned long long* ts = (const unsigned long long*)(ws + WS_CTL + 32768);
            float total = (float)(ts[23] - ts[0]) * 0.01f; float barsum = 0.f; for (int k = 0; k < 11; ++k) barsum += (float)(ts[2 * k + 2] - ts[2 * k + 1]) * 0.01f;
            float ph[12]; for (int k = 0; k < 12; ++k) ph[k] = (float)(ts[2 * k + 1] - ts[2 * k]) * 0.01f;
            float W[12]; for (int k = 0; k < 11; ++k) W[k] = (float)(ts[2 * k + 2] - ts[2 * k]) * 0.01f / total; W[11] = (float)(ts[23] - ts[22]) * 0.01f / total;
            const float fa = DBG_A, fb = DBG_B;
            const float A = 100.f + 10.f * floorf(fa * 50.f); (void)fb;
            __syncthreads(); if (tid == 0) ka->out[0] = A; } }
#endif
#ifdef DBG_CHECK
    if (IN(11)) { xcd_barrier(bar); if (vb == 0 && tid == 0) { const unsigned* res = (const unsigned*)(ws + WS_CTL) + 3000; const float d = __uint_as_float(res[DBG_CHECK * 2]), r = __uint_as_float(res[DBG_CHECK * 2 + 1]); ka->out[0] = 1.0e6f * d / r + 100.f; } }
#endif
#undef IN
#undef SEAM
}

#ifndef MK_N_LAUNCHES
#define MK_N_LAUNCHES 1
#endif

template <int P> static void launch_one(int grid, Args a, hipStream_t stream) {
    static bool attr = false;
    if (!attr) { (void)hipFuncSetAttribute((const void*)mk_fwd<P>, hipFuncAttributeMaxDynamicSharedMemorySize, LDS_BYTES); attr = true; }
    a.ph_lo = (P < 0 || P > 99) ? 0 : P; a.ph_hi = (P < 0) ? N_PHASES : ((P > 99) ? 0 : P + 1); a.use_bar = (P < 0) ? 1 : 0;
    hipLaunchKernelGGL(mk_fwd<P>, dim3(grid), dim3(NTHREADS), LDS_BYTES, stream, a);
}
extern "C" void kernel_launch(void* const* d_in, const int* in_sizes, int n_in, void* d_out, int out_size, void* d_ws, size_t ws_size, hipStream_t stream) {
    static int grid = 0;
    if (grid == 0) {
        if (n_in != 18 || out_size != M * D || ws_size < WS_END) { fprintf(stderr, "kernel_launch: unexpected shapes n_in %d out %d ws %zu\n", n_in, out_size, ws_size); grid = -1; return; }
        int dev = 0, cus = 0;
        (void)hipGetDevice(&dev); (void)hipDeviceGetAttribute(&cus, hipDeviceAttributeMultiprocessorCount, dev);
        grid = cus > 0 ? cus : 256;
    }
    if (grid < 0) return;
    (void)hipMemsetAsync((char*)d_ws + WS_CTL, 0, CTL_ZERO_BYTES, stream);
    Args a{};
    for (int i = 0; i < 18; ++i) a.in[i] = (const float*)d_in[i];
    a.out = (float*)d_out; a.ws = (unsigned char*)d_ws;
#if MK_N_LAUNCHES == 1
    launch_one<-1>(grid, a, stream);
#else
    launch_one<0>(grid, a, stream); launch_one<1>(grid, a, stream);
#if defined(NAIVEMASK) && (NAIVEMASK & 2)
    launch_one<101>(grid, a, stream);
#endif
    launch_one<2>(grid, a, stream); launch_one<3>(grid, a, stream); launch_one<4>(grid, a, stream); launch_one<5>(grid, a, stream);
    launch_one<6>(grid, a, stream); launch_one<7>(grid, a, stream); launch_one<8>(grid, a, stream);
#if defined(NAIVEMASK) && (NAIVEMASK & (1 << 8))
    launch_one<102>(grid, a, stream);
#endif
    launch_one<9>(grid, a, stream); launch_one<10>(grid, a, stream); launch_one<11>(grid, a, stream);
#endif
}
```
